# Optimizing an MI355X kernel written in HIP

```python
import jax, jax.numpy as jnp
from jax import lax
import numpy as np


D_MODEL = 1024
BATCH = 16
SEQ = 2048
DEPTH = 2

N_A_LAYERS = DEPTH // 2
N_B_LAYERS = DEPTH - N_A_LAYERS
N_DENSE = (DEPTH + 1) // 2
N_MOE = DEPTH // 2
NORM_EPS = 1e-6

MLSTM_HEADS = 4
MLSTM_DQK = D_MODEL // (2 * MLSTM_HEADS)
MLSTM_DV = D_MODEL // MLSTM_HEADS
MLSTM_CHUNK = 64
MLSTM_PROJ = MLSTM_HEADS * (2 * MLSTM_DQK + 2 * MLSTM_DV + 2)
MLSTM_SPLITS = (MLSTM_HEADS * MLSTM_DQK,
                2 * MLSTM_HEADS * MLSTM_DQK,
                2 * MLSTM_HEADS * MLSTM_DQK + MLSTM_HEADS * MLSTM_DV,
                2 * MLSTM_HEADS * MLSTM_DQK + 2 * MLSTM_HEADS * MLSTM_DV,
                2 * MLSTM_HEADS * MLSTM_DQK + 2 * MLSTM_HEADS * MLSTM_DV + MLSTM_HEADS)

ATT_HEADS = 8
ATT_KV_HEADS = 2
HEAD_DIM = D_MODEL // ATT_HEADS
MOBA_BLOCK = 256
MOBA_TOPK = 3
QUERY_BLOCK = 128
ROPE_THETA = 500000.0
ROT_DIM = HEAD_DIM // 4

D_FF = 2816
N_EXPERTS = 8
TOP_K_EXPERTS = 2
D_EXPERT = 3584

kernel_name = 'yoco_mlstm_moba_moe_block'


def rmsnorm(x, gain):
    xf = x.astype(jnp.float32)
    y = xf * lax.rsqrt(jnp.mean(xf * xf, axis=-1, keepdims=True) + NORM_EPS)
    return (y * gain.astype(jnp.float32)).astype(x.dtype)


def rope_partial(x, cos, sin):
    c = cos.astype(x.dtype)
    s = sin.astype(x.dtype)
    half = ROT_DIM // 2
    x1 = x[..., :half]
    x2 = x[..., half:ROT_DIM]
    return jnp.concatenate([x1 * c - x2 * s, x2 * c + x1 * s, x[..., ROT_DIM:]], axis=-1)


def swiglu(x, w_gu, w_down):
    g, u = jnp.split(x @ w_gu, 2, axis=-1)
    return (jax.nn.silu(g) * u) @ w_down


def mlstm_mixer(xn, w_in, b_if, out_gain, w_out):
    B, S, _ = xn.shape
    nc = S // MLSTM_CHUNK
    H, L = MLSTM_HEADS, MLSTM_CHUNK
    f32 = jnp.float32
    proj = xn @ w_in
    q, k, v, o, ig, fg = jnp.split(proj, MLSTM_SPLITS, axis=-1)

    def heads(t, d):
        return t.reshape(B, S, H, d).transpose(0, 2, 1, 3).reshape(B, H, nc, L, d).astype(f32)

    q = heads(q, MLSTM_DQK) * (MLSTM_DQK ** -0.5)
    k = heads(k, MLSTM_DQK)
    v = heads(v, MLSTM_DV)
    ig = (ig.astype(f32) + b_if[0].astype(f32)).transpose(0, 2, 1).reshape(B, H, nc, L)
    logf = jax.nn.log_sigmoid(fg.astype(f32) + b_if[1].astype(f32)).transpose(0, 2, 1).reshape(B, H, nc, L)

    bcum = jnp.cumsum(logf, axis=-1)
    g_tot = bcum[..., -1]
    a_end = g_tot[..., None] - bcum + ig

    def step(carry, xs):
        C, n, m = carry
        k_c, v_c, a_c, g_c = xs
        m_new = jnp.maximum(g_c + m, jnp.max(a_c, axis=-1))
        w = jnp.exp(a_c - m_new[..., None])
        decay = jnp.exp(g_c + m - m_new)
        C_new = decay[..., None, None] * C + jnp.einsum('bhlv,bhlk->bhvk', w[..., None] * v_c, k_c)
        n_new = decay[..., None] * n + jnp.einsum('bhl,bhlk->bhk', w, k_c)
        return (C_new, n_new, m_new), (C, n, m)

    init = (jnp.zeros((B, H, MLSTM_DV, MLSTM_DQK), f32),
            jnp.zeros((B, H, MLSTM_DQK), f32),
            jnp.zeros((B, H), f32))
    xs = (jnp.moveaxis(k, 2, 0), jnp.moveaxis(v, 2, 0), jnp.moveaxis(a_end, 2, 0), jnp.moveaxis(g_tot, 2, 0))
    _, (C_s, n_s, m_s) = lax.scan(step, init, xs)
    C_s = jnp.moveaxis(C_s, 0, 2)
    n_s = jnp.moveaxis(n_s, 0, 2)
    m_s = jnp.moveaxis(m_s, 0, 2)

    causal = jnp.tril(jnp.ones((L, L), dtype=bool))
    D = bcum[..., :, None] - bcum[..., None, :] + ig[..., None, :]
    D = jnp.where(causal, D, -jnp.inf)
    inter = bcum + m_s[..., None]
    m_t = jnp.maximum(inter, jnp.max(D, axis=-1))
    P = jnp.einsum('bhctk,bhcsk->bhcts', q, k) * jnp.exp(D - m_t[..., None])
    inter_w = jnp.exp(inter - m_t)
    num = jnp.einsum('bhcts,bhcsv->bhctv', P, v) + inter_w[..., None] * jnp.einsum('bhcvk,bhctk->bhctv', C_s, q)
    nq = jnp.sum(P, axis=-1) + inter_w * jnp.einsum('bhck,bhctk->bhct', n_s, q)
    den = jnp.maximum(jnp.abs(nq), jnp.exp(-m_t))
    h = num / den[..., None]

    h = h.reshape(B, H, S, MLSTM_DV).transpose(0, 2, 1, 3)
    h = h * lax.rsqrt(jnp.mean(h * h, axis=-1, keepdims=True) + NORM_EPS)
    h = h * out_gain.astype(f32).reshape(H, MLSTM_DV)
    h = h * jax.nn.sigmoid(o.astype(f32)).reshape(B, S, H, MLSTM_DV)
    return h.reshape(B, S, H * MLSTM_DV).astype(xn.dtype) @ w_out


def shared_kv(x, kv_norm, kv_w, cos, sin):
    B, S, _ = x.shape
    kv = rmsnorm(x, kv_norm) @ kv_w
    k, v = jnp.split(kv, 2, axis=-1)
    k = k.reshape(B, S, ATT_KV_HEADS, HEAD_DIM).transpose(0, 2, 1, 3)
    v = v.reshape(B, S, ATT_KV_HEADS, HEAD_DIM).transpose(0, 2, 1, 3)
    k = rope_partial(k, cos, sin)
    nb = -(-S // MOBA_BLOCK)
    pad = nb * MOBA_BLOCK - S
    k = jnp.pad(k, ((0, 0), (0, 0), (0, pad), (0, 0)))
    v = jnp.pad(v, ((0, 0), (0, 0), (0, pad), (0, 0)))
    k_blocks = k.reshape(B, ATT_KV_HEADS, nb, MOBA_BLOCK, HEAD_DIM)
    v_blocks = v.reshape(B, ATT_KV_HEADS, nb, MOBA_BLOCK, HEAD_DIM)
    k_means = jnp.mean(k_blocks.astype(jnp.float32), axis=3)
    return k_blocks, v_blocks, k_means


def moba_mixer(xn, w_q, w_o, k_blocks, v_blocks, k_means, cos, sin):
    B, S, _ = xn.shape
    H = ATT_HEADS
    nb = k_blocks.shape[2]
    nqb = S // QUERY_BLOCK
    kk = min(MOBA_TOPK, nb)
    f32 = jnp.float32
    q = (xn @ w_q).reshape(B, S, H, HEAD_DIM).transpose(0, 2, 1, 3)
    q = rope_partial(q, cos, sin)
    kv_of_head = jnp.arange(H) // (H // ATT_KV_HEADS)

    gate = jnp.einsum('bhtd,bhnd->bhtn', q.astype(f32), k_means[:, kv_of_head])
    own = jnp.arange(S) // MOBA_BLOCK
    past = jnp.arange(nb)[None, :] < own[:, None]
    gate = jnp.where(past, gate, -jnp.inf)
    _, sel = lax.top_k(gate, kk)

    def to_items(t):
        t = t.reshape(B, H, nqb, QUERY_BLOCK, *t.shape[3:])
        t = jnp.moveaxis(t, 2, 1)
        return t.reshape(B * nqb, H, QUERY_BLOCK, *t.shape[4:])

    b_ids = jnp.repeat(jnp.arange(B, dtype=jnp.int32), nqb)
    qb_ids = jnp.tile(jnp.arange(nqb, dtype=jnp.int32), B)
    scale = HEAD_DIM ** -0.5

    def attend(item):
        q_i, sel_i, b_i, qb_i = item
        kb = k_blocks[b_i]
        vb = v_blocks[b_i]
        own_blk = (qb_i * QUERY_BLOCK) // MOBA_BLOCK
        k_sel = kb[kv_of_head[:, None, None], sel_i]
        v_sel = vb[kv_of_head[:, None, None], sel_i]
        k_own = kb[kv_of_head, own_blk]
        v_own = vb[kv_of_head, own_blk]
        s_sel = jnp.einsum('htd,htjsd->htjs', q_i, k_sel).astype(f32) * scale
        slot_ok = jnp.arange(kk) < own_blk
        s_sel = jnp.where(slot_ok[:, None], s_sel, -jnp.inf)
        s_own = jnp.einsum('htd,hsd->hts', q_i, k_own).astype(f32) * scale
        t_pos = qb_i * QUERY_BLOCK + jnp.arange(QUERY_BLOCK)
        s_pos = own_blk * MOBA_BLOCK + jnp.arange(MOBA_BLOCK)
        s_own = jnp.where(s_pos[None, :] <= t_pos[:, None], s_own, -jnp.inf)
        scores = jnp.concatenate([s_sel.reshape(H, QUERY_BLOCK, kk * MOBA_BLOCK), s_own], axis=-1)
        p = jax.nn.softmax(scores, axis=-1).astype(v_sel.dtype)
        p_sel = p[..., :kk * MOBA_BLOCK].reshape(H, QUERY_BLOCK, kk, MOBA_BLOCK)
        p_own = p[..., kk * MOBA_BLOCK:]
        return jnp.einsum('htjs,htjsd->htd', p_sel, v_sel) + jnp.einsum('hts,hsd->htd', p_own, v_own)

    out = lax.map(attend, (to_items(q), to_items(sel), b_ids, qb_ids))
    out = out.reshape(B, nqb, H, QUERY_BLOCK, HEAD_DIM).transpose(0, 1, 3, 2, 4).reshape(B, S, H * HEAD_DIM)
    return out @ w_o


def moe_ffn(xn, router, w_gu, w_down):
    B, S, D = xn.shape
    xt = xn.reshape(B * S, D)
    logits = (xt @ router).astype(jnp.float32)
    top_logits, top_idx = lax.top_k(logits, TOP_K_EXPERTS)
    top_w = jax.nn.softmax(top_logits, axis=-1)
    combine = jnp.einsum('nk,nke->ne', top_w, jax.nn.one_hot(top_idx, N_EXPERTS, dtype=jnp.float32)).astype(xn.dtype)
    y = jnp.zeros_like(xt)
    for e in range(N_EXPERTS):
        y = y + combine[:, e:e + 1] * swiglu(xt, w_gu[e], w_down[e])
    return y.reshape(B, S, D)


def setup_inputs(seed: int = 0) -> dict:
    key = jax.random.key(seed)
    ks = jax.random.split(key, 20)
    f32 = jnp.float32

    def w(k, shape, fan_in):
        return jax.random.normal(k, shape, f32) * (fan_in ** -0.5)

    def g(k, shape):
        return 1.0 + 0.02 * jax.random.normal(k, shape, f32)

    x = jax.random.normal(ks[0], (BATCH, SEQ, D_MODEL), f32)
    b_i = 0.1 * jax.random.normal(ks[3], (N_A_LAYERS, MLSTM_HEADS), f32)
    b_f = jnp.linspace(3.0, 6.0, MLSTM_HEADS, dtype=f32)[None, :] + 0.1 * jax.random.normal(ks[4], (N_A_LAYERS, MLSTM_HEADS), f32)
    return {
        'x': x,
        'mlstm_norm': g(ks[1], (N_A_LAYERS, D_MODEL)),
        'mlstm_w_in': w(ks[2], (N_A_LAYERS, D_MODEL, MLSTM_PROJ), D_MODEL),
        'mlstm_b_if': jnp.stack([b_i, b_f], axis=1),
        'mlstm_out_norm': g(ks[5], (N_A_LAYERS, MLSTM_HEADS * MLSTM_DV)),
        'mlstm_w_out': w(ks[6], (N_A_LAYERS, MLSTM_HEADS * MLSTM_DV, D_MODEL), MLSTM_HEADS * MLSTM_DV),
        'ffn_norm': g(ks[7], (DEPTH, D_MODEL)),
        'dense_w_gu': w(ks[8], (N_DENSE, D_MODEL, 2 * D_FF), D_MODEL),
        'dense_w_down': w(ks[9], (N_DENSE, D_FF, D_MODEL), D_FF),
        'moe_router': w(ks[10], (N_MOE, D_MODEL, N_EXPERTS), D_MODEL),
        'moe_w_gu': w(ks[11], (N_MOE, N_EXPERTS, D_MODEL, 2 * D_EXPERT), D_MODEL),
        'moe_w_down': w(ks[12], (N_MOE, N_EXPERTS, D_EXPERT, D_MODEL), D_EXPERT),
        'kv_norm': g(ks[13], (D_MODEL,)),
        'kv_w': w(ks[14], (D_MODEL, 2 * ATT_KV_HEADS * HEAD_DIM), D_MODEL),
        'moba_norm': g(ks[15], (N_B_LAYERS, D_MODEL)),
        'moba_w_q': w(ks[16], (N_B_LAYERS, D_MODEL, ATT_HEADS * HEAD_DIM), D_MODEL),
        'moba_w_o': w(ks[17], (N_B_LAYERS, ATT_HEADS * HEAD_DIM, D_MODEL), ATT_HEADS * HEAD_DIM),
        'final_norm': g(ks[18], (D_MODEL,)),
    }


def reference(x, mlstm_norm, mlstm_w_in, mlstm_b_if, mlstm_out_norm, mlstm_w_out, ffn_norm,
              dense_w_gu, dense_w_down, moe_router, moe_w_gu, moe_w_down, kv_norm, kv_w,
              moba_norm, moba_w_q, moba_w_o, final_norm):
    S = x.shape[1]
    pos = jnp.arange(S, dtype=jnp.float32)
    inv_freq = ROPE_THETA ** (-jnp.arange(0, ROT_DIM, 2, dtype=jnp.float32) / ROT_DIM)
    ang = pos[:, None] * inv_freq[None, :]
    cos, sin = jnp.cos(ang), jnp.sin(ang)

    shared = None
    for l in range(DEPTH):
        if l < N_A_LAYERS:
            x = x + mlstm_mixer(rmsnorm(x, mlstm_norm[l]), mlstm_w_in[l], mlstm_b_if[l],
                                mlstm_out_norm[l], mlstm_w_out[l])
        else:
            if shared is None:
                shared = shared_kv(x, kv_norm, kv_w, cos, sin)
            j = l - N_A_LAYERS
            k_blocks, v_blocks, k_means = shared
            x = x + moba_mixer(rmsnorm(x, moba_norm[j]), moba_w_q[j], moba_w_o[j],
                               k_blocks, v_blocks, k_means, cos, sin)
        hn = rmsnorm(x, ffn_norm[l])
        if l % 2 == 0:
            x = x + swiglu(hn, dense_w_gu[l // 2], dense_w_down[l // 2])
        else:
            x = x + moe_ffn(hn, moe_router[l // 2], moe_w_gu[l // 2], moe_w_down[l // 2])
    return rmsnorm(x, final_norm)
```

```cpp
#include <hip/hip_runtime.h>
#include <cstdio>
#include <cstdint>
namespace pg8 {
#define PG8_LAS __attribute__((address_space(3)))
typedef unsigned short bf16_t;
typedef short bf16x8 __attribute__((ext_vector_type(8)));
typedef float f32x4 __attribute__((ext_vector_type(4)));
typedef unsigned u32x4 __attribute__((ext_vector_type(4)));
constexpr int BM = 256, BK = 64, HALF = 128, HTB = HALF * BK * 2  , STAGE_BYTES = 8 * HTB, NXCD = 8, WGM = 8;

__host__ __device__ __forceinline__ int lds_byte(int r, int c) { const int st = (r >> 4) * 2 + (c >> 5), rr = r & 15, cc = c & 31, ob = rr * 64 + cc * 2; return st * 1024 + (ob ^ (((ob >> 9) & 1) << 5)); }
__host__ __device__ __forceinline__ void stage_rc(int b, int& R, int& C) { const int st = b / 1024, sb = b % 1024, swz = sb ^ (((sb >> 9) & 1) << 5); R = (st >> 1) * 16 + swz / 64; C = (st & 1) * 32 + (swz % 64) / 2; }
__host__ __device__ __forceinline__ int perm32(int rho) { const int n = rho >> 4, i = rho & 15; return 8 * (i >> 2) + 4 * n + (i & 3); }

struct Unit { int pm, pn, pc; };
struct Gemm { const bf16_t* A; const bf16_t* Bt; int M, N, K, Kext; };

struct StaticOrder {
    int nM, nN, nwg, G, c;
    __host__ __device__ __forceinline__ void init(int M, int N, int G_, int c_) { nM = M / BM; nN = N / BM; nwg = nM * nN; G = G_; c = c_; }
    __host__ __device__ __forceinline__ bool next(int i, Unit& u) const {
        const long L = (long)i * G + c; if (L >= nwg) return false;
        int wgid = (int)L; { const int q = nwg / NXCD, r = nwg % NXCD, xcd = wgid % NXCD, off = wgid / NXCD; wgid = (xcd < r ? xcd * (q + 1) : r * (q + 1) + (xcd - r) * q) + off; }
        const int nig = WGM * nN, gid = wgid / nig, fm = gid * WGM, gsz = (nM - fm) < WGM ? (nM - fm) : WGM;
        u.pm = fm + ((wgid % nig) % gsz); u.pn = (wgid % nig) / gsz; u.pc = u.pn; return true;
    }
    __device__ __forceinline__ void a_ready(const Unit&) const {}
    __device__ __forceinline__ void done(const Unit&) const {}
};

__device__ __forceinline__ unsigned cvt_pk_bf16(float lo, float hi) { unsigned r; asm volatile("v_cvt_pk_bf16_f32 %0, %1, %2" : "=v"(r) : "v"(lo), "v"(hi)); return r; }
typedef float f32x2 __attribute__((ext_vector_type(2)));
typedef unsigned u32x2 __attribute__((ext_vector_type(2)));
struct EpiStore {
    static constexpr bool PERM = true, AFTER_DRAIN = false;
    bf16_t* O; int ldc;
    __device__ __forceinline__ void operator()(const f32x4 (&acc)[2][2][4][2], const Unit& u, int wr, int wc, int fr, int fq) const {
        const int row0 = u.pm * BM + wr * 64 + fr; const int col0 = u.pc * BM + wc * 32 + 8 * fq;
#pragma unroll
        for (int ai = 0; ai < 2; ++ai)
#pragma unroll
            for (int m = 0; m < 4; ++m) { bf16_t* rowp = O + (size_t)(row0 + ai * HALF + m * 16) * ldc + col0;
#pragma unroll
                for (int bj = 0; bj < 2; ++bj) { const f32x4 v0 = acc[ai][bj][m][0], v1 = acc[ai][bj][m][1];
                    u32x4 w; w.x = cvt_pk_bf16(v0[0], v0[1]); w.y = cvt_pk_bf16(v0[2], v0[3]); w.z = cvt_pk_bf16(v1[0], v1[1]); w.w = cvt_pk_bf16(v1[2], v1[3]);
                    *(u32x4*)(rowp + bj * HALF) = w; } }
    }
};
template <bool XB, int SHIFT = 0> struct EpiRes {
    static constexpr bool PERM = false, AFTER_DRAIN = false;
    const float* base; float* out; bf16_t* xb; float* part; static constexpr int ldc = 1024;
    __device__ __forceinline__ void operator()(const f32x4 (&acc)[2][2][4][2], const Unit& u, int wr, int wc, int fr, int fq) const {
        const int col0 = u.pc * BM + wc * 32 + 4 * fq;
#pragma unroll
        for (int ai = 0; ai < 2; ++ai)
#pragma unroll
            for (int m = 0; m < 4; ++m) { const int row = u.pm * BM + ai * HALF + wr * 64 + m * 16 + fr; const size_t off = (size_t)row * ldc + col0; float ss = 0.f;
#pragma unroll
                for (int bj = 0; bj < 2; ++bj)
#pragma unroll
                    for (int n = 0; n < 2; ++n) { const f32x4 bs = *(const f32x4*)(base + off + bj * HALF + n * 16); const f32x4 o = bs + acc[ai][bj][m][n] * (1.0f / (float)(1 << SHIFT)); *(f32x4*)(out + off + bj * HALF + n * 16) = o;
                        if constexpr (XB) { u32x2 w; w.x = cvt_pk_bf16(o[0], o[1]); w.y = cvt_pk_bf16(o[2], o[3]); *(u32x2*)(xb + off + bj * HALF + n * 16) = w; ss += (o[0] * o[0] + o[1] * o[1]) + (o[2] * o[2] + o[3] * o[3]); } }
                if constexpr (XB) { ss += __shfl_xor(ss, 16); ss += __shfl_xor(ss, 32); if (fq == 0) part[(size_t)row * 16 + u.pc * 4 + wc] = ss; }
                if (m & 1) asm volatile("" ::: "memory"); }
    }
};
__device__ __forceinline__ unsigned pk4_fp8(float a, float b, float c, float d) {
    a = __builtin_amdgcn_fmed3f(a, -448.f, 448.f); b = __builtin_amdgcn_fmed3f(b, -448.f, 448.f); c = __builtin_amdgcn_fmed3f(c, -448.f, 448.f); d = __builtin_amdgcn_fmed3f(d, -448.f, 448.f);
    int r = __builtin_amdgcn_cvt_pk_fp8_f32(a, b, 0, false); r = __builtin_amdgcn_cvt_pk_fp8_f32(c, d, r, true); return (unsigned)r;
}
template <bool F8OUT, bool ROWSC = false> struct EpiSwiglu {
    static constexpr bool PERM = false, AFTER_DRAIN = false;
    void* O; int ldc; float isc, osc; const float* rs; const float* ms;
    __device__ __forceinline__ void operator()(const f32x4 (&acc)[2][2][4][2], const Unit& u, int wr, int wc, int fr, int fq) const {
        const int j0 = u.pc * 128 + wc * 32 + 8 * fq; const float c1 = -1.4426950408889634f * isc, c2i = 1.0f / (isc * isc * osc);
#pragma unroll
        for (int ai = 0; ai < 2; ++ai)
#pragma unroll
            for (int m = 0; m < 4; ++m) { const int row = u.pm * BM + ai * HALF + wr * 64 + m * 16 + fr; const size_t off = (size_t)row * ldc + j0;
                float c1r = c1, c2r = c2i; if constexpr (ROWSC) { c1r = c1 * rs[row]; c2r = c2i * ms[row]; }
                f32x4 a[2];
#pragma unroll
                for (int bj = 0; bj < 2; ++bj) { const f32x4 g = acc[ai][bj][m][0], uu = acc[ai][bj][m][1];
#pragma unroll
                    for (int e = 0; e < 4; e += 2) { const f32x2 g2 = (f32x2){g[e], g[e + 1]}, u2 = (f32x2){uu[e], uu[e + 1]};
                        const f32x2 t2 = g2 * c1r; f32x2 ex; ex.x = __builtin_amdgcn_exp2f(t2.x); ex.y = __builtin_amdgcn_exp2f(t2.y);
                        const f32x2 d2 = ex * c2r + c2r; f32x2 r2; r2.x = __builtin_amdgcn_rcpf(d2.x); r2.y = __builtin_amdgcn_rcpf(d2.y);
                        const f32x2 o2 = (g2 * u2) * r2; a[bj][e] = o2.x; a[bj][e + 1] = o2.y; } }
                if constexpr (F8OUT) { u32x2 w; w.x = pk4_fp8(a[0][0], a[0][1], a[0][2], a[0][3]); w.y = pk4_fp8(a[1][0], a[1][1], a[1][2], a[1][3]); *(u32x2*)((unsigned char*)O + off) = w; }
                else { u32x4 w; w.x = cvt_pk_bf16(a[0][0], a[0][1]); w.y = cvt_pk_bf16(a[0][2], a[0][3]); w.z = cvt_pk_bf16(a[1][0], a[1][1]); w.w = cvt_pk_bf16(a[1][2], a[1][3]); *(u32x4*)((bf16_t*)O + off) = w; }
                __builtin_amdgcn_sched_barrier(0); }
    }
};
struct EpiRope {
    static constexpr bool PERM = false, AFTER_DRAIN = false;
    bf16_t* Q; bf16_t* Kb; float* KM; const float* rope;
    bf16_t* VT; int vt_ld, vt_pn0; const float* rs;
    __device__ __forceinline__ void operator()(const f32x4 (&acc)[2][2][4][2], const Unit& u, int wr, int wc, int fr, int fq) const {
        const bool isk = (u.pc == 4), isv = (u.pc == 5);
        bf16_t* base = Q + (isv ? (long)(VT - Q) : (isk ? (long)(Kb - Q) : 0L)); const int ldc = isv ? vt_ld : (isk ? 256 : 1024); const int colt = isv ? (u.pn - vt_pn0) * BM : (isk ? 0 : u.pc * BM);
        const int rowt = isv ? 0 : u.pm * BM; const bool rot = (wc == 0) && !isv;
        const int col0 = colt + wc * 32 + 4 * fq;
        f32x4 cs[2][2];
#pragma unroll
        for (int bj = 0; bj < 2; ++bj)
#pragma unroll
            for (int n = 0; n < 2; ++n) cs[bj][n] = (f32x4){0.f, 0.f, 0.f, 0.f};
#pragma unroll
        for (int ai = 0; ai < 2; ++ai)
#pragma unroll
            for (int m = 0; m < 4; ++m) { const int r = rowt + ai * HALF + wr * 64 + m * 16 + fr; bf16_t* rowp = base + (size_t)r * ldc + col0;
                f32x4 c4 = (f32x4){1.f, 1.f, 1.f, 1.f}, s4 = (f32x4){0.f, 0.f, 0.f, 0.f};
                if (rot) { const float* rp = rope + (size_t)(r & 2047) * 32 + 4 * fq; c4 = *(const f32x4*)rp; s4 = *(const f32x4*)(rp + 16); }
                const float rsr = isv ? 1.f : rs[r];
#pragma unroll
                for (int bj = 0; bj < 2; ++bj) { f32x4 x1 = acc[ai][bj][m][0] * rsr, x2 = acc[ai][bj][m][1] * rsr;
                    if (isv) { x1 = x1 * *(const f32x4*)(rs + col0 + bj * HALF); x2 = x2 * *(const f32x4*)(rs + col0 + bj * HALF + 16); }
                    if (rot) { const f32x4 y1 = x1 * c4 - x2 * s4, y2 = x2 * c4 + x1 * s4; x1 = y1; x2 = y2; }
                    if (isk) { cs[bj][0] += x1; cs[bj][1] += x2; }
                    u32x2 w; w.x = cvt_pk_bf16(x1[0], x1[1]); w.y = cvt_pk_bf16(x1[2], x1[3]); *(u32x2*)(rowp + bj * HALF) = w;
                    w.x = cvt_pk_bf16(x2[0], x2[1]); w.y = cvt_pk_bf16(x2[2], x2[3]); *(u32x2*)(rowp + bj * HALF + 16) = w; } }
        if (isk) {
#pragma unroll
            for (int bj = 0; bj < 2; ++bj)
#pragma unroll
                for (int n = 0; n < 2; ++n)
#pragma unroll
                    for (int e = 0; e < 4; ++e) { float s = cs[bj][n][e]; s += __shfl_xor(s, 1); s += __shfl_xor(s, 2); s += __shfl_xor(s, 4); s += __shfl_xor(s, 8);
                        if (fr == 0) atomicAdd(KM + (size_t)u.pm * 256 + bj * HALF + wc * 32 + n * 16 + 4 * fq + e, s); }
        }
    }
};
struct QkvOrder {
    StaticOrder so; int G, c, nnorm, nsw, swA, swB;
    __device__ __forceinline__ bool next(int i, Unit& u) const {
        if (so.next(i, u)) return true;
        const int j = i * G + c - nnorm; if (j >= nsw) return false;
        u.pm = swA; u.pn = swB + j; u.pc = 5; return true;
    }
    __device__ __forceinline__ void a_ready(const Unit&) const {}
    __device__ __forceinline__ void done(const Unit&) const {}
};
struct TailOrder {
    int c, ntail, pm0, nct; int pb1, pb2, pb3, pb4, pb5, pb6, pb7;
    __device__ __forceinline__ bool next(int i, Unit& u) const {
        const int j = c >> 1; if (i > 0 || j >= ntail) return false;
        u.pm = pm0 + (j >> 2); u.pc = j & 3;
        const int e = (u.pm >= pb1) + (u.pm >= pb2) + (u.pm >= pb3) + (u.pm >= pb4) + (u.pm >= pb5) + (u.pm >= pb6) + (u.pm >= pb7);
        u.pn = e * nct + u.pc; return true;
    }
    __device__ __forceinline__ void a_ready(const Unit&) const {}
    __device__ __forceinline__ void done(const Unit&) const {}
};
struct MoeOrder {
    StaticOrder so; int nct; int pb1, pb2, pb3, pb4, pb5, pb6, pb7;
    __device__ __forceinline__ bool next(int i, Unit& u) const {
        if (!so.next(i, u)) return false;
        const int e = (u.pm >= pb1) + (u.pm >= pb2) + (u.pm >= pb3) + (u.pm >= pb4) + (u.pm >= pb5) + (u.pm >= pb6) + (u.pm >= pb7);
        u.pc = u.pn; u.pn = e * nct + u.pc; return true;
    }
    __device__ __forceinline__ void a_ready(const Unit&) const {}
    __device__ __forceinline__ void done(const Unit&) const {}
};
typedef int i32x4 __attribute__((ext_vector_type(4)));
typedef int i32x8 __attribute__((ext_vector_type(8)));
template <class Epi, class Sched, bool ALIGN_EPI = false, bool SP2 = false, bool FP8 = false>
__device__ __forceinline__ void gemm_phase(PG8_LAS unsigned char* lds, const Gemm g, const Sched& S, const Epi& E) {
    const int tid = threadIdx.x, wid = __builtin_amdgcn_readfirstlane(tid >> 6), lane = tid & 63, wr = wid >> 2, wc = wid & 3, fr = lane & 15, fq = lane >> 4;
    const int K = g.K, nt = (g.Kext ? g.Kext : K) / BK;
    unsigned voffA[2], voffB[2];
#pragma unroll
    for (int i = 0; i < 2; ++i) { int R, C; stage_rc(tid * 16 + i * 8192, R, C); const int Rb = Epi::PERM ? ((R & ~31) + perm32(R & 31)) : R;
        voffA[i] = (unsigned)(R * K + C) * 2u; voffB[i] = (unsigned)(Rb * K + C) * 2u; }
    const size_t kstep = (size_t)(BK * 2);
    const size_t hstep = (size_t)HALF * K * 2;
    const size_t tstep = 2 * hstep;
    const unsigned ldsw = (unsigned)wid * 1024u;
    const int aoff = lds_byte(wr * 64 + fr, fq * 8), boff = lds_byte(wc * 32 + fr, fq * 8);
#define PG8_SA(b, h) (((b) * 2 + (h)) * HTB)
#define PG8_SB(b, h) ((4 + (b) * 2 + (h)) * HTB)
#define PG8_STAGE(bufoff, gbase, voff) do { _Pragma("unroll") for (int _i = 0; _i < 2; ++_i) \
        __builtin_amdgcn_global_load_lds((const unsigned*)((const char*)(gbase) + (voff)[_i]), (PG8_LAS unsigned*)(lds + (bufoff) + ldsw + _i * 8192), 16, 0, 0); } while (0)
#define PG8_LDA(dst, b, h) do { if constexpr (FP8) { _Pragma("unroll") for (int m = 0; m < 4; ++m) { const i32x4 lo_ = *(const PG8_LAS i32x4*)(lds + PG8_SA(b, h) + aoff + m * 2048), hi_ = *(const PG8_LAS i32x4*)(lds + PG8_SA(b, h) + aoff + m * 2048 + 1024); dst##8[m] = __builtin_shufflevector(lo_, hi_, 0, 1, 2, 3, 4, 5, 6, 7); } } \
    else { _Pragma("unroll") for (int m = 0; m < 4; ++m) _Pragma("unroll") for (int k = 0; k < 2; ++k) dst[m][k] = *(const PG8_LAS bf16x8*)(lds + PG8_SA(b, h) + aoff + m * 2048 + k * 1024); } } while (0)
#define PG8_LDB(dst, b, h) do { if constexpr (FP8) { _Pragma("unroll") for (int n = 0; n < 2; ++n) { const i32x4 lo_ = *(const PG8_LAS i32x4*)(lds + PG8_SB(b, h) + boff + n * 2048), hi_ = *(const PG8_LAS i32x4*)(lds + PG8_SB(b, h) + boff + n * 2048 + 1024); dst##8[n] = __builtin_shufflevector(lo_, hi_, 0, 1, 2, 3, 4, 5, 6, 7); } } \
    else { _Pragma("unroll") for (int n = 0; n < 2; ++n) _Pragma("unroll") for (int k = 0; k < 2; ++k) dst[n][k] = *(const PG8_LAS bf16x8*)(lds + PG8_SB(b, h) + boff + n * 2048 + k * 1024); } } while (0)
#define PG8_MMA(ai, bj, At, Bt) do { __builtin_amdgcn_s_setprio(1); \
        if constexpr (FP8) { asm volatile("s_nop 1\n\t" \
            "v_mfma_scale_f32_16x16x128_f8f6f4 %0, %12, %8, %0, %14, %14 op_sel_hi:[0,0,0]\n\t" \
            "v_mfma_scale_f32_16x16x128_f8f6f4 %1, %13, %8, %1, %14, %14 op_sel_hi:[0,0,0]\n\t" \
            "v_mfma_scale_f32_16x16x128_f8f6f4 %2, %12, %9, %2, %14, %14 op_sel_hi:[0,0,0]\n\t" \
            "v_mfma_scale_f32_16x16x128_f8f6f4 %3, %13, %9, %3, %14, %14 op_sel_hi:[0,0,0]\n\t" \
            "v_mfma_scale_f32_16x16x128_f8f6f4 %4, %12, %10, %4, %14, %14 op_sel_hi:[0,0,0]\n\t" \
            "v_mfma_scale_f32_16x16x128_f8f6f4 %5, %13, %10, %5, %14, %14 op_sel_hi:[0,0,0]\n\t" \
            "v_mfma_scale_f32_16x16x128_f8f6f4 %6, %12, %11, %6, %14, %14 op_sel_hi:[0,0,0]\n\t" \
            "v_mfma_scale_f32_16x16x128_f8f6f4 %7, %13, %11, %7, %14, %14 op_sel_hi:[0,0,0]\n\t" \
            : "+v"(acc[ai][bj][0][0]), "+v"(acc[ai][bj][0][1]), "+v"(acc[ai][bj][1][0]), "+v"(acc[ai][bj][1][1]), "+v"(acc[ai][bj][2][0]), "+v"(acc[ai][bj][2][1]), "+v"(acc[ai][bj][3][0]), "+v"(acc[ai][bj][3][1]) \
            : "v"(At##8[0]), "v"(At##8[1]), "v"(At##8[2]), "v"(At##8[3]), "v"(Bt##8[0]), "v"(Bt##8[1]), "v"(scl8)); } \
        else { _Pragma("unroll") for (int m = 0; m < 4; ++m) _Pragma("unroll") for (int n = 0; n < 2; ++n) _Pragma("unroll") for (int k = 0; k < 2; ++k) \
            acc[ai][bj][m][n] = __builtin_amdgcn_mfma_f32_16x16x32_bf16(Bt[n][k], At[m][k], acc[ai][bj][m][n], 0, 0, 0); } \
        __builtin_amdgcn_s_setprio(0); } while (0)
#define PG8_WAIT_V(n) asm volatile("s_waitcnt vmcnt(" #n ")" ::: "memory")
#define PG8_WAIT_L(n) asm volatile("s_waitcnt lgkmcnt(" #n ")" ::: "memory")
#define PG8_BAR __builtin_amdgcn_s_barrier()
#define PG8_SCHED __builtin_amdgcn_sched_barrier(0)
    Unit cur, nxt; int ui = 0;
    if (!S.next(0, cur)) return;
    f32x4 acc[2][2][4][2];
#pragma unroll
    for (int a = 0; a < 2; ++a)
#pragma unroll
        for (int b = 0; b < 2; ++b)
#pragma unroll
            for (int m = 0; m < 4; ++m)
#pragma unroll
                for (int n = 0; n < 2; ++n) { acc[a][b][m][n] = (f32x4){0.f, 0.f, 0.f, 0.f}; }
    const int scl8 = 0x7f7f7f7f;
    bf16x8 At[4][2], B0[2][2], B1[2][2]; i32x8 At8[4], B08[2], B18[2];
    const char* cA = (const char*)g.A + (size_t)cur.pm * tstep; const char* cB = (const char*)g.Bt + (size_t)cur.pn * tstep;
    S.a_ready(cur);
    if constexpr (SP2) {
        PG8_STAGE(PG8_SB(0, 0), cB, voffB); PG8_STAGE(PG8_SB(0, 1), cB + hstep, voffB); PG8_STAGE(PG8_SA(0, 0), cA, voffA); PG8_STAGE(PG8_SA(0, 1), cA + hstep, voffA);
        if (wr == 1) PG8_BAR;
        PG8_WAIT_V(2); PG8_BAR;
        PG8_STAGE(PG8_SB(1, 0), cB + kstep, voffB); PG8_STAGE(PG8_SA(1, 0), cA + kstep, voffA); PG8_STAGE(PG8_SB(1, 1), cB + hstep + kstep, voffB);
        PG8_WAIT_V(6); PG8_BAR;
    } else {
        PG8_STAGE(PG8_SB(0, 0), cB, voffB); PG8_STAGE(PG8_SA(0, 0), cA, voffA); PG8_STAGE(PG8_SB(0, 1), cB + hstep, voffB); PG8_STAGE(PG8_SA(0, 1), cA + hstep, voffA);
        if (wr == 1) PG8_BAR;
        PG8_WAIT_V(4); PG8_BAR;
        PG8_STAGE(PG8_SB(1, 0), cB + kstep, voffB); PG8_STAGE(PG8_SA(1, 0), cA + kstep, voffA); PG8_STAGE(PG8_SB(1, 1), cB + hstep + kstep, voffB);
        PG8_WAIT_V(6); PG8_BAR;
    }
    for (;;) {
        const bool has_next = S.next(ui + 1, nxt);
        const char* nA = has_next ? (const char*)g.A + (size_t)nxt.pm * tstep : cA; const char* nB = has_next ? (const char*)g.Bt + (size_t)nxt.pn * tstep : cB;
        for (int t = 0; t < nt; t += 2) {
            const bool last = (t == nt - 2);
            const char* a1 = cA + (size_t)(t + 1) * kstep;
            const char* a2 = last ? nA : cA + (size_t)(t + 2) * kstep; const char* b2 = last ? nB : cB + (size_t)(t + 2) * kstep;
            const char* a3 = a2 + kstep; const char* b3 = b2 + kstep;
            if (last && has_next) S.a_ready(nxt);
            if constexpr (SP2) {
            PG8_LDB(B0, 0, 0); PG8_LDB(B1, 0, 1); PG8_SCHED; PG8_LDA(At, 0, 0); PG8_STAGE(PG8_SA(1, 1), a1 + hstep, voffA);
            PG8_WAIT_V(8); PG8_WAIT_L(0); PG8_BAR; PG8_MMA(0, 0, At, B0); PG8_MMA(0, 1, At, B1); PG8_BAR; PG8_SCHED;
            PG8_LDA(At, 0, 1); PG8_STAGE(PG8_SB(0, 0), b2, voffB); PG8_STAGE(PG8_SB(0, 1), b2 + hstep, voffB); PG8_STAGE(PG8_SA(0, 0), a2, voffA);
            PG8_WAIT_V(8); PG8_WAIT_L(0); PG8_BAR; PG8_MMA(1, 0, At, B0); PG8_MMA(1, 1, At, B1); PG8_BAR; PG8_SCHED;
            PG8_LDB(B0, 1, 0); PG8_LDB(B1, 1, 1); PG8_SCHED; PG8_LDA(At, 1, 0); PG8_STAGE(PG8_SA(0, 1), a2 + hstep, voffA);
            PG8_WAIT_V(8); PG8_WAIT_L(0); PG8_BAR; PG8_MMA(0, 0, At, B0); PG8_MMA(0, 1, At, B1); PG8_BAR; PG8_SCHED;
            PG8_LDA(At, 1, 1); PG8_STAGE(PG8_SB(1, 0), b3, voffB); PG8_STAGE(PG8_SB(1, 1), b3 + hstep, voffB); PG8_STAGE(PG8_SA(1, 0), a3, voffA);
            PG8_WAIT_V(8); PG8_WAIT_L(0); PG8_BAR; PG8_MMA(1, 0, At, B0); PG8_MMA(1, 1, At, B1); PG8_BAR; PG8_SCHED;
            } else {
            PG8_LDB(B0, 0, 0); PG8_SCHED; PG8_LDA(At, 0, 0); PG8_STAGE(PG8_SA(1, 1), a1 + hstep, voffA);
            PG8_WAIT_L(8); PG8_BAR; PG8_WAIT_L(0); PG8_MMA(0, 0, At, B0); PG8_BAR; PG8_SCHED;
            PG8_LDB(B1, 0, 1); PG8_STAGE(PG8_SB(0, 0), b2, voffB);
            PG8_BAR; PG8_WAIT_L(0); PG8_MMA(0, 1, At, B1); PG8_BAR;
            PG8_LDA(At, 0, 1); PG8_STAGE(PG8_SA(0, 0), a2, voffA);
            PG8_BAR; PG8_WAIT_L(0); PG8_MMA(1, 0, At, B0); PG8_BAR; PG8_SCHED;
            PG8_STAGE(PG8_SB(0, 1), b2 + hstep, voffB);
            PG8_WAIT_V(6); PG8_BAR; PG8_MMA(1, 1, At, B1); PG8_BAR;
            PG8_LDB(B0, 1, 0); PG8_SCHED; PG8_LDA(At, 1, 0); PG8_STAGE(PG8_SA(0, 1), a2 + hstep, voffA);
            PG8_WAIT_L(8); PG8_BAR; PG8_WAIT_L(0); PG8_MMA(0, 0, At, B0); PG8_BAR; PG8_SCHED;
            PG8_LDB(B1, 1, 1); PG8_STAGE(PG8_SB(1, 0), b3, voffB);
            PG8_BAR; PG8_WAIT_L(0); PG8_MMA(0, 1, At, B1); PG8_BAR;
            PG8_LDA(At, 1, 1); PG8_STAGE(PG8_SA(1, 0), a3, voffA);
            PG8_BAR; PG8_WAIT_L(0); PG8_MMA(1, 0, At, B0); PG8_BAR; PG8_SCHED;
            PG8_STAGE(PG8_SB(1, 1), b3 + hstep, voffB);
            PG8_WAIT_V(6); PG8_BAR; PG8_MMA(1, 1, At, B1); PG8_BAR;
            }
        }
        if constexpr (FP8) asm volatile("s_nop 15\n\ts_nop 15" : "+v"(acc[1][0][0][0]), "+v"(acc[1][0][0][1]), "+v"(acc[1][0][1][0]), "+v"(acc[1][0][1][1]), "+v"(acc[1][0][2][0]), "+v"(acc[1][0][2][1]), "+v"(acc[1][0][3][0]), "+v"(acc[1][0][3][1]),
            "+v"(acc[1][1][0][0]), "+v"(acc[1][1][0][1]), "+v"(acc[1][1][1][0]), "+v"(acc[1][1][1][1]), "+v"(acc[1][1][2][0]), "+v"(acc[1][1][2][1]), "+v"(acc[1][1][3][0]), "+v"(acc[1][1][3][1]));
        if constexpr (ALIGN_EPI) { if (wr == 0) PG8_BAR; }
        if constexpr (!Epi::AFTER_DRAIN) { E(acc, cur, wr, wc, fr, fq); S.done(cur); }
        if (!has_next) break;
#pragma unroll
        for (int a = 0; a < 2; ++a)
#pragma unroll
            for (int b = 0; b < 2; ++b)
#pragma unroll
                for (int m = 0; m < 4; ++m)
#pragma unroll
                    for (int n = 0; n < 2; ++n) { acc[a][b][m][n] = (f32x4){0.f, 0.f, 0.f, 0.f}; }
        cur = nxt; cA = nA; cB = nB; ++ui;
        if constexpr (ALIGN_EPI) { if (wr == 1) PG8_BAR; }
    }
    PG8_WAIT_V(0);
    if constexpr (!ALIGN_EPI) { if (wr == 0) PG8_BAR; }
    PG8_BAR;
    if constexpr (Epi::AFTER_DRAIN) { E.fused(acc, cur, wr, wc, fr, fq, lds, wid, lane); S.done(cur); }
#undef PG8_SA
#undef PG8_SB
#undef PG8_STAGE
#undef PG8_LDA
#undef PG8_LDB
#undef PG8_MMA
#undef PG8_WAIT_V
#undef PG8_WAIT_L
#undef PG8_BAR
#undef PG8_SCHED
}
}
#ifndef MK_PER_PHASE
#define MK_PER_PHASE 0
#endif
#ifndef MK_DUP
#define MK_DUP (-1)
#endif
#ifndef SIDEJOB
#define SIDEJOB 0
#endif
#ifndef DOWN_F8
#define DOWN_F8 1
#endif
#ifndef DENSE_F8
#define DENSE_F8 0
#endif
#ifndef MOE_F8
#define MOE_F8 1
#endif
constexpr float XA_SC = 8.f, WGU_SC = 64.f, ACT_SC = 8.f, WDN_SC = 128.f;
constexpr int NWAVES = 8;
constexpr int NPHASE = 17;

constexpr int DM = 1024, BATCH = 16, SEQ = 2048, NTOK = BATCH * SEQ;
constexpr int MH = 4, DQK = 128, DV = 256, CH = 64, NCH = SEQ / CH;
constexpr int WIN_LD = 3080;
constexpr int AH = 8, AKV = 2, HD = 128, NBLK = 8;
constexpr int DFF = 2816, NE = 8, DEXP = 3584;
constexpr int MAXPANEL = 264;
constexpr float EPS = 1e-6f;

constexpr size_t MiB = 1u << 20;
constexpr size_t WS_CTL = 0, CTL_ZERO_BYTES = 1 * MiB;
constexpr int CW_BAR = 4096;
constexpr size_t WS_KM = 256 * 1024;
constexpr size_t WS_ROPE = 1 * MiB;
constexpr size_t WS_GATES = 2 * MiB;
constexpr size_t WS_ME = 4 * MiB;
constexpr size_t WS_MW = 5 * MiB;
constexpr size_t WS_MR = 6 * MiB;
constexpr size_t WS_MP = 7 * MiB;
constexpr size_t WS_HIST = 8 * MiB;
constexpr size_t WS_PB = 8 * MiB + 64 * 1024;
constexpr size_t WS_PART = 9 * MiB;
constexpr size_t WS_RS = 12 * MiB, WS_MS = 13 * MiB;
constexpr size_t WS_WIN = 16 * MiB;
constexpr size_t WS_WOUT = 22 * MiB;
constexpr size_t WS_WGU = 24 * MiB;
constexpr size_t WS_WDN = 35 * MiB;
constexpr size_t WS_WQKV = 41 * MiB;
constexpr size_t WS_WO = 44 * MiB;
constexpr size_t WS_WMGU = 46 * MiB;
constexpr size_t WS_WMDN = 158 * MiB;
constexpr size_t WS_A = 224 * MiB;
constexpr size_t WS_B = 360 * MiB;
constexpr size_t WS_QKO = WS_B;
constexpr size_t WS_KVT = WS_B + 128 * MiB;
constexpr size_t WS_H = WS_B + 224 * MiB;
constexpr size_t WS_ACT = WS_B;
constexpr size_t WS_Q = WS_B;
constexpr size_t WS_K = WS_B + 64 * MiB;
constexpr size_t WS_VT = WS_B + 80 * MiB;
constexpr size_t WS_ATT = WS_B + 96 * MiB;
constexpr size_t WS_ACT2 = WS_B;
constexpr size_t WS_Y2 = WS_B + (size_t)MAXPANEL * 256 * DEXP * 2;
constexpr size_t WS_END = WS_Y2 + 4 * MiB;
static_assert(WS_WMDN + (size_t)NE * 1024 * DEXP * 2 <= WS_A && WS_A + (size_t)MAXPANEL * 256 * 1024 * 2 <= WS_B, "d_ws map");

constexpr int RING_OFF = 0, RING_BYTES = 131072;
constexpr int LDSCTL_OFF = 155648, MISC_OFF = LDSCTL_OFF + 320;
constexpr int LDS_BYTES = 156672;

#define GAS __attribute__((address_space(1)))
#define LAS __attribute__((address_space(3)))
typedef unsigned short bf16;
typedef unsigned v4u __attribute__((ext_vector_type(4)));
typedef unsigned v2u __attribute__((ext_vector_type(2)));
typedef float f32x4 __attribute__((ext_vector_type(4)));
typedef short bf16x8 __attribute__((ext_vector_type(8)));
typedef GAS unsigned gu32;
#define RLX_AGENT __ATOMIC_RELAXED, __HIP_MEMORY_SCOPE_AGENT
#define LDS_WAIT() asm volatile("s_waitcnt lgkmcnt(0)" ::: "memory")
#define VM_WAIT() asm volatile("s_waitcnt vmcnt(0)" ::: "memory")
#define MFMA16(a, b, c) __builtin_amdgcn_mfma_f32_16x16x32_bf16((a), (b), (c), 0, 0, 0)
__device__ __forceinline__ unsigned pk2(float lo, float hi) { return pg8::cvt_pk_bf16(lo, hi); }
__device__ __forceinline__ float bflo(unsigned w) { return __uint_as_float(w << 16); }
__device__ __forceinline__ float bfhi(unsigned w) { return __uint_as_float(w & 0xffff0000u); }
__device__ __forceinline__ float wave_sum(float v) {
#pragma unroll
    for (int o = 1; o < 64; o <<= 1) v += __shfl_xor(v, o);
    return v;
}

#define XB_TMO      128
#define XB_XCNT(j)  (256  + 64 * (j))
#define XB_XSUB(j)  (1280 + 64 * (j))
#define XB_XGEN(j)  (2304 + 64 * (j))
#define XB_TOP      3328
#define XB_TOPGEN   3392
#define XCD_BAR_WORDS 3456
#define XB_SPIN_CAP (1u << 18)

__device__ __forceinline__ unsigned xb_ld(unsigned* p)              { return __hip_atomic_load(p, __ATOMIC_RELAXED, __HIP_MEMORY_SCOPE_AGENT); }
__device__ __forceinline__ unsigned xb_add(unsigned* p, unsigned v) { return __hip_atomic_fetch_add(p, v, __ATOMIC_RELAXED, __HIP_MEMORY_SCOPE_AGENT); }
__device__ __forceinline__ unsigned xb_xcc_id() { return (unsigned)__builtin_amdgcn_s_getreg((3 << 11) | 20) & 0xFu; }
#define XB_SPIN(cond, bar) do { unsigned _sp = 0; while (cond) { __builtin_amdgcn_s_sleep(1); \
    if ((++_sp & 255u) == 0u) { if (xb_ld(&(bar)[XB_TMO])) break; if (_sp > XB_SPIN_CAP) { atomicAdd(&(bar)[XB_TMO], 1u); break; } } } } while (0)

struct XcdBarrier {
    unsigned* bar; unsigned x;
    volatile LAS unsigned* st;
};

__device__ __forceinline__ XcdBarrier xcd_barrier_post(unsigned* bar, volatile LAS unsigned* st) {
    XcdBarrier b; b.bar = bar; b.x = xb_xcc_id(); b.st = st;
    if (threadIdx.x == 0) (void)xb_add(&bar[XB_XCNT(b.x)], 1u);
    return b;
}
__device__ __forceinline__ void xcd_barrier_complete(unsigned* bar, unsigned x, unsigned& nloc, unsigned& nx) {
    const unsigned G = gridDim.x * gridDim.y * gridDim.z;
    unsigned sum, cnt, mine, sp = 0u;
    for (;;) {
        sum = 0u; cnt = 0u; mine = 0u;
#pragma unroll
        for (unsigned j = 0; j < 16; ++j) { const unsigned c = xb_ld(&bar[XB_XCNT(j)]); sum += c; cnt += (c > 0u) ? 1u : 0u; mine = (j == x) ? c : mine; }
        if (sum == G) break;
        __builtin_amdgcn_s_sleep(1);
        if ((++sp & 255u) == 0u) { if (xb_ld(&bar[XB_TMO])) break; if (sp > XB_SPIN_CAP) { atomicAdd(&bar[XB_TMO], 1u); break; } }
    }
    nloc = mine > 0u ? mine : 1u; nx = cnt > 0u ? cnt : 1u;
}

__device__ __forceinline__ void xcd_barrier(const XcdBarrier& b) {
    asm volatile("s_waitcnt vmcnt(0)" ::: "memory");
    __syncthreads();
    if (threadIdx.x == 0) {
        unsigned* bar = b.bar;
        __builtin_amdgcn_s_waitcnt(0);
        unsigned nloc = b.st[0], nx = b.st[1];
        if (nloc == 0u) { xcd_barrier_complete(bar, b.x, nloc, nx); b.st[0] = nloc; b.st[1] = nx; }
        const unsigned old = xb_add(&bar[XB_XSUB(b.x)], 1u);
        const unsigned gen = old / nloc;
        if (old + 1u == (gen + 1u) * nloc) {
            __builtin_amdgcn_fence(__ATOMIC_RELEASE, "agent");
            asm volatile("s_waitcnt vmcnt(0)" ::: "memory");
            const unsigned og = xb_add(&bar[XB_TOP], 1u);
            const unsigned tg = og / nx;
            if (og + 1u == (tg + 1u) * nx) xb_add(&bar[XB_TOPGEN], 1u);
            else XB_SPIN(xb_ld(&bar[XB_TOPGEN]) == tg, bar);
            __builtin_amdgcn_fence(__ATOMIC_ACQUIRE, "agent");
            xb_add(&bar[XB_XGEN(b.x)], 1u);
            asm volatile("s_waitcnt vmcnt(0)" ::: "memory");
        } else {
            XB_SPIN(xb_ld(&bar[XB_XGEN(b.x)]) == gen, bar);
            __builtin_amdgcn_fence(__ATOMIC_ACQUIRE, "agent");
            asm volatile("s_waitcnt vmcnt(0)" ::: "memory");
        }
    }
    __syncthreads();
}


struct TDesc { const float* src; bf16* dst; const float* gain; int ldw, col0, ncol32, kgrp, ngrp, dst_ld, dst_rpg, mode, F, row_off; float scale; int item0, nitem, f8, pad; };
constexpr int NDESC = SIDEJOB ? 10 : 12;

__device__ __forceinline__ void tdesc_set(LAS TDesc* t, int& run, const float* src, bf16* dst, const float* gain, int ldw, int col0, int ncols, int kgrp, int ngrp, int dst_ld, int dst_rpg, int mode, int F, int row_off, float scale, int f8 = 0) {
    t->f8 = f8; t->pad = 0;
    t->src = src; t->dst = dst; t->gain = gain; t->ldw = ldw; t->col0 = col0; t->ncol32 = ncols / 32; t->kgrp = kgrp; t->ngrp = ngrp; t->dst_ld = dst_ld; t->dst_rpg = dst_rpg; t->mode = mode; t->F = F; t->row_off = row_off; t->scale = scale;
    t->item0 = run; t->nitem = (kgrp * ngrp / 64) * (ncols / 32); run += t->nitem;
}
__device__ __forceinline__ void titem_load(const LAS TDesc* t, int it, int lane, f32x4 (&v)[8]) {
    const int ncol32 = t->ncol32, kb = it / ncol32, nb = it - kb * ncol32;
    const float* src = t->src + (size_t)(kb * 64) * t->ldw + t->col0 + nb * 32;
    const int kr = lane >> 3, c4 = lane & 7;
#pragma unroll
    for (int i = 0; i < 8; ++i) v[i] = *(const f32x4*)(src + (size_t)(8 * i + kr) * t->ldw + 4 * c4);
}
__device__ __forceinline__ void titem_store(const LAS TDesc* t, int it, LAS float* scr, int lane, const f32x4 (&v)[8]) {
    const int ncol32 = t->ncol32, kb = it / ncol32, nb = it - kb * ncol32;
    const int k0g = kb * 64, grp = k0g / t->kgrp, k0 = k0g - grp * t->kgrp, nrel0 = nb * 32;
    const int kr = lane >> 3, c4 = lane & 7;
    const float* gp = t->gain; const float sc = t->scale;
#pragma unroll
    for (int i = 0; i < 8; ++i) { const int kk = 8 * i + kr; const float gsc = gp ? gp[k0 + kk] * sc : sc;
        LAS float* d = scr + kk * 33 + 4 * c4; d[0] = v[i][0] * gsc; d[1] = v[i][1] * gsc; d[2] = v[i][2] * gsc; d[3] = v[i][3] * gsc; }
    LDS_WAIT(); asm volatile("" ::: "memory");
    const int c = lane & 7;
#pragma unroll
    for (int j = 0; j < 4; ++j) { const int n = (lane >> 3) + 8 * j; const LAS float* s = scr + (8 * c) * 33 + n;
        const int nrel = nrel0 + n; int drow;
        if (t->mode == 0) drow = nrel;
        else { const int F = t->F, uu = nrel >= F ? 1 : 0, j2 = nrel - uu * F, jl = j2 & 127;
            drow = 256 * (j2 >> 7) + 128 * ((jl >> 2) & 1) + 32 * (jl >> 5) + 16 * uu + 4 * ((jl >> 3) & 3) + (jl & 3); }
        drow += grp * t->dst_rpg + t->row_off;
        if (t->f8) { v2u o; o.x = pg8::pk4_fp8(s[0 * 33], s[1 * 33], s[2 * 33], s[3 * 33]); o.y = pg8::pk4_fp8(s[4 * 33], s[5 * 33], s[6 * 33], s[7 * 33]); *(v2u*)((unsigned char*)t->dst + (size_t)drow * t->dst_ld + k0 + 8 * c) = o; }
        else { v4u o; o.x = pk2(s[0 * 33], s[1 * 33]); o.y = pk2(s[2 * 33], s[3 * 33]); o.z = pk2(s[4 * 33], s[5 * 33]); o.w = pk2(s[6 * 33], s[7 * 33]); *(v4u*)(t->dst + (size_t)drow * t->dst_ld + k0 + 8 * c) = o; } }
    LDS_WAIT(); asm volatile("" ::: "memory");
}
__device__ __forceinline__ void sincos_d(double x, double& s, double& c) {
    const double n = __builtin_rint(x * 0.63661977236758134308);
    double r = __builtin_fma(-n, 1.57079632679489655800e+00, x); r = __builtin_fma(-n, 6.12323399573676603587e-17, r);
    const double r2 = r * r;
    double sp = -1.0 / 1307674368000.0; sp = sp * r2 + 1.0 / 6227020800.0; sp = sp * r2 - 1.0 / 39916800.0; sp = sp * r2 + 1.0 / 362880.0; sp = sp * r2 - 1.0 / 5040.0; sp = sp * r2 + 1.0 / 120.0; sp = sp * r2 - 1.0 / 6.0; sp = sp * r2 + 1.0;
    const double sr = sp * r;
    double cp = 1.0 / 20922789888000.0; cp = cp * r2 - 1.0 / 87178291200.0; cp = cp * r2 + 1.0 / 479001600.0; cp = cp * r2 - 1.0 / 3628800.0; cp = cp * r2 + 1.0 / 40320.0; cp = cp * r2 - 1.0 / 720.0; cp = cp * r2 + 1.0 / 24.0; cp = cp * r2 - 0.5; cp = cp * r2 + 1.0;
    const int q = ((int)n) & 3;
    s = (q == 0) ? sr : (q == 1) ? cp : (q == 2) ? -sr : -cp;
    c = (q == 0) ? cp : (q == 1) ? -sr : (q == 2) ? -cp : sr;
}
__device__ __forceinline__ double inv_freq_d(int i) {
    switch (i) { case 0: return 1.0; case 1: return 0.44036660267178046; case 2: return 0.19392274474868576; case 3: return 0.085397100285765609; case 4: return 0.037606030930863933;
        case 5: return 0.016560440080994446; case 6: return 0.0072926647372171093; case 7: return 0.0032114459947525909; case 8: return 0.001414213562373095; case 9: return 0.00062277242191459599;
        case 10: return 0.0002742481756762073; case 11: return 0.00012076973741146504; case 12: return 5.3182958969449883e-05; case 13: return 2.3419998961409342e-05; case 14: return 1.031338537721246e-05; default: return 4.5416704806078695e-06; }
}
__device__ __forceinline__ void load_row(const float* row, int lane, f32x4 (&v)[4]) {
    const f32x4* xr = (const f32x4*)row + lane;
#pragma unroll
    for (int j = 0; j < 4; ++j) v[j] = xr[64 * j];
}
__device__ __forceinline__ float row_sumsq(const f32x4 (&v)[4]) {
    float s = 0.f;
#pragma unroll
    for (int j = 0; j < 4; ++j) s += (v[j][0] * v[j][0] + v[j][1] * v[j][1]) + (v[j][2] * v[j][2] + v[j][3] * v[j][3]);
    return wave_sum(s);
}
__device__ __forceinline__ void store_row_bf16(bf16* orow, int lane, const f32x4 (&v)[4], float sc) {
    v2u* o8 = (v2u*)orow + lane;
#pragma unroll
    for (int j = 0; j < 4; ++j) { v2u w; w.x = pk2(v[j][0] * sc, v[j][1] * sc); w.y = pk2(v[j][2] * sc, v[j][3] * sc); o8[64 * j] = w; }
}

__device__ __forceinline__ void store_row_fp8(unsigned char* orow, int lane, const f32x4 (&v)[4], float sc) {
    unsigned* o4 = (unsigned*)orow + lane;
#pragma unroll
    for (int j = 0; j < 4; ++j) o4[64 * j] = pg8::pk4_fp8(v[j][0] * sc, v[j][1] * sc, v[j][2] * sc, v[j][3] * sc);
}

constexpr int ML_QS = 0, ML_KS = 17408, ML_KWT = 34816, ML_VT = 53248, ML_SBF = 62464, ML_DD = 79872, ML_MM = 80128, ML_BC = 80384, ML_NV = 80640, ML_END = 81664;
constexpr int ML_SCR = 81920, ML_TD = 150016;
__device__ __forceinline__ void mlstm_phase(LAS unsigned char* lds, const bf16* QKO, const bf16* KVT, const float* GATES, const float* b_if, bf16* Hout, int vcu, int G, int tid) {
    const LAS TDesc* td2 = (const LAS TDesc*)(lds + ML_TD); const int nitems2 = td2[1].item0 + td2[1].nitem;
    LAS float* scr = (LAS float*)(lds + ML_SCR + (tid >> 6) * 8448); int itw = vcu * 8 + (tid >> 6);
    const int lane = tid & 63, w = __builtin_amdgcn_readfirstlane(tid >> 6), l15 = lane & 15, g = lane >> 4;
    const int tt = w & 3, vh = w >> 2;
    for (int unit = vcu; unit < 256; unit += G) {
        const int bh = unit >> 2, vs = unit & 3, b = bh >> 2, h = bh & 3;
        const size_t tok0 = (size_t)b * SEQ;
        const float bi = b_if[h], bfg = b_if[4 + h];
        f32x4 accS[4];
#pragma unroll
        for (int j = 0; j < 4; ++j) accS[j] = (f32x4){0.f, 0.f, 0.f, 0.f};
        float m_s = 0.f;
        for (int i = tid; i < 17408 / 16; i += 512) *(LAS v4u*)(lds + ML_SBF + i * 16) = (v4u){0u, 0u, 0u, 0u};
        if (tid < 256) *(LAS float*)(lds + ML_NV + tid * 4) = 0.f;
        v4u rq[2], rk[2], rt[2], rv; float gi, gf;
#define ML_LOADS(c_) do { const size_t t0_ = tok0 + (size_t)(c_) * CH; \
        _Pragma("unroll") for (int i_ = 0; i_ < 2; ++i_) { const int p_ = tid + 512 * i_; const int r_ = p_ >> 4, cp_ = p_ & 15; const bf16* s_ = QKO + (t0_ + r_) * 2048 + h * 128 + cp_ * 8; rq[i_] = *(const v4u*)s_; rk[i_] = *(const v4u*)(s_ + 1536); \
            const int kk_ = p_ >> 3, sg_ = p_ & 7; rt[i_] = *(const v4u*)(KVT + (size_t)(h * 128 + kk_) * NTOK + t0_ + 8 * sg_); } \
        rv = *(const v4u*)(KVT + (size_t)(512 + h * 256 + vs * 64 + (tid >> 3)) * NTOK + t0_ + 8 * (tid & 7)); \
        gi = GATES[(t0_ + lane) * 8 + h]; gf = GATES[(t0_ + lane) * 8 + 4 + h]; } while (0)
        ML_LOADS(0);
        for (int c = 0; c < NCH; ++c) {
            const size_t t0 = tok0 + (size_t)c * CH;
            const float igv = gi + bi, xf = gf + bfg;
            const float lgf = fminf(xf, 0.f) - log1pf(__expf(-fabsf(xf)));
            float bc = lgf;
#pragma unroll
            for (int o = 1; o < 64; o <<= 1) { const float t = __shfl_up(bc, o); if (lane >= o) bc += t; }
            const float dd = igv - bc;
            float pm = dd;
#pragma unroll
            for (int o = 1; o < 64; o <<= 1) { const float t = __shfl_up(pm, o); if (lane >= o) pm = fmaxf(pm, t); }
            const float mm = fmaxf(m_s, pm);
            const float g_tot = __shfl(bc, 63), mm63 = __shfl(mm, 63);
            const float wgt = __expf(dd - mm63), decay = __expf(m_s - mm63);
            if (w == 0) { *(LAS float*)(lds + ML_DD + lane * 4) = dd; *(LAS float*)(lds + ML_MM + lane * 4) = mm; *(LAS float*)(lds + ML_BC + lane * 4) = bc; }
            {
                float wv[8];
#pragma unroll
                for (int e = 0; e < 8; ++e) wv[e] = __shfl(wgt, 8 * (tid & 7) + e);
#pragma unroll
                for (int i = 0; i < 2; ++i) { const int p = tid + 512 * i; const int r = p >> 4, cp = p & 15;
                    *(LAS v4u*)(lds + ML_QS + r * 272 + cp * 16) = rq[i]; *(LAS v4u*)(lds + ML_KS + r * 272 + cp * 16) = rk[i];
                    const int kk = p >> 3, sg = p & 7; v4u o;
                    o.x = pk2(bflo(rt[i].x) * wv[0], bfhi(rt[i].x) * wv[1]); o.y = pk2(bflo(rt[i].y) * wv[2], bfhi(rt[i].y) * wv[3]);
                    o.z = pk2(bflo(rt[i].z) * wv[4], bfhi(rt[i].z) * wv[5]); o.w = pk2(bflo(rt[i].w) * wv[6], bfhi(rt[i].w) * wv[7]);
                    *(LAS v4u*)(lds + ML_KWT + kk * 144 + sg * 16) = o; }
                *(LAS v4u*)(lds + ML_VT + (tid >> 3) * 144 + (tid & 7) * 16) = rv;
            }
            __syncthreads();
            if (c + 1 < NCH) ML_LOADS(c + 1);
            const int it2 = itw; itw += G * 8; const bool has2 = SIDEJOB && it2 < nitems2; const int d2 = (has2 && it2 >= td2[1].item0) ? 1 : 0;
            f32x4 tv[8]; if (has2) titem_load(td2 + d2, it2 - td2[d2].item0, lane, tv);
            const int cur = c & 1;
            const int t_loc = 16 * tt + l15;
            bf16x8 qf[4];
#pragma unroll
            for (int kp = 0; kp < 4; ++kp) qf[kp] = *(const LAS bf16x8*)(lds + ML_QS + t_loc * 272 + (32 * kp + 8 * g) * 2);
            const float mmt = *(const LAS float*)(lds + ML_MM + t_loc * 4), bct = *(const LAS float*)(lds + ML_BC + t_loc * 4);
            f32x4 P[4]; float psum = 0.f;
#pragma unroll
            for (int i = 0; i < 4; ++i) {
                P[i] = (f32x4){0.f, 0.f, 0.f, 0.f};
                if (i <= tt) {
                    f32x4 a = (f32x4){0.f, 0.f, 0.f, 0.f};
#pragma unroll
                    for (int kp = 0; kp < 4; ++kp) { const bf16x8 kf = *(const LAS bf16x8*)(lds + ML_KS + (16 * i + l15) * 272 + (32 * kp + 8 * g) * 2); a = MFMA16(kf, qf[kp], a); }
                    const f32x4 ddv = *(const LAS f32x4*)(lds + ML_DD + (16 * i + 4 * g) * 4);
#pragma unroll
                    for (int r = 0; r < 4; ++r) { const int s = 16 * i + 4 * g + r; const float pv = (s <= t_loc) ? a[r] * __expf(ddv[r] - mmt) : 0.f; P[i][r] = pv; psum += pv; }
                }
            }
            psum += __shfl_xor(psum, 16); psum += __shfl_xor(psum, 32);
            bf16x8 pf[2];
#pragma unroll
            for (int kp = 0; kp < 2; ++kp) { v4u o; o.x = pk2(P[2 * kp][0], P[2 * kp][1]); o.y = pk2(P[2 * kp][2], P[2 * kp][3]); o.z = pk2(P[2 * kp + 1][0], P[2 * kp + 1][1]); o.w = pk2(P[2 * kp + 1][2], P[2 * kp + 1][3]);
                pf[kp] = __builtin_bit_cast(bf16x8, o); }
            float nqp = 0.f;
#pragma unroll
            for (int kp = 0; kp < 4; ++kp) { const v4u qw = __builtin_bit_cast(v4u, qf[kp]); const LAS float* nv = (const LAS float*)(lds + ML_NV + cur * 512) + 32 * kp + 8 * g;
                const f32x4 n0 = *(const LAS f32x4*)nv, n1 = *(const LAS f32x4*)(nv + 4);
                nqp += bflo(qw.x) * n0[0] + bfhi(qw.x) * n0[1] + bflo(qw.y) * n0[2] + bfhi(qw.y) * n0[3] + bflo(qw.z) * n1[0] + bfhi(qw.z) * n1[1] + bflo(qw.w) * n1[2] + bfhi(qw.w) * n1[3]; }
            nqp += __shfl_xor(nqp, 16); nqp += __shfl_xor(nqp, 32);
            const float iw = __expf(m_s - mmt);
            const float nq = psum + iw * nqp;
            const float den = fmaxf(fabsf(nq), __expf(-(bct + mmt)));
            const float rden = 1.0f / den;
#pragma unroll
            for (int j = 0; j < 2; ++j) {
                const int v_loc = 32 * vh + 16 * j + l15;
                f32x4 ao = (f32x4){0.f, 0.f, 0.f, 0.f}, ai = (f32x4){0.f, 0.f, 0.f, 0.f};
#pragma unroll
                for (int kp = 0; kp < 2; ++kp) if (2 * kp <= tt) {
                    const v2u lo = *(const LAS v2u*)(lds + ML_VT + v_loc * 144 + (32 * kp + 4 * g) * 2), hi = *(const LAS v2u*)(lds + ML_VT + v_loc * 144 + (32 * kp + 16 + 4 * g) * 2);
                    const v4u vv = (v4u){lo.x, lo.y, hi.x, hi.y};
                    ao = MFMA16(__builtin_bit_cast(bf16x8, vv), pf[kp], ao); }
#pragma unroll
                for (int kp = 0; kp < 4; ++kp) { const bf16x8 sf = *(const LAS bf16x8*)(lds + ML_SBF + v_loc * 272 + (32 * kp + 8 * g) * 2); ai = MFMA16(sf, qf[kp], ai); }
                v2u o; o.x = pk2((ao[0] + iw * ai[0]) * rden, (ao[1] + iw * ai[1]) * rden); o.y = pk2((ao[2] + iw * ai[2]) * rden, (ao[3] + iw * ai[3]) * rden);
                *(v2u*)(Hout + (t0 + t_loc) * 1024 + h * 256 + vs * 64 + 32 * vh + 16 * j + 4 * g) = o;
            }
            {
                bf16x8 kf[2];
#pragma unroll
                for (int kp = 0; kp < 2; ++kp) kf[kp] = *(const LAS bf16x8*)(lds + ML_KWT + (16 * w + l15) * 144 + (32 * kp + 8 * g) * 2);
#pragma unroll
                for (int jv = 0; jv < 4; ++jv) { accS[jv] = accS[jv] * decay;
#pragma unroll
                    for (int kp = 0; kp < 2; ++kp) { const bf16x8 vf = *(const LAS bf16x8*)(lds + ML_VT + (16 * jv + l15) * 144 + (32 * kp + 8 * g) * 2); accS[jv] = MFMA16(kf[kp], vf, accS[jv]); } }
            }
            if (tid < 128) { float s = 0.f;
#pragma unroll
                for (int i = 0; i < 8; ++i) { const v4u x = *(const LAS v4u*)(lds + ML_KWT + tid * 144 + i * 16); s += (bflo(x.x) + bfhi(x.x)) + (bflo(x.y) + bfhi(x.y)) + (bflo(x.z) + bfhi(x.z)) + (bflo(x.w) + bfhi(x.w)); }
                const float nold = *(const LAS float*)(lds + ML_NV + cur * 512 + tid * 4);
                *(LAS float*)(lds + ML_NV + (cur ^ 1) * 512 + tid * 4) = decay * nold + s; }
            __syncthreads();
#pragma unroll
            for (int jv = 0; jv < 4; ++jv) { v2u o; o.x = pk2(accS[jv][0], accS[jv][1]); o.y = pk2(accS[jv][2], accS[jv][3]);
                *(LAS v2u*)(lds + ML_SBF + (16 * jv + l15) * 272 + (16 * w + 4 * g) * 2) = o; }
            if (has2) titem_store(td2 + d2, it2 - td2[d2].item0, scr, lane, tv);
            m_s = g_tot + mm63;
        }
        __syncthreads();
#undef ML_LOADS
    }
}

constexpr int AT_K0 = 0, AT_V0 = 34816, AT_KM = 71680, AT_END = 75776;
__device__ __forceinline__ void moba_phase(LAS unsigned char* lds, const bf16* Qb, const bf16* Kb, const bf16* VT, const float* KM, bf16* ATT, int vcu, int G, int tid) {
    const int lane = tid & 63, w = __builtin_amdgcn_readfirstlane(tid >> 6), l15 = lane & 15, g = lane >> 4;
    constexpr float SC2 = 0.08838834764831845f * 1.4426950408889634f;
    const float NEG = -__builtin_inff();
    for (int item = vcu; item < 512; item += G) {
        const int bh = item >> 2, pr = item & 3, b = bh >> 3, h = bh & 7, kvh = h >> 2;
        for (int half = 0; half < 2; ++half) {
            const int qb = half ? pr : 7 - pr;
            const size_t row0 = (size_t)b * SEQ + 256 * qb + 32 * w;
            bf16x8 qf[2][4];
#pragma unroll
            for (int u = 0; u < 2; ++u)
#pragma unroll
                for (int kp = 0; kp < 4; ++kp) qf[u][kp] = *(const bf16x8*)(Qb + (row0 + 16 * u + l15) * 1024 + h * 128 + 32 * kp + 8 * g);
            for (int i = tid; i < 1024; i += 512) { const int n = i >> 7, d = i & 127; *(LAS float*)(lds + AT_KM + i * 4) = KM[(size_t)(b * 8 + n) * 256 + kvh * 128 + d] * (1.0f / 256.0f); }
            const int ntile = 4 * (qb + 1);
            v4u rk[2], rv[2];
#define AT_LOADS(j_) do { const int n_ = (j_) >> 2, kt_ = (j_) & 3; const size_t key0_ = (size_t)b * SEQ + 256 * n_ + 64 * kt_; \
            _Pragma("unroll") for (int i_ = 0; i_ < 2; ++i_) { const int p_ = tid + 512 * i_; rk[i_] = *(const v4u*)(Kb + (key0_ + (p_ >> 4)) * 256 + kvh * 128 + 8 * (p_ & 15)); \
                rv[i_] = *(const v4u*)(VT + (size_t)(kvh * 128 + (p_ >> 3)) * NTOK + key0_ + 8 * (p_ & 7)); } } while (0)
#define AT_STAGE(buf_) do { _Pragma("unroll") for (int i_ = 0; i_ < 2; ++i_) { const int p_ = tid + 512 * i_; \
                *(LAS v4u*)(lds + AT_K0 + (buf_) * 17408 + (p_ >> 4) * 272 + (p_ & 15) * 16) = rk[i_]; \
                const int sg_ = p_ & 7, vo_ = (p_ >> 3) * 144 + (sg_ >> 2) * 64 + (sg_ & 1) * 32 + ((sg_ >> 1) & 1) * 8;     \
                *(LAS v2u*)(lds + AT_V0 + (buf_) * 18432 + vo_) = (v2u){rv[i_].x, rv[i_].y}; *(LAS v2u*)(lds + AT_V0 + (buf_) * 18432 + vo_ + 16) = (v2u){rv[i_].z, rv[i_].w}; } } while (0)
            AT_LOADS(0);
            __syncthreads();
            AT_STAGE(0);
            __syncthreads();
            unsigned sel[2];
#pragma unroll
            for (int u = 0; u < 2; ++u) {
                float gate[7];
#pragma unroll
                for (int n = 0; n < 7; ++n) { gate[n] = NEG;
                    if (n < qb) { float s = 0.f;
#pragma unroll
                        for (int kp = 0; kp < 4; ++kp) { const v4u qw = __builtin_bit_cast(v4u, qf[u][kp]); const LAS float* kmp = (const LAS float*)(lds + AT_KM) + n * 128 + 32 * kp + 8 * g;
                            const f32x4 k0 = *(const LAS f32x4*)kmp, k1 = *(const LAS f32x4*)(kmp + 4);
                            s += bflo(qw.x) * k0[0] + bfhi(qw.x) * k0[1] + bflo(qw.y) * k0[2] + bfhi(qw.y) * k0[3] + bflo(qw.z) * k1[0] + bfhi(qw.z) * k1[1] + bflo(qw.w) * k1[2] + bfhi(qw.w) * k1[3]; }
                        s += __shfl_xor(s, 16); s += __shfl_xor(s, 32); gate[n] = s; } }
                unsigned sm = 0u;
                if (qb <= 3) sm = (1u << qb) - 1u;
                else {
#pragma unroll
                    for (int rnd = 0; rnd < 3; ++rnd) { float bv = NEG; int bi = 0;
#pragma unroll
                        for (int n = 0; n < 7; ++n) { const bool ok = (n < qb) && !((sm >> n) & 1u) && (gate[n] > bv); bv = ok ? gate[n] : bv; bi = ok ? n : bi; }
                        sm |= 1u << bi; }
                }
                sel[u] = sm;
            }
            f32x4 accO[2][8]; float m_run[2], l_run[2];
#pragma unroll
            for (int u = 0; u < 2; ++u) { m_run[u] = -1e30f; l_run[u] = 0.f;
#pragma unroll
                for (int jd = 0; jd < 8; ++jd) accO[u][jd] = (f32x4){0.f, 0.f, 0.f, 0.f}; }
            for (int j = 0; j < ntile; ++j) {
                if (j + 1 < ntile) AT_LOADS(j + 1);
                const int buf = j & 1, n = j >> 2, kt = j & 3; const bool own = (n == qb);
                const bool active = !own || (64 * kt <= 32 * w + 31);
                if (active) {
                    const LAS unsigned char* kb = lds + AT_K0 + buf * 17408; const LAS unsigned char* vb = lds + AT_V0 + buf * 18432;
                    f32x4 S[2][4];
#pragma unroll
                    for (int i = 0; i < 4; ++i) { bf16x8 kf[4];
#pragma unroll
                        for (int kp = 0; kp < 4; ++kp) kf[kp] = *(const LAS bf16x8*)(kb + (16 * i + l15) * 272 + (32 * kp + 8 * g) * 2);
#pragma unroll
                        for (int u = 0; u < 2; ++u) { f32x4 a = (f32x4){0.f, 0.f, 0.f, 0.f};
#pragma unroll
                            for (int kp = 0; kp < 4; ++kp) a = MFMA16(kf[kp], qf[u][kp], a);
                            S[u][i] = a; } }
                    bf16x8 pf[2][2];
#pragma unroll
                    for (int u = 0; u < 2; ++u) {
                        const bool allowed = own || ((sel[u] >> n) & 1u);
                        if (own && (64 * kt + 63 > 32 * w + 16 * u)) {
                            const int qpos = 32 * w + 16 * u + l15;
#pragma unroll
                            for (int i = 0; i < 4; ++i)
#pragma unroll
                                for (int r = 0; r < 4; ++r) { const int kpos = 64 * kt + 16 * i + 4 * g + r; S[u][i][r] = (kpos <= qpos) ? S[u][i][r] : NEG; }
                        }
                        float mx = fmaxf(fmaxf(S[u][0][0], S[u][0][1]), fmaxf(S[u][0][2], S[u][0][3]));
#pragma unroll
                        for (int i = 1; i < 4; ++i) mx = fmaxf(mx, fmaxf(fmaxf(S[u][i][0], S[u][i][1]), fmaxf(S[u][i][2], S[u][i][3])));
                        mx = fmaxf(mx, __shfl_xor(mx, 16)); mx = fmaxf(mx, __shfl_xor(mx, 32));
                        mx = allowed ? mx : NEG;
                        if (__any((mx - m_run[u]) * SC2 > 8.f)) {
                            const float mn = fmaxf(m_run[u], mx);
                            const float alpha = __builtin_amdgcn_exp2f((m_run[u] - mn) * SC2);
                            m_run[u] = mn; l_run[u] *= alpha;
#pragma unroll
                            for (int jd = 0; jd < 8; ++jd) accO[u][jd] = accO[u][jd] * alpha;
                        }
                        const float mb = allowed ? m_run[u] * SC2 : __builtin_inff(); float ps = 0.f;
#pragma unroll
                        for (int i = 0; i < 4; ++i)
#pragma unroll
                            for (int r = 0; r < 4; ++r) { const float p = __builtin_amdgcn_exp2f(S[u][i][r] * SC2 - mb); S[u][i][r] = p; ps += p; }
                        ps += __shfl_xor(ps, 16); ps += __shfl_xor(ps, 32);
                        l_run[u] += ps;
#pragma unroll
                        for (int kp = 0; kp < 2; ++kp) { v4u o; o.x = pk2(S[u][2 * kp][0], S[u][2 * kp][1]); o.y = pk2(S[u][2 * kp][2], S[u][2 * kp][3]); o.z = pk2(S[u][2 * kp + 1][0], S[u][2 * kp + 1][1]); o.w = pk2(S[u][2 * kp + 1][2], S[u][2 * kp + 1][3]);
                            pf[u][kp] = __builtin_bit_cast(bf16x8, o); }
                    }
#pragma unroll
                    for (int jd = 0; jd < 8; ++jd)
#pragma unroll
                        for (int kp = 0; kp < 2; ++kp) {
                            const bf16x8 vf = *(const LAS bf16x8*)(vb + (16 * jd + l15) * 144 + kp * 64 + g * 16);
                            accO[0][jd] = MFMA16(vf, pf[0][kp], accO[0][jd]); accO[1][jd] = MFMA16(vf, pf[1][kp], accO[1][jd]); }
                }
                if (j + 1 < ntile) AT_STAGE(buf ^ 1);
                __syncthreads();
            }
#pragma unroll
            for (int u = 0; u < 2; ++u) { const float rl = 1.0f / l_run[u]; bf16* orow = ATT + (row0 + 16 * u + l15) * 1024 + h * 128 + 4 * g;
#pragma unroll
                for (int jd = 0; jd < 8; ++jd) { v2u o; o.x = pk2(accO[u][jd][0] * rl, accO[u][jd][1] * rl); o.y = pk2(accO[u][jd][2] * rl, accO[u][jd][3] * rl); *(v2u*)(orow + 16 * jd) = o; } }
#undef AT_LOADS
#undef AT_STAGE
        }
    }
}

struct Args { const float* in[18]; float* out; unsigned char* ws; int ph_lo, ph_hi, bar_region, pad; };
__global__ void __launch_bounds__(NWAVES * 64, 2) yoco_fwd(Args args) {
    extern __shared__ __attribute__((aligned(16))) unsigned char lds_raw[];
    LAS unsigned char* lds = (LAS unsigned char*)lds_raw;
    volatile LAS unsigned* MISC = (volatile LAS unsigned*)(lds + MISC_OFF);
    const int tid = threadIdx.x, lane = tid & 63, wave = __builtin_amdgcn_readfirstlane(tid >> 6);
    const int G = gridDim.x; const int bx = blockIdx.x; const int vcu = (G % 8 == 0) ? (bx % 8) * (G / 8) + bx / 8 : bx;
    const int gw = vcu * NWAVES + wave, NGW = G * NWAVES;
    unsigned char* ws = args.ws;
    gu32* ctl = (gu32*)(ws + WS_CTL);
    const float* x_in = args.in[0]; const float* mlstm_norm = args.in[1]; const float* mlstm_w_in = args.in[2]; const float* mlstm_b_if = args.in[3]; const float* mlstm_out_norm = args.in[4];
    const float* mlstm_w_out = args.in[5]; const float* ffn_norm = args.in[6]; const float* dense_w_gu = args.in[7]; const float* dense_w_down = args.in[8]; const float* moe_router = args.in[9];
    const float* moe_w_gu = args.in[10]; const float* moe_w_down = args.in[11]; const float* kv_norm = args.in[12]; const float* kv_w = args.in[13]; const float* moba_norm = args.in[14];
    const float* moba_w_q = args.in[15]; const float* moba_w_o = args.in[16]; const float* final_norm = args.in[17];
    float* X = args.out;
    bf16* Win_t = (bf16*)(ws + WS_WIN); bf16* Wout_t = (bf16*)(ws + WS_WOUT); bf16* Wgu_t = (bf16*)(ws + WS_WGU); bf16* Wdn_t = (bf16*)(ws + WS_WDN);
    bf16* Wqkv_t = (bf16*)(ws + WS_WQKV); bf16* Wo_t = (bf16*)(ws + WS_WO); bf16* Wmgu_t = (bf16*)(ws + WS_WMGU); bf16* Wmdn_t = (bf16*)(ws + WS_WMDN);
    bf16* XN = (bf16*)(ws + WS_A); bf16* XB = (bf16*)(ws + WS_A + 64 * MiB); float* PART = (float*)(ws + WS_PART); float* RS = (float*)(ws + WS_RS); float* MS = (float*)(ws + WS_MS); bf16* APERM = (bf16*)(ws + WS_A); bf16* Y = (bf16*)(ws + WS_A);
    bf16* QKO = (bf16*)(ws + WS_QKO); bf16* KVT = (bf16*)(ws + WS_KVT); bf16* Hb = (bf16*)(ws + WS_H); bf16* ACT = (bf16*)(ws + WS_ACT);
    bf16* Qb = (bf16*)(ws + WS_Q); bf16* Kb = (bf16*)(ws + WS_K); bf16* VTb = (bf16*)(ws + WS_VT); bf16* ATT = (bf16*)(ws + WS_ATT); bf16* ACT2 = (bf16*)(ws + WS_ACT2); bf16* Y2 = (bf16*)(ws + WS_Y2);
    float* KM = (float*)(ws + WS_KM); float* ROPE = (float*)(ws + WS_ROPE); float* GATES = (float*)(ws + WS_GATES);
    unsigned* ME = (unsigned*)(ws + WS_ME); float* MW = (float*)(ws + WS_MW); unsigned* MR = (unsigned*)(ws + WS_MR); unsigned* MP = (unsigned*)(ws + WS_MP);
    unsigned* HIST = (unsigned*)(ws + WS_HIST); unsigned* PB = (unsigned*)(ws + WS_PB);

    for (int u = tid; u < (LDS_BYTES - LDSCTL_OFF) / 4; u += NWAVES * 64) ((LAS unsigned*)(lds + LDSCTL_OFF))[u] = 0u;
    __syncthreads();
    unsigned* barw = (unsigned*)(ctl + CW_BAR) + args.bar_region * XCD_BAR_WORDS;
    XcdBarrier bar; bar.bar = barw; bar.x = 0; bar.st = nullptr;
    if (!MK_PER_PHASE) bar = xcd_barrier_post(barw, MISC + 8);
    const int lo = args.ph_lo, hi = args.ph_hi;
#define IN(k) (lo <= (k) && (k) < hi)
#define SEAM(k) do { if (IN(k) && IN((k) + 1)) { if (MK_PER_PHASE) { if (tid == 0) __hip_atomic_store(ctl, 0xBADBA0u, RLX_AGENT); } else xcd_barrier(bar); } } while (0)

    if (IN(0)) {
        LAS TDesc* td = (LAS TDesc*)(lds + 8 * 8448);
        if (tid == 0) { int run = 0;
            tdesc_set(td + 0, run, dense_w_gu, Wgu_t, ffn_norm, 5632, 0, 5632, 1024, 1, 1024, 0, 1, DFF, 0, DENSE_F8 ? WGU_SC : 1.f, DENSE_F8);
            tdesc_set(td + 1, run, dense_w_down, Wdn_t, nullptr, 1024, 0, 1024, DFF, 1, DFF, 0, 0, 0, 0, DOWN_F8 ? WDN_SC : 1.f, DOWN_F8);
            tdesc_set(td + 2, run, mlstm_w_in, Win_t, mlstm_norm, WIN_LD, 0, 512, 1024, 1, 1024, 0, 0, 0, 0, 0.08838834764831845f);
            tdesc_set(td + 3, run, mlstm_w_in, Win_t, mlstm_norm, WIN_LD, 512, 512, 1024, 1, 1024, 0, 0, 0, 1536, 1.f);
            tdesc_set(td + 4, run, mlstm_w_in, Win_t, mlstm_norm, WIN_LD, 1024, 1024, 1024, 1, 1024, 0, 0, 0, 2048, 1.f);
            tdesc_set(td + 5, run, mlstm_w_in, Win_t, mlstm_norm, WIN_LD, 2048, 1024, 1024, 1, 1024, 0, 0, 0, 512, 1.f);
            tdesc_set(td + 6, run, mlstm_w_out, Wout_t, nullptr, 1024, 0, 1024, 1024, 1, 1024, 0, 0, 0, 0, 1.f);
            tdesc_set(td + 7, run, moba_w_q, Wqkv_t, moba_norm, 1024, 0, 1024, 1024, 1, 1024, 0, 0, 0, 0, 1.f);
            tdesc_set(td + 8, run, kv_w, Wqkv_t, kv_norm, 512, 0, 512, 1024, 1, 1024, 0, 0, 0, 1024, 1.f);
            tdesc_set(td + 9, run, moba_w_o, Wo_t, nullptr, 1024, 0, 1024, 1024, 1, 1024, 0, 0, 0, 0, 1.f);
            if (!SIDEJOB) {
                tdesc_set(td + 10, run, moe_w_gu, Wmgu_t, ffn_norm + 1024, 7168, 0, 7168, 1024, 8, 1024, 7168, 1, DEXP, 0, MOE_F8 ? WGU_SC : 1.f, MOE_F8);
                tdesc_set(td + 11, run, moe_w_down, Wmdn_t, nullptr, 1024, 0, 1024, DEXP, 8, DEXP, 1024, 0, 0, 0, MOE_F8 ? WDN_SC : 1.f, MOE_F8); }
        }
        __syncthreads();
        const int nitems = td[NDESC - 1].item0 + td[NDESC - 1].nitem;
        LAS float* scr = (LAS float*)(lds + wave * 8448);
        {
            f32x4 va[8], vb[8]; int it = gw, da = 0, db = 0;
#define TD_FIND(it_, d_) do { d_ = 0; _Pragma("unroll") for (int q = 1; q < NDESC; ++q) d_ += ((it_) >= td[q].item0) ? 1 : 0; } while (0)
            if (it < nitems) { TD_FIND(it, da); titem_load(td + da, it - td[da].item0, lane, va); }
            while (it < nitems) {
                int nx = it + NGW;
                if (nx < nitems) { TD_FIND(nx, db); titem_load(td + db, nx - td[db].item0, lane, vb); }
                titem_store(td + da, it - td[da].item0, scr, lane, va);
                it = nx; if (it >= nitems) break;
                nx = it + NGW;
                if (nx < nitems) { TD_FIND(nx, da); titem_load(td + da, nx - td[da].item0, lane, va); }
                titem_store(td + db, it - td[db].item0, scr, lane, vb);
                it = nx;
            }
#undef TD_FIND
        }
        for (int i = vcu * 512 + tid; i < 2048 * 16; i += G * 512) { const int pos = i >> 4, fi = i & 15; double s, c; sincos_d((double)pos * inv_freq_d(fi), s, c); ROPE[pos * 32 + fi] = (float)c; ROPE[pos * 32 + 16 + fi] = (float)s; }
        {
            float wg[4][4][8];
#pragma unroll
            for (int j = 0; j < 4; ++j)
#pragma unroll
                for (int e = 0; e < 4; ++e) { const int k = 4 * lane + 256 * j + e; const float gk = mlstm_norm[k]; const f32x4 a = *(const f32x4*)(mlstm_w_in + (size_t)k * WIN_LD + 3072), bq = *(const f32x4*)(mlstm_w_in + (size_t)k * WIN_LD + 3076);
#pragma unroll
                    for (int c = 0; c < 4; ++c) { wg[j][e][c] = a[c] * gk; wg[j][e][4 + c] = bq[c] * gk; } }
            for (int m = gw; m < NTOK; m += NGW) {
                f32x4 v[4]; load_row(x_in + (size_t)m * DM, lane, v);
                const float rinv = 1.0f / sqrtf(row_sumsq(v) * (1.0f / DM) + EPS);
                store_row_bf16(XN + (size_t)m * DM, lane, v, rinv);
                float gs[8];
#pragma unroll
                for (int c = 0; c < 8; ++c) { float s = 0.f;
#pragma unroll
                    for (int j = 0; j < 4; ++j)
#pragma unroll
                        for (int e = 0; e < 4; ++e) s += v[j][e] * wg[j][e][c];
                    gs[c] = wave_sum(s) * rinv; }
                float mine = gs[0];
#pragma unroll
                for (int c = 1; c < 8; ++c) mine = (lane == c) ? gs[c] : mine;
                if (lane < 8) GATES[(size_t)m * 8 + lane] = mine;
            }
        }
    }
    SEAM(0);

    if (IN(1)) {
        { pg8::Gemm gm{XN, Win_t, NTOK, 2048, DM}; pg8::StaticOrder S; S.init(NTOK, 2048, G, bx); pg8::EpiStore E{QKO, 2048};
          pg8::gemm_phase<pg8::EpiStore, pg8::StaticOrder, true, true>(lds + RING_OFF, gm, S, E); }
        __syncthreads();
        { pg8::Gemm gm{Win_t + (size_t)1536 * DM, XN, 1536, NTOK, DM}; pg8::StaticOrder S; S.init(1536, NTOK, G, bx); pg8::EpiStore E{KVT, NTOK};
          pg8::gemm_phase<pg8::EpiStore, pg8::StaticOrder, true, true>(lds + RING_OFF, gm, S, E); }
    }
    SEAM(1);

    if (IN(2)) { __syncthreads();
        if (tid == 0) { LAS TDesc* td2 = (LAS TDesc*)(lds + ML_TD); int run = 0;
            tdesc_set(td2 + 0, run, moe_w_gu, Wmgu_t, ffn_norm + 1024, 7168, 0, 7168, 1024, 8, 1024, 7168, 1, DEXP, 0, MOE_F8 ? WGU_SC : 1.f, MOE_F8);
            tdesc_set(td2 + 1, run, moe_w_down, Wmdn_t, nullptr, 1024, 0, 1024, DEXP, 8, DEXP, 1024, 0, 0, 0, MOE_F8 ? WDN_SC : 1.f, MOE_F8); }
        __syncthreads();
        if (wave >= 4) __builtin_amdgcn_s_setprio(1);
        mlstm_phase(lds, QKO, KVT, GATES, mlstm_b_if, Hb, vcu, G, tid); __builtin_amdgcn_s_setprio(0); }
    SEAM(2);

    if (IN(3)) {
        float og[16];
#pragma unroll
        for (int i = 0; i < 16; ++i) og[i] = mlstm_out_norm[16 * lane + i];
        for (int m0 = gw; m0 < NTOK; m0 += 2 * NGW) {
            const int mm[2] = {m0, (m0 + NGW < NTOK) ? m0 + NGW : m0};
            v4u hh[2][2], oo[2][2];
#pragma unroll
            for (int r = 0; r < 2; ++r) { const size_t m = (size_t)mm[r];
                hh[r][0] = *(const v4u*)(Hb + m * 1024 + 16 * lane); hh[r][1] = *(const v4u*)(Hb + m * 1024 + 16 * lane + 8);
                oo[r][0] = *(const v4u*)(QKO + m * 2048 + 512 + 16 * lane); oo[r][1] = *(const v4u*)(QKO + m * 2048 + 512 + 16 * lane + 8); }
#pragma unroll
            for (int r = 0; r < 2; ++r) { const size_t m = (size_t)mm[r];
                float hv[16], ov[16];
#pragma unroll
                for (int q = 0; q < 2; ++q) { const v4u hw = hh[r][q], ow = oo[r][q];
                    hv[8 * q + 0] = bflo(hw.x); hv[8 * q + 1] = bfhi(hw.x); hv[8 * q + 2] = bflo(hw.y); hv[8 * q + 3] = bfhi(hw.y); hv[8 * q + 4] = bflo(hw.z); hv[8 * q + 5] = bfhi(hw.z); hv[8 * q + 6] = bflo(hw.w); hv[8 * q + 7] = bfhi(hw.w);
                    ov[8 * q + 0] = bflo(ow.x); ov[8 * q + 1] = bfhi(ow.x); ov[8 * q + 2] = bflo(ow.y); ov[8 * q + 3] = bfhi(ow.y); ov[8 * q + 4] = bflo(ow.z); ov[8 * q + 5] = bfhi(ow.z); ov[8 * q + 6] = bflo(ow.w); ov[8 * q + 7] = bfhi(ow.w); }
                float s = 0.f;
#pragma unroll
                for (int i = 0; i < 16; ++i) s += hv[i] * hv[i];
                s += __shfl_xor(s, 1); s += __shfl_xor(s, 2); s += __shfl_xor(s, 4); s += __shfl_xor(s, 8);
                const float rinv = 1.0f / sqrtf(s * (1.0f / DV) + EPS);
                float rr[16];
#pragma unroll
                for (int i = 0; i < 16; ++i) rr[i] = hv[i] * rinv * og[i] * __builtin_amdgcn_rcpf(1.0f + __expf(-ov[i]));
                v4u w0, w1; w0.x = pk2(rr[0], rr[1]); w0.y = pk2(rr[2], rr[3]); w0.z = pk2(rr[4], rr[5]); w0.w = pk2(rr[6], rr[7]); w1.x = pk2(rr[8], rr[9]); w1.y = pk2(rr[10], rr[11]); w1.z = pk2(rr[12], rr[13]); w1.w = pk2(rr[14], rr[15]);
                *(v4u*)(XN + m * 1024 + 16 * lane) = w0; *(v4u*)(XN + m * 1024 + 16 * lane + 8) = w1; }
        }
    }
    SEAM(3);

    if (IN(4)) { pg8::Gemm gm{XN, Wout_t, NTOK, DM, DM}; pg8::StaticOrder S; S.init(NTOK, DM, G, bx); pg8::EpiRes<true> E{x_in, X, XB, PART};
        pg8::gemm_phase<pg8::EpiRes<true>, pg8::StaticOrder, true, true>(lds + RING_OFF, gm, S, E); }
    SEAM(4);

#define ROW_SCALES() do { for (int row = vcu * 512 + tid; row < NTOK; row += G * 512) { const f32x4* pp = (const f32x4*)(PART + (size_t)row * 16); const f32x4 p0 = pp[0], p1 = pp[1], p2 = pp[2], p3 = pp[3]; \
        const float s_ = (((p0[0] + p0[1]) + (p0[2] + p0[3])) + ((p1[0] + p1[1]) + (p1[2] + p1[3]))) + (((p2[0] + p2[1]) + (p2[2] + p2[3])) + ((p3[0] + p3[1]) + (p3[2] + p3[3]))); \
        const float ms_ = s_ * (1.0f / DM) + EPS; MS[row] = ms_; RS[row] = 1.0f / sqrtf(ms_); } } while (0)
    if (IN(5)) { ROW_SCALES(); }
    SEAM(5);

    if (IN(6)) { pg8::Gemm gm{XB, Wgu_t, NTOK, 2 * DFF, DM}; pg8::StaticOrder S; S.init(NTOK, 2 * DFF, G, bx); pg8::EpiSwiglu<DOWN_F8 != 0, true> E{ACT, DFF, 1.f, DOWN_F8 ? ACT_SC : 1.f, RS, MS};
        pg8::gemm_phase<pg8::EpiSwiglu<DOWN_F8 != 0, true>, pg8::StaticOrder, true, true>(lds + RING_OFF, gm, S, E); }
    SEAM(6);

    if (IN(7)) { pg8::Gemm gm{ACT, Wdn_t, NTOK, DM, DOWN_F8 ? DFF / 2 : DFF}; pg8::StaticOrder S; S.init(NTOK, DM, G, bx); pg8::EpiRes<true, DOWN_F8 ? 10 : 0> E{X, X, XB, PART};
        static_assert(ACT_SC * WDN_SC == 1024.f, "P7 epilogue shift");
        pg8::gemm_phase<pg8::EpiRes<true, DOWN_F8 ? 10 : 0>, pg8::StaticOrder, true, true, DOWN_F8 != 0>(lds + RING_OFF, gm, S, E); }
    SEAM(7);

    if (IN(8)) { ROW_SCALES(); }
    SEAM(8);

    if (IN(9)) {
        constexpr long TSTEP = 256L * DM * 2;
        constexpr long WS_XB = (long)WS_A + 64L * 1048576L;
        static_assert(((long)WS_WQKV + 1280L * DM * 2 - WS_XB) % TSTEP == 0 && (WS_XB - (long)WS_WQKV) % TSTEP == 0, "swapped-unit tile offsets");
        pg8::QkvOrder S; S.so.init(NTOK, 1280, G, bx); S.G = G; S.c = bx; S.nnorm = (NTOK / 256) * 5; S.nsw = NTOK / 256;
        S.swA = (int)(((long)WS_WQKV + 1280L * DM * 2 - WS_XB) / TSTEP); S.swB = (int)((WS_XB - (long)WS_WQKV) / TSTEP);
        pg8::Gemm gm{XB, Wqkv_t, NTOK, 1280, DM}; pg8::EpiRope E{Qb, Kb, KM, ROPE, VTb, NTOK, S.swB, RS};
        pg8::gemm_phase<pg8::EpiRope, pg8::QkvOrder, true, true>(lds + RING_OFF, gm, S, E);
    }
    SEAM(9);

    if (IN(10)) { __syncthreads(); if (wave >= 4) __builtin_amdgcn_s_setprio(1);
        moba_phase(lds, Qb, Kb, VTb, KM, ATT, vcu, G, tid); __builtin_amdgcn_s_setprio(0); }
    SEAM(10);

    if (IN(11)) { pg8::Gemm gm{ATT, Wo_t, NTOK, DM, DM}; pg8::StaticOrder S; S.init(NTOK, DM, G, bx); pg8::EpiRes<false> E{X, X, nullptr, nullptr};
        pg8::gemm_phase<pg8::EpiRes<false>, pg8::StaticOrder, true, true>(lds + RING_OFF, gm, S, E); }
    SEAM(11);

    if (IN(12)) {
        __syncthreads();
        float wr8[4][4][8];
#pragma unroll
        for (int j = 0; j < 4; ++j)
#pragma unroll
            for (int e = 0; e < 4; ++e) { const int k = 4 * lane + 256 * j + e; const float gk = ffn_norm[1024 + k]; const f32x4 a = *(const f32x4*)(moe_router + (size_t)k * 8), bq = *(const f32x4*)(moe_router + (size_t)k * 8 + 4);
#pragma unroll
                for (int c = 0; c < 4; ++c) { wr8[j][e][c] = a[c] * gk; wr8[j][e][4 + c] = bq[c] * gk; } }
        LAS unsigned* le = (LAS unsigned*)lds;
        for (int chunk = vcu; chunk < 256; chunk += G) {
            for (int i = 0; i < 16; ++i) { const int tl = 16 * wave + i; const size_t m = (size_t)chunk * 128 + tl;
                f32x4 v[4]; load_row(X + m * DM, lane, v);
                const float rinv = 1.0f / sqrtf(row_sumsq(v) * (1.0f / DM) + EPS);
                float lg[8];
#pragma unroll
                for (int c = 0; c < 8; ++c) { float s = 0.f;
#pragma unroll
                    for (int j = 0; j < 4; ++j)
#pragma unroll
                        for (int e = 0; e < 4; ++e) s += v[j][e] * wr8[j][e][c];
                    lg[c] = wave_sum(s) * rinv; }
                int e1 = 0; float l1 = lg[0];
#pragma unroll
                for (int c = 1; c < 8; ++c) { const bool gt = lg[c] > l1; l1 = gt ? lg[c] : l1; e1 = gt ? c : e1; }
                int e2 = -1; float l2 = -__builtin_inff();
#pragma unroll
                for (int c = 0; c < 8; ++c) { const bool gt = (c != e1) && (lg[c] > l2); l2 = gt ? lg[c] : l2; e2 = gt ? c : e2; }
                const float w2 = 1.0f / (1.0f + __expf(l1 - l2)), w1 = 1.0f - w2;
                if (lane == 0) { le[tl] = (unsigned)e1 | ((unsigned)e2 << 8); ME[m] = (unsigned)e1 | ((unsigned)e2 << 8); MW[2 * m] = w1; MW[2 * m + 1] = w2; }
            }
            __syncthreads();
            if (tid < 128) { const unsigned mine = le[tid]; const unsigned a1 = mine & 255u, a2 = mine >> 8; unsigned r1 = 0, r2 = 0;
                for (int j = 0; j < tid; ++j) { const unsigned o = le[j]; const unsigned b1 = o & 255u, b2 = o >> 8; r1 += (b1 == a1) + (b2 == a1); r2 += (b1 == a2) + (b2 == a2); }
                MR[(size_t)chunk * 128 + tid] = r1 | (r2 << 16); }
            else if (tid < 136) { const unsigned ex = tid - 128; unsigned cnt = 0;
                for (int j = 0; j < 128; ++j) { const unsigned o = le[j]; cnt += ((o & 255u) == ex) + ((o >> 8) == ex); }
                HIST[chunk * 8 + ex] = cnt; }
            __syncthreads();
        }
    }
    SEAM(12);

    if (IN(13)) {
        __syncthreads();
        LAS unsigned* lh = (LAS unsigned*)lds;
        LAS unsigned* pre4 = (LAS unsigned*)(lds + 8192);
        LAS unsigned* cnt = (LAS unsigned*)(lds + 8192 + 2048);
        LAS unsigned* cpre = (LAS unsigned*)(lds + 8192 + 2048 + 64);
        for (int i = tid; i < 2048; i += 512) lh[i] = HIST[i];
        __syncthreads();
        { const int ex = wave; unsigned s4 = lh[(4 * lane) * 8 + ex] + lh[(4 * lane + 1) * 8 + ex] + lh[(4 * lane + 2) * 8 + ex] + lh[(4 * lane + 3) * 8 + ex]; unsigned inc = s4;
#pragma unroll
          for (int o = 1; o < 64; o <<= 1) { const unsigned t = __shfl_up(inc, o); if (lane >= o) inc += t; }
          pre4[ex * 64 + lane] = inc - s4; if (lane == 63) cnt[ex] = inc; }
        __syncthreads();
        unsigned mybase = 0u; { unsigned run = 0;
#pragma unroll
            for (int e = 0; e < 8; ++e) { if (e == tid) mybase = run; run += (cnt[e] + 255u) & ~255u; }
            if (vcu == 0 && tid < 8) PB[tid] = mybase >> 8;
            if (vcu == 0 && tid == 0) PB[8] = run >> 8; }
        for (int chunk = vcu; chunk < 256; chunk += G) {
            if (tid < 8) { unsigned p = pre4[tid * 64 + (chunk >> 2)]; for (int c2 = chunk & ~3; c2 < chunk; ++c2) p += lh[c2 * 8 + tid]; cpre[tid] = p + mybase; }
            __syncthreads();
            for (int i = 0; i < 16; ++i) { const size_t m = (size_t)chunk * 128 + 16 * wave + i;
                const unsigned me = ME[m], mr = MR[m]; const unsigned e1 = me & 255u, e2 = me >> 8;
                const unsigned s1 = cpre[e1] + (mr & 0xffffu), s2 = cpre[e2] + (mr >> 16);
                f32x4 v[4]; load_row(X + m * DM, lane, v);
                const float rinv = 1.0f / sqrtf(row_sumsq(v) * (1.0f / DM) + EPS);
                if (MOE_F8) { store_row_fp8((unsigned char*)APERM + (size_t)s1 * DM, lane, v, rinv * XA_SC); store_row_fp8((unsigned char*)APERM + (size_t)s2 * DM, lane, v, rinv * XA_SC); }
                else { store_row_bf16(APERM + (size_t)s1 * DM, lane, v, rinv); store_row_bf16(APERM + (size_t)s2 * DM, lane, v, rinv); }
                if (lane == 0) { MP[2 * m] = s1; MP[2 * m + 1] = s2; } }
            __syncthreads();
        }
    }
    SEAM(13);

    if (IN(14)) { const int npan = (int)PB[8];
        pg8::MoeOrder S; S.so.init(npan * 256, 2 * DEXP, G, bx); S.nct = 2 * DEXP / 256; S.pb1 = PB[1]; S.pb2 = PB[2]; S.pb3 = PB[3]; S.pb4 = PB[4]; S.pb5 = PB[5]; S.pb6 = PB[6]; S.pb7 = PB[7];
        pg8::Gemm gm{APERM, Wmgu_t, npan * 256, 2 * DEXP, MOE_F8 ? DM / 2 : DM}; pg8::EpiSwiglu<MOE_F8 != 0> E{ACT2, DEXP, MOE_F8 ? 1.f / (XA_SC * WGU_SC) : 1.f, MOE_F8 ? ACT_SC : 1.f, nullptr, nullptr};
        pg8::gemm_phase<pg8::EpiSwiglu<MOE_F8 != 0>, pg8::MoeOrder, true, true, MOE_F8 != 0>(lds + RING_OFF, gm, S, E); }
    SEAM(14);

    if (IN(15)) { const int npan = (int)PB[8]; const int nmain = npan < 256 ? npan : 256; constexpr int KU = MOE_F8 ? DEXP / 2 : DEXP;
        { pg8::MoeOrder S; S.so.init(nmain * 256, DM, G, bx); S.nct = DM / 256; S.pb1 = PB[1]; S.pb2 = PB[2]; S.pb3 = PB[3]; S.pb4 = PB[4]; S.pb5 = PB[5]; S.pb6 = PB[6]; S.pb7 = PB[7];
          pg8::Gemm gm{ACT2, Wmdn_t, nmain * 256, DM, KU}; pg8::EpiStore E{Y, DM};
          pg8::gemm_phase<pg8::EpiStore, pg8::MoeOrder, true, true, MOE_F8 != 0>(lds + RING_OFF, gm, S, E); }
        if (npan > nmain) {
            __syncthreads();
            pg8::TailOrder T; T.c = bx; T.ntail = (npan - nmain) * 4; T.pm0 = nmain; T.nct = DM / 256; T.pb1 = PB[1]; T.pb2 = PB[2]; T.pb3 = PB[3]; T.pb4 = PB[4]; T.pb5 = PB[5]; T.pb6 = PB[6]; T.pb7 = PB[7];
            const int half = bx & 1; const size_t koff = half ? (size_t)(KU / 2) : 0;
            pg8::Gemm gt{ACT2 + koff, Wmdn_t + koff, npan * 256, DM, KU, KU / 2};
            pg8::EpiStore E2{half ? Y2 - (size_t)nmain * 256 * DM : Y, DM};
            pg8::gemm_phase<pg8::EpiStore, pg8::TailOrder, true, true, MOE_F8 != 0>(lds + RING_OFF, gt, T, E2);
        }
    }
    SEAM(15);

    if (IN(16)) {
        f32x4 fg[4]; load_row(final_norm, lane, fg);
        const bool bad = (__hip_atomic_load(ctl, RLX_AGENT) != 0u) || (__hip_atomic_load((gu32*)(barw + XB_TMO), RLX_AGENT) != 0u);
        const float ysc = MOE_F8 ? 1.f / (ACT_SC * WDN_SC) : 1.f;
        for (int m0 = gw; m0 < NTOK; m0 += 2 * NGW) {
            const int mm[2] = {m0, (m0 + NGW < NTOK) ? m0 + NGW : m0};
            f32x4 v[2][4]; v2u ya[2][4], yb[2][4]; float w1[2], w2[2]; unsigned s1v[2], s2v[2];
#pragma unroll
            for (int r = 0; r < 2; ++r) { const size_t m = (size_t)mm[r]; load_row(X + m * DM, lane, v[r]);
                const unsigned s1 = MP[2 * m], s2 = MP[2 * m + 1]; s1v[r] = s1; s2v[r] = s2; w1[r] = MW[2 * m] * ysc; w2[r] = MW[2 * m + 1] * ysc;
                const v2u* y1 = (const v2u*)(Y + (size_t)s1 * DM) + lane; const v2u* y2 = (const v2u*)(Y + (size_t)s2 * DM) + lane;
#pragma unroll
                for (int j = 0; j < 4; ++j) { ya[r][j] = y1[64 * j]; yb[r][j] = y2[64 * j]; } }
#pragma unroll
            for (int r = 0; r < 2; ++r) {
#pragma unroll
                for (int j = 0; j < 4; ++j) { const v2u a = ya[r][j], bq = yb[r][j];
                    v[r][j][0] += w1[r] * bflo(a.x) + w2[r] * bflo(bq.x); v[r][j][1] += w1[r] * bfhi(a.x) + w2[r] * bfhi(bq.x); v[r][j][2] += w1[r] * bflo(a.y) + w2[r] * bflo(bq.y); v[r][j][3] += w1[r] * bfhi(a.y) + w2[r] * bfhi(bq.y); }
                if (s1v[r] >= 65536u) { const v2u* t = (const v2u*)(Y2 + (size_t)(s1v[r] - 65536u) * DM) + lane;
#pragma unroll
                    for (int j = 0; j < 4; ++j) { const v2u a = t[64 * j]; v[r][j][0] += w1[r] * bflo(a.x); v[r][j][1] += w1[r] * bfhi(a.x); v[r][j][2] += w1[r] * bflo(a.y); v[r][j][3] += w1[r] * bfhi(a.y); } }
                if (s2v[r] >= 65536u) { const v2u* t = (const v2u*)(Y2 + (size_t)(s2v[r] - 65536u) * DM) + lane;
#pragma unroll
                    for (int j = 0; j < 4; ++j) { const v2u a = t[64 * j]; v[r][j][0] += w2[r] * bflo(a.x); v[r][j][1] += w2[r] * bfhi(a.x); v[r][j][2] += w2[r] * bflo(a.y); v[r][j][3] += w2[r] * bfhi(a.y); } }
                const float rinv = 1.0f / sqrtf(row_sumsq(v[r]) * (1.0f / DM) + EPS);
                f32x4* o = (f32x4*)(X + (size_t)mm[r] * DM) + lane;
#pragma unroll
                for (int j = 0; j < 4; ++j) { f32x4 rr = v[r][j] * rinv * fg[j]; if (bad) rr = (f32x4){__builtin_nanf(""), __builtin_nanf(""), __builtin_nanf(""), __builtin_nanf("")}; o[64 * j] = rr; } }
        }
    }
#undef IN
#undef SEAM
}

extern "C" void kernel_launch(void* const* d_in, const int* in_sizes, int n_in, void* d_out, int out_size, void* d_ws, size_t ws_size, hipStream_t stream) {
    static int grid = 0;
    if (grid == 0) {
        if (n_in != 18 || in_sizes[0] != NTOK * DM || out_size != NTOK * DM || ws_size < WS_END) { fprintf(stderr, "kernel_launch: unexpected shapes / workspace (n_in %d, in0 %d, out %d, ws %zu, need %zu)\n", n_in, n_in > 0 ? in_sizes[0] : -1, out_size, ws_size, (size_t)WS_END); grid = -1; return; }
        int dev = 0, cus = 0, per_cu = 0;
        if (hipGetDevice(&dev) != hipSuccess || hipDeviceGetAttribute(&cus, hipDeviceAttributeMultiprocessorCount, dev) != hipSuccess) { grid = -1; return; }
        if (hipFuncSetAttribute((const void*)yoco_fwd, hipFuncAttributeMaxDynamicSharedMemorySize, LDS_BYTES) != hipSuccess) { fprintf(stderr, "kernel_launch: hipFuncSetAttribute failed\n"); grid = -1; return; }
        if (hipOccupancyMaxActiveBlocksPerMultiprocessor(&per_cu, (const void*)yoco_fwd, NWAVES * 64, LDS_BYTES) != hipSuccess || per_cu < 1) fprintf(stderr, "kernel_launch: occupancy query reports %d workgroups per CU\n", per_cu);
        (void)hipGetLastError();
        grid = cus < 256 ? cus : 256;
    }
    if (grid < 0) return;
    if (hipMemsetAsync((char*)d_ws + WS_CTL, 0, CTL_ZERO_BYTES, stream) != hipSuccess) return;
    Args a{};
    for (int i = 0; i < 18; ++i) a.in[i] = (const float*)d_in[i];
    a.out = (float*)d_out; a.ws = (unsigned char*)d_ws;
#if MK_PER_PHASE
    for (int p = 0; p < NPHASE; ++p) { a.ph_lo = p; a.ph_hi = p + 1; hipLaunchKernelGGL(yoco_fwd, dim3(grid), dim3(NWAVES * 64), LDS_BYTES, stream, a); }
#elif MK_DUP >= 0
#ifndef MK_DUP_N
#define MK_DUP_N 1
#endif
    a.ph_lo = 0; a.ph_hi = MK_DUP + 1; a.bar_region = 0; hipLaunchKernelGGL(yoco_fwd, dim3(grid), dim3(NWAVES * 64), LDS_BYTES, stream, a);
    for (int r = 0; r < MK_DUP_N; ++r) { a.ph_lo = MK_DUP; a.ph_hi = MK_DUP + 1; a.bar_region = 1; hipLaunchKernelGGL(yoco_fwd, dim3(grid), dim3(NWAVES * 64), LDS_BYTES, stream, a); }
    if (MK_DUP + 1 < NPHASE) { a.ph_lo = MK_DUP + 1; a.ph_hi = NPHASE; a.bar_region = 2; hipLaunchKernelGGL(yoco_fwd, dim3(grid), dim3(NWAVES * 64), LDS_BYTES, stream, a); }
#else
    a.ph_lo = 0; a.ph_hi = NPHASE; hipLaunchKernelGGL(yoco_fwd, dim3(grid), dim3(NWAVES * 64), LDS_BYTES, stream, a);
#endif
}
```

```cpp
#include <hip/hip_runtime.h>
#include <cstdio>
#include <cstdint>
namespace pg8 {
#define PG8_LAS __attribute__((address_space(3)))
typedef unsigned short bf16_t;
typedef short bf16x8 __attribute__((ext_vector_type(8)));
typedef float f32x4 __attribute__((ext_vector_type(4)));
typedef unsigned u32x4 __attribute__((ext_vector_type(4)));
constexpr int BM = 256, BK = 64, HALF = 128, HTB = HALF * BK * 2  , STAGE_BYTES = 8 * HTB, NXCD = 8, WGM = 8;

__host__ __device__ __forceinline__ int lds_byte(int r, int c) { const int st = (r >> 4) * 2 + (c >> 5), rr = r & 15, cc = c & 31, ob = rr * 64 + cc * 2; return st * 1024 + (ob ^ (((ob >> 9) & 1) << 5)); }
__host__ __device__ __forceinline__ void stage_rc(int b, int& R, int& C) { const int st = b / 1024, sb = b % 1024, swz = sb ^ (((sb >> 9) & 1) << 5); R = (st >> 1) * 16 + swz / 64; C = (st & 1) * 32 + (swz % 64) / 2; }
__host__ __device__ __forceinline__ int perm32(int rho) { const int n = rho >> 4, i = rho & 15; return 8 * (i >> 2) + 4 * n + (i & 3); }

struct Unit { int pm, pn, pc; };
struct Gemm { const bf16_t* A; const bf16_t* Bt; int M, N, K, Kext; };

struct StaticOrder {
    int nM, nN, nwg, G, c;
    __host__ __device__ __forceinline__ void init(int M, int N, int G_, int c_) { nM = M / BM; nN = N / BM; nwg = nM * nN; G = G_; c = c_; }
    __host__ __device__ __forceinline__ bool next(int i, Unit& u) const {
        const long L = (long)i * G + c; if (L >= nwg) return false;
        int wgid = (int)L; { const int q = nwg / NXCD, r = nwg % NXCD, xcd = wgid % NXCD, off = wgid / NXCD; wgid = (xcd < r ? xcd * (q + 1) : r * (q + 1) + (xcd - r) * q) + off; }
        const int nig = WGM * nN, gid = wgid / nig, fm = gid * WGM, gsz = (nM - fm) < WGM ? (nM - fm) : WGM;
        u.pm = fm + ((wgid % nig) % gsz); u.pn = (wgid % nig) / gsz; u.pc = u.pn; return true;
    }
    __device__ __forceinline__ void a_ready(const Unit&) const {}
    __device__ __forceinline__ void done(const Unit&) const {}
};

__device__ __forceinline__ unsigned cvt_pk_bf16(float lo, float hi) { unsigned r; asm volatile("v_cvt_pk_bf16_f32 %0, %1, %2" : "=v"(r) : "v"(lo), "v"(hi)); return r; }
typedef float f32x2 __attribute__((ext_vector_type(2)));
typedef unsigned u32x2 __attribute__((ext_vector_type(2)));
struct EpiStore {
    static constexpr bool PERM = true, AFTER_DRAIN = false;
    bf16_t* O; int ldc;
    __device__ __forceinline__ void operator()(const f32x4 (&acc)[2][2][4][2], const Unit& u, int wr, int wc, int fr, int fq) const {
        const int row0 = u.pm * BM + wr * 64 + fr; const int col0 = u.pc * BM + wc * 32 + 8 * fq;
#pragma unroll
        for (int ai = 0; ai < 2; ++ai)
#pragma unroll
            for (int m = 0; m < 4; ++m) { bf16_t* rowp = O + (size_t)(row0 + ai * HALF + m * 16) * ldc + col0;
#pragma unroll
                for (int bj = 0; bj < 2; ++bj) { const f32x4 v0 = acc[ai][bj][m][0], v1 = acc[ai][bj][m][1];
                    u32x4 w; w.x = cvt_pk_bf16(v0[0], v0[1]); w.y = cvt_pk_bf16(v0[2], v0[3]); w.z = cvt_pk_bf16(v1[0], v1[1]); w.w = cvt_pk_bf16(v1[2], v1[3]);
                    *(u32x4*)(rowp + bj * HALF) = w; } }
    }
};
template <bool XB, int SHIFT = 0> struct EpiRes {
    static constexpr bool PERM = false, AFTER_DRAIN = false;
    const float* base; float* out; bf16_t* xb; float* part; static constexpr int ldc = 1024;
    __device__ __forceinline__ void operator()(const f32x4 (&acc)[2][2][4][2], const Unit& u, int wr, int wc, int fr, int fq) const {
        const int col0 = u.pc * BM + wc * 32 + 4 * fq;
#pragma unroll
        for (int ai = 0; ai < 2; ++ai)
#pragma unroll
            for (int m = 0; m < 4; ++m) { const int row = u.pm * BM + ai * HALF + wr * 64 + m * 16 + fr; const size_t off = (size_t)row * ldc + col0; float ss = 0.f;
#pragma unroll
                for (int bj = 0; bj < 2; ++bj)
#pragma unroll
                    for (int n = 0; n < 2; ++n) { const f32x4 bs = *(const f32x4*)(base + off + bj * HALF + n * 16); const f32x4 o = bs + acc[ai][bj][m][n] * (1.0f / (float)(1 << SHIFT)); *(f32x4*)(out + off + bj * HALF + n * 16) = o;
                        if constexpr (XB) { u32x2 w; w.x = cvt_pk_bf16(o[0], o[1]); w.y = cvt_pk_bf16(o[2], o[3]); *(u32x2*)(xb + off + bj * HALF + n * 16) = w; ss += (o[0] * o[0] + o[1] * o[1]) + (o[2] * o[2] + o[3] * o[3]); } }
                if constexpr (XB) { ss += __shfl_xor(ss, 16); ss += __shfl_xor(ss, 32); if (fq == 0) part[(size_t)row * 16 + u.pc * 4 + wc] = ss; }
                if (m & 1) asm volatile("" ::: "memory"); }
    }
};
__device__ __forceinline__ unsigned pk4_fp8(float a, float b, float c, float d) {
    a = __builtin_amdgcn_fmed3f(a, -448.f, 448.f); b = __builtin_amdgcn_fmed3f(b, -448.f, 448.f); c = __builtin_amdgcn_fmed3f(c, -448.f, 448.f); d = __builtin_amdgcn_fmed3f(d, -448.f, 448.f);
    int r = __builtin_amdgcn_cvt_pk_fp8_f32(a, b, 0, false); r = __builtin_amdgcn_cvt_pk_fp8_f32(c, d, r, true); return (unsigned)r;
}
template <bool F8OUT, bool ROWSC = false> struct EpiSwiglu {
    static constexpr bool PERM = false, AFTER_DRAIN = false;
    void* O; int ldc; float isc, osc; const float* rs; const float* ms;
    __device__ __forceinline__ void operator()(const f32x4 (&acc)[2][2][4][2], const Unit& u, int wr, int wc, int fr, int fq) const {
        const int j0 = u.pc * 128 + wc * 32 + 8 * fq; const float c1 = -1.4426950408889634f * isc, c2i = 1.0f / (isc * isc * osc);
#pragma unroll
        for (int ai = 0; ai < 2; ++ai)
#pragma unroll
            for (int m = 0; m < 4; ++m) { const int row = u.pm * BM + ai * HALF + wr * 64 + m * 16 + fr; const size_t off = (size_t)row * ldc + j0;
                float c1r = c1, c2r = c2i; if constexpr (ROWSC) { c1r = c1 * rs[row]; c2r = c2i * ms[row]; }
                f32x4 a[2];
#pragma unroll
                for (int bj = 0; bj < 2; ++bj) { const f32x4 g = acc[ai][bj][m][0], uu = acc[ai][bj][m][1];
#pragma unroll
                    for (int e = 0; e < 4; e += 2) { const f32x2 g2 = (f32x2){g[e], g[e + 1]}, u2 = (f32x2){uu[e], uu[e + 1]};
                        const f32x2 t2 = g2 * c1r; f32x2 ex; ex.x = __builtin_amdgcn_exp2f(t2.x); ex.y = __builtin_amdgcn_exp2f(t2.y);
                        const f32x2 d2 = ex * c2r + c2r; f32x2 r2; r2.x = __builtin_amdgcn_rcpf(d2.x); r2.y = __builtin_amdgcn_rcpf(d2.y);
                        const f32x2 o2 = (g2 * u2) * r2; a[bj][e] = o2.x; a[bj][e + 1] = o2.y; } }
                if constexpr (F8OUT) { u32x2 w; w.x = pk4_fp8(a[0][0], a[0][1], a[0][2], a[0][3]); w.y = pk4_fp8(a[1][0], a[1][1], a[1][2], a[1][3]); *(u32x2*)((unsigned char*)O + off) = w; }
                else { u32x4 w; w.x = cvt_pk_bf16(a[0][0], a[0][1]); w.y = cvt_pk_bf16(a[0][2], a[0][3]); w.z = cvt_pk_bf16(a[1][0], a[1][1]); w.w = cvt_pk_bf16(a[1][2], a[1][3]); *(u32x4*)((bf16_t*)O + off) = w; }
                if (m & 1) __builtin_amdgcn_sched_barrier(0); }
    }
};
struct EpiRope {
    static constexpr bool PERM = false, AFTER_DRAIN = false;
    bf16_t* Q; bf16_t* Kb; float* KM; const float* rope;
    bf16_t* VT; int vt_ld, vt_pn0; const float* rs;
    __device__ __forceinline__ void operator()(const f32x4 (&acc)[2][2][4][2], const Unit& u, int wr, int wc, int fr, int fq) const {
        const bool isk = (u.pc == 4), isv = (u.pc == 5);
        bf16_t* base = Q + (isv ? (long)(VT - Q) : (isk ? (long)(Kb - Q) : 0L)); const int ldc = isv ? vt_ld : (isk ? 256 : 1024); const int colt = isv ? (u.pn - vt_pn0) * BM : (isk ? 0 : u.pc * BM);
        const int rowt = isv ? 0 : u.pm * BM; const bool rot = (wc == 0) && !isv;
        const int col0 = colt + wc * 32 + 4 * fq;
        f32x4 cs[2][2];
#pragma unroll
        for (int bj = 0; bj < 2; ++bj)
#pragma unroll
            for (int n = 0; n < 2; ++n) cs[bj][n] = (f32x4){0.f, 0.f, 0.f, 0.f};
#pragma unroll
        for (int ai = 0; ai < 2; ++ai)
#pragma unroll
            for (int m = 0; m < 4; ++m) { const int r = rowt + ai * HALF + wr * 64 + m * 16 + fr; bf16_t* rowp = base + (size_t)r * ldc + col0;
                f32x4 c4 = (f32x4){1.f, 1.f, 1.f, 1.f}, s4 = (f32x4){0.f, 0.f, 0.f, 0.f};
                if (rot) { const float* rp = rope + (size_t)(r & 2047) * 32 + 4 * fq; c4 = *(const f32x4*)rp; s4 = *(const f32x4*)(rp + 16); }
                const float rsr = isv ? 1.f : rs[r];
#pragma unroll
                for (int bj = 0; bj < 2; ++bj) { f32x4 x1 = acc[ai][bj][m][0] * rsr, x2 = acc[ai][bj][m][1] * rsr;
                    if (isv) { x1 = x1 * *(const f32x4*)(rs + col0 + bj * HALF); x2 = x2 * *(const f32x4*)(rs + col0 + bj * HALF + 16); }
                    if (rot) { const f32x4 y1 = x1 * c4 - x2 * s4, y2 = x2 * c4 + x1 * s4; x1 = y1; x2 = y2; }
                    if (isk) { cs[bj][0] += x1; cs[bj][1] += x2; }
                    u32x2 w; w.x = cvt_pk_bf16(x1[0], x1[1]); w.y = cvt_pk_bf16(x1[2], x1[3]); *(u32x2*)(rowp + bj * HALF) = w;
                    w.x = cvt_pk_bf16(x2[0], x2[1]); w.y = cvt_pk_bf16(x2[2], x2[3]); *(u32x2*)(rowp + bj * HALF + 16) = w; } }
        if (isk) {
#pragma unroll
            for (int bj = 0; bj < 2; ++bj)
#pragma unroll
                for (int n = 0; n < 2; ++n)
#pragma unroll
                    for (int e = 0; e < 4; ++e) { float s = cs[bj][n][e]; s += __shfl_xor(s, 1); s += __shfl_xor(s, 2); s += __shfl_xor(s, 4); s += __shfl_xor(s, 8);
                        if (fr == 0) atomicAdd(KM + (size_t)u.pm * 256 + bj * HALF + wc * 32 + n * 16 + 4 * fq + e, s); }
        }
    }
};
struct QkvOrder {
    StaticOrder so; int G, c, nnorm, nsw, swA, swB;
    __device__ __forceinline__ bool next(int i, Unit& u) const {
        if (so.next(i, u)) return true;
        const int j = i * G + c - nnorm; if (j >= nsw) return false;
        u.pm = swA; u.pn = swB + j; u.pc = 5; return true;
    }
    __device__ __forceinline__ void a_ready(const Unit&) const {}
    __device__ __forceinline__ void done(const Unit&) const {}
};
struct TailOrder {
    int c, ntail, pm0, nct; int pb1, pb2, pb3, pb4, pb5, pb6, pb7;
    __device__ __forceinline__ bool next(int i, Unit& u) const {
        const int j = c >> 1; if (i > 0 || j >= ntail) return false;
        u.pm = pm0 + (j >> 2); u.pc = j & 3;
        const int e = (u.pm >= pb1) + (u.pm >= pb2) + (u.pm >= pb3) + (u.pm >= pb4) + (u.pm >= pb5) + (u.pm >= pb6) + (u.pm >= pb7);
        u.pn = e * nct + u.pc; return true;
    }
    __device__ __forceinline__ void a_ready(const Unit&) const {}
    __device__ __forceinline__ void done(const Unit&) const {}
};
struct EpiNull {
    static constexpr bool PERM = false, AFTER_DRAIN = false;
    float* junk;
    __device__ __forceinline__ void operator()(const f32x4 (&acc)[2][2][4][2], const Unit& u, int wr, int wc, int fr, int fq) const {
        f32x4 s = (f32x4){0.f, 0.f, 0.f, 0.f};
#pragma unroll
        for (int ai = 0; ai < 2; ++ai)
#pragma unroll
            for (int bj = 0; bj < 2; ++bj)
#pragma unroll
                for (int m = 0; m < 4; ++m)
#pragma unroll
                    for (int n = 0; n < 2; ++n) s += acc[ai][bj][m][n];
        if (s[0] + s[1] + s[2] + s[3] == 1.2345e-30f) junk[u.pm + wr + wc + fr + fq] = s[0];
    }
};
struct MoeOrder {
    StaticOrder so; int nct; int pb1, pb2, pb3, pb4, pb5, pb6, pb7;
    __device__ __forceinline__ bool next(int i, Unit& u) const {
        if (!so.next(i, u)) return false;
        const int e = (u.pm >= pb1) + (u.pm >= pb2) + (u.pm >= pb3) + (u.pm >= pb4) + (u.pm >= pb5) + (u.pm >= pb6) + (u.pm >= pb7);
        u.pc = u.pn; u.pn = e * nct + u.pc; return true;
    }
    __device__ __forceinline__ void a_ready(const Unit&) const {}
    __device__ __forceinline__ void done(const Unit&) const {}
};
typedef int i32x4 __attribute__((ext_vector_type(4)));
typedef int i32x8 __attribute__((ext_vector_type(8)));
template <class Epi, class Sched, bool ALIGN_EPI = false, bool SP2 = false, bool FP8 = false>
__device__ __forceinline__ void gemm_phase(PG8_LAS unsigned char* lds, const Gemm g, const Sched& S, const Epi& E) {
    const int tid = threadIdx.x, wid = __builtin_amdgcn_readfirstlane(tid >> 6), lane = tid & 63, wr = wid >> 2, wc = wid & 3, fr = lane & 15, fq = lane >> 4;
    const int K = g.K, nt = (g.Kext ? g.Kext : K) / BK;
    unsigned voffA[2], voffB[2];
#pragma unroll
    for (int i = 0; i < 2; ++i) { int R, C; stage_rc(tid * 16 + i * 8192, R, C); const int Rb = Epi::PERM ? ((R & ~31) + perm32(R & 31)) : R;
        voffA[i] = (unsigned)(R * K + C) * 2u; voffB[i] = (unsigned)(Rb * K + C) * 2u; }
    const size_t kstep = (size_t)(BK * 2);
    const size_t hstep = (size_t)HALF * K * 2;
    const size_t tstep = 2 * hstep;
    const unsigned ldsw = (unsigned)wid * 1024u;
    const int aoff = lds_byte(wr * 64 + fr, fq * 8), boff = lds_byte(wc * 32 + fr, fq * 8);
#define PG8_SA(b, h) (((b) * 2 + (h)) * HTB)
#define PG8_SB(b, h) ((4 + (b) * 2 + (h)) * HTB)
#define PG8_STAGE(bufoff, gbase, voff) do { _Pragma("unroll") for (int _i = 0; _i < 2; ++_i) \
        __builtin_amdgcn_global_load_lds((const unsigned*)((const char*)(gbase) + (voff)[_i]), (PG8_LAS unsigned*)(lds + (bufoff) + ldsw + _i * 8192), 16, 0, 0); } while (0)
#define PG8_LDA(dst, b, h) do { if constexpr (FP8) { _Pragma("unroll") for (int m = 0; m < 4; ++m) { const i32x4 lo_ = *(const PG8_LAS i32x4*)(lds + PG8_SA(b, h) + aoff + m * 2048), hi_ = *(const PG8_LAS i32x4*)(lds + PG8_SA(b, h) + aoff + m * 2048 + 1024); dst##8[m] = __builtin_shufflevector(lo_, hi_, 0, 1, 2, 3, 4, 5, 6, 7); } } \
    else { _Pragma("unroll") for (int m = 0; m < 4; ++m) _Pragma("unroll") for (int k = 0; k < 2; ++k) dst[m][k] = *(const PG8_LAS bf16x8*)(lds + PG8_SA(b, h) + aoff + m * 2048 + k * 1024); } } while (0)
#define PG8_LDB(dst, b, h) do { if constexpr (FP8) { _Pragma("unroll") for (int n = 0; n < 2; ++n) { const i32x4 lo_ = *(const PG8_LAS i32x4*)(lds + PG8_SB(b, h) + boff + n * 2048), hi_ = *(const PG8_LAS i32x4*)(lds + PG8_SB(b, h) + boff + n * 2048 + 1024); dst##8[n] = __builtin_shufflevector(lo_, hi_, 0, 1, 2, 3, 4, 5, 6, 7); } } \
    else { _Pragma("unroll") for (int n = 0; n < 2; ++n) _Pragma("unroll") for (int k = 0; k < 2; ++k) dst[n][k] = *(const PG8_LAS bf16x8*)(lds + PG8_SB(b, h) + boff + n * 2048 + k * 1024); } } while (0)
#define PG8_MMA(ai, bj, At, Bt) do { __builtin_amdgcn_s_setprio(1); \
        if constexpr (FP8) { asm volatile("s_nop 1\n\t" \
            "v_mfma_scale_f32_16x16x128_f8f6f4 %0, %12, %8, %0, %14, %14 op_sel_hi:[0,0,0]\n\t" \
            "v_mfma_scale_f32_16x16x128_f8f6f4 %1, %13, %8, %1, %14, %14 op_sel_hi:[0,0,0]\n\t" \
            "v_mfma_scale_f32_16x16x128_f8f6f4 %2, %12, %9, %2, %14, %14 op_sel_hi:[0,0,0]\n\t" \
            "v_mfma_scale_f32_16x16x128_f8f6f4 %3, %13, %9, %3, %14, %14 op_sel_hi:[0,0,0]\n\t" \
            "v_mfma_scale_f32_16x16x128_f8f6f4 %4, %12, %10, %4, %14, %14 op_sel_hi:[0,0,0]\n\t" \
            "v_mfma_scale_f32_16x16x128_f8f6f4 %5, %13, %10, %5, %14, %14 op_sel_hi:[0,0,0]\n\t" \
            "v_mfma_scale_f32_16x16x128_f8f6f4 %6, %12, %11, %6, %14, %14 op_sel_hi:[0,0,0]\n\t" \
            "v_mfma_scale_f32_16x16x128_f8f6f4 %7, %13, %11, %7, %14, %14 op_sel_hi:[0,0,0]\n\t" \
            : "+v"(acc[ai][bj][0][0]), "+v"(acc[ai][bj][0][1]), "+v"(acc[ai][bj][1][0]), "+v"(acc[ai][bj][1][1]), "+v"(acc[ai][bj][2][0]), "+v"(acc[ai][bj][2][1]), "+v"(acc[ai][bj][3][0]), "+v"(acc[ai][bj][3][1]) \
            : "v"(At##8[0]), "v"(At##8[1]), "v"(At##8[2]), "v"(At##8[3]), "v"(Bt##8[0]), "v"(Bt##8[1]), "v"(scl8)); } \
        else { _Pragma("unroll") for (int m = 0; m < 4; ++m) _Pragma("unroll") for (int n = 0; n < 2; ++n) _Pragma("unroll") for (int k = 0; k < 2; ++k) \
            acc[ai][bj][m][n] = __builtin_amdgcn_mfma_f32_16x16x32_bf16(Bt[n][k], At[m][k], acc[ai][bj][m][n], 0, 0, 0); } \
        __builtin_amdgcn_s_setprio(0); } while (0)
#define PG8_WAIT_V(n) asm volatile("s_waitcnt vmcnt(" #n ")" ::: "memory")
#define PG8_WAIT_L(n) asm volatile("s_waitcnt lgkmcnt(" #n ")" ::: "memory")
#define PG8_BAR __builtin_amdgcn_s_barrier()
#define PG8_SCHED __builtin_amdgcn_sched_barrier(0)
    Unit cur, nxt; int ui = 0;
    if (!S.next(0, cur)) return;
    f32x4 acc[2][2][4][2];
#pragma unroll
    for (int a = 0; a < 2; ++a)
#pragma unroll
        for (int b = 0; b < 2; ++b)
#pragma unroll
            for (int m = 0; m < 4; ++m)
#pragma unroll
                for (int n = 0; n < 2; ++n) { acc[a][b][m][n] = (f32x4){0.f, 0.f, 0.f, 0.f}; }
    const int scl8 = 0x7f7f7f7f;
    bf16x8 At[4][2], B0[2][2], B1[2][2]; i32x8 At8[4], B08[2], B18[2];
    const char* cA = (const char*)g.A + (size_t)cur.pm * tstep; const char* cB = (const char*)g.Bt + (size_t)cur.pn * tstep;
    S.a_ready(cur);
    if constexpr (SP2) {
        PG8_STAGE(PG8_SB(0, 0), cB, voffB); PG8_STAGE(PG8_SB(0, 1), cB + hstep, voffB); PG8_STAGE(PG8_SA(0, 0), cA, voffA); PG8_STAGE(PG8_SA(0, 1), cA + hstep, voffA);
        if (wr == 1) PG8_BAR;
        PG8_WAIT_V(2); PG8_BAR;
        PG8_STAGE(PG8_SB(1, 0), cB + kstep, voffB); PG8_STAGE(PG8_SA(1, 0), cA + kstep, voffA); PG8_STAGE(PG8_SB(1, 1), cB + hstep + kstep, voffB);
        PG8_WAIT_V(6); PG8_BAR;
    } else {
        PG8_STAGE(PG8_SB(0, 0), cB, voffB); PG8_STAGE(PG8_SA(0, 0), cA, voffA); PG8_STAGE(PG8_SB(0, 1), cB + hstep, voffB); PG8_STAGE(PG8_SA(0, 1), cA + hstep, voffA);
        if (wr == 1) PG8_BAR;
        PG8_WAIT_V(4); PG8_BAR;
        PG8_STAGE(PG8_SB(1, 0), cB + kstep, voffB); PG8_STAGE(PG8_SA(1, 0), cA + kstep, voffA); PG8_STAGE(PG8_SB(1, 1), cB + hstep + kstep, voffB);
        PG8_WAIT_V(6); PG8_BAR;
    }
    for (;;) {
        const bool has_next = S.next(ui + 1, nxt);
        const char* nA = has_next ? (const char*)g.A + (size_t)nxt.pm * tstep : cA; const char* nB = has_next ? (const char*)g.Bt + (size_t)nxt.pn * tstep : cB;
        for (int t = 0; t < nt; t += 2) {
            const bool last = (t == nt - 2);
            const char* a1 = cA + (size_t)(t + 1) * kstep;
            const char* a2 = last ? nA : cA + (size_t)(t + 2) * kstep; const char* b2 = last ? nB : cB + (size_t)(t + 2) * kstep;
            const char* a3 = a2 + kstep; const char* b3 = b2 + kstep;
            if (last && has_next) S.a_ready(nxt);
            if constexpr (SP2) {
            PG8_LDB(B0, 0, 0); PG8_LDB(B1, 0, 1); PG8_SCHED; PG8_LDA(At, 0, 0); PG8_STAGE(PG8_SA(1, 1), a1 + hstep, voffA);
            PG8_WAIT_V(8); PG8_WAIT_L(0); PG8_BAR; PG8_MMA(0, 0, At, B0); PG8_MMA(0, 1, At, B1); PG8_BAR; PG8_SCHED;
            PG8_LDA(At, 0, 1); PG8_STAGE(PG8_SB(0, 0), b2, voffB); PG8_STAGE(PG8_SB(0, 1), b2 + hstep, voffB); PG8_STAGE(PG8_SA(0, 0), a2, voffA);
            PG8_WAIT_V(8); PG8_WAIT_L(0); PG8_BAR; PG8_MMA(1, 0, At, B0); PG8_MMA(1, 1, At, B1); PG8_BAR; PG8_SCHED;
            PG8_LDB(B0, 1, 0); PG8_LDB(B1, 1, 1); PG8_SCHED; PG8_LDA(At, 1, 0); PG8_STAGE(PG8_SA(0, 1), a2 + hstep, voffA);
            PG8_WAIT_V(8); PG8_WAIT_L(0); PG8_BAR; PG8_MMA(0, 0, At, B0); PG8_MMA(0, 1, At, B1); PG8_BAR; PG8_SCHED;
            PG8_LDA(At, 1, 1); PG8_STAGE(PG8_SB(1, 0), b3, voffB); PG8_STAGE(PG8_SB(1, 1), b3 + hstep, voffB); PG8_STAGE(PG8_SA(1, 0), a3, voffA);
            PG8_WAIT_V(8); PG8_WAIT_L(0); PG8_BAR; PG8_MMA(1, 0, At, B0); PG8_MMA(1, 1, At, B1); PG8_BAR; PG8_SCHED;
            } else {
            PG8_LDB(B0, 0, 0); PG8_SCHED; PG8_LDA(At, 0, 0); PG8_STAGE(PG8_SA(1, 1), a1 + hstep, voffA);
            PG8_WAIT_L(8); PG8_BAR; PG8_WAIT_L(0); PG8_MMA(0, 0, At, B0); PG8_BAR; PG8_SCHED;
            PG8_LDB(B1, 0, 1); PG8_STAGE(PG8_SB(0, 0), b2, voffB);
            PG8_BAR; PG8_WAIT_L(0); PG8_MMA(0, 1, At, B1); PG8_BAR;
            PG8_LDA(At, 0, 1); PG8_STAGE(PG8_SA(0, 0), a2, voffA);
            PG8_BAR; PG8_WAIT_L(0); PG8_MMA(1, 0, At, B0); PG8_BAR; PG8_SCHED;
            PG8_STAGE(PG8_SB(0, 1), b2 + hstep, voffB);
            PG8_WAIT_V(6); PG8_BAR; PG8_MMA(1, 1, At, B1); PG8_BAR;
            PG8_LDB(B0, 1, 0); PG8_SCHED; PG8_LDA(At, 1, 0); PG8_STAGE(PG8_SA(0, 1), a2 + hstep, voffA);
            PG8_WAIT_L(8); PG8_BAR; PG8_WAIT_L(0); PG8_MMA(0, 0, At, B0); PG8_BAR; PG8_SCHED;
            PG8_LDB(B1, 1, 1); PG8_STAGE(PG8_SB(1, 0), b3, voffB);
            PG8_BAR; PG8_WAIT_L(0); PG8_MMA(0, 1, At, B1); PG8_BAR;
            PG8_LDA(At, 1, 1); PG8_STAGE(PG8_SA(1, 0), a3, voffA);
            PG8_BAR; PG8_WAIT_L(0); PG8_MMA(1, 0, At, B0); PG8_BAR; PG8_SCHED;
            PG8_STAGE(PG8_SB(1, 1), b3 + hstep, voffB);
            PG8_WAIT_V(6); PG8_BAR; PG8_MMA(1, 1, At, B1); PG8_BAR;
            }
        }
        if constexpr (FP8) asm volatile("s_nop 15\n\ts_nop 15" : "+v"(acc[1][0][0][0]), "+v"(acc[1][0][0][1]), "+v"(acc[1][0][1][0]), "+v"(acc[1][0][1][1]), "+v"(acc[1][0][2][0]), "+v"(acc[1][0][2][1]), "+v"(acc[1][0][3][0]), "+v"(acc[1][0][3][1]),
            "+v"(acc[1][1][0][0]), "+v"(acc[1][1][0][1]), "+v"(acc[1][1][1][0]), "+v"(acc[1][1][1][1]), "+v"(acc[1][1][2][0]), "+v"(acc[1][1][2][1]), "+v"(acc[1][1][3][0]), "+v"(acc[1][1][3][1]));
        if constexpr (ALIGN_EPI) { if (wr == 0) PG8_BAR; }
        if constexpr (!Epi::AFTER_DRAIN) { E(acc, cur, wr, wc, fr, fq); S.done(cur); }
        if (!has_next) break;
#pragma unroll
        for (int a = 0; a < 2; ++a)
#pragma unroll
            for (int b = 0; b < 2; ++b)
#pragma unroll
                for (int m = 0; m < 4; ++m)
#pragma unroll
                    for (int n = 0; n < 2; ++n) { acc[a][b][m][n] = (f32x4){0.f, 0.f, 0.f, 0.f}; }
        cur = nxt; cA = nA; cB = nB; ++ui;
        if constexpr (ALIGN_EPI) { if (wr == 1) PG8_BAR; }
    }
    PG8_WAIT_V(0);
    if constexpr (!ALIGN_EPI) { if (wr == 0) PG8_BAR; }
    PG8_BAR;
    if constexpr (Epi::AFTER_DRAIN) { E.fused(acc, cur, wr, wc, fr, fq, lds, wid, lane); S.done(cur); }
#undef PG8_SA
#undef PG8_SB
#undef PG8_STAGE
#undef PG8_LDA
#undef PG8_LDB
#undef PG8_MMA
#undef PG8_WAIT_V
#undef PG8_WAIT_L
#undef PG8_BAR
#undef PG8_SCHED
}
}
#ifndef MK_PER_PHASE
#define MK_PER_PHASE 0
#endif
#ifndef MK_DUP
#define MK_DUP (-1)
#endif
#ifndef SIDEJOB
#define SIDEJOB 0
#endif
#ifndef DOWN_F8
#define DOWN_F8 1
#endif
#ifndef DENSE_F8
#define DENSE_F8 0
#endif
#ifndef MOE_F8
#define MOE_F8 1
#endif
constexpr float XA_SC = 8.f, WGU_SC = 64.f, ACT_SC = 8.f, WDN_SC = 128.f;
constexpr int NWAVES = 8;
constexpr int NPHASE = 17;

constexpr int DM = 1024, BATCH = 16, SEQ = 2048, NTOK = BATCH * SEQ;
constexpr int MH = 4, DQK = 128, DV = 256, CH = 64, NCH = SEQ / CH;
constexpr int WIN_LD = 3080;
constexpr int AH = 8, AKV = 2, HD = 128, NBLK = 8;
constexpr int DFF = 2816, NE = 8, DEXP = 3584;
constexpr int MAXPANEL = 264;
constexpr float EPS = 1e-6f;

constexpr size_t MiB = 1u << 20;
constexpr size_t WS_CTL = 0, CTL_ZERO_BYTES = 1 * MiB;
constexpr int CW_BAR = 4096;
constexpr size_t WS_KM = 256 * 1024;
constexpr size_t WS_ROPE = 1 * MiB;
constexpr size_t WS_GATES = 2 * MiB;
constexpr size_t WS_ME = 4 * MiB;
constexpr size_t WS_MW = 5 * MiB;
constexpr size_t WS_MR = 6 * MiB;
constexpr size_t WS_MP = 7 * MiB;
constexpr size_t WS_HIST = 8 * MiB;
constexpr size_t WS_PB = 8 * MiB + 64 * 1024;
constexpr size_t WS_PART = 9 * MiB;
constexpr size_t WS_RS = 12 * MiB, WS_MS = 13 * MiB;
constexpr size_t WS_WIN = 16 * MiB;
constexpr size_t WS_WOUT = 22 * MiB;
constexpr size_t WS_WGU = 24 * MiB;
constexpr size_t WS_WDN = 35 * MiB;
constexpr size_t WS_WQKV = 41 * MiB;
constexpr size_t WS_WO = 44 * MiB;
constexpr size_t WS_WMGU = 46 * MiB;
constexpr size_t WS_WMDN = 158 * MiB;
constexpr size_t WS_A = 224 * MiB;
constexpr size_t WS_B = 360 * MiB;
constexpr size_t WS_QKO = WS_B;
constexpr size_t WS_KVT = WS_B + 128 * MiB;
constexpr size_t WS_H = WS_B + 224 * MiB;
constexpr size_t WS_ACT = WS_B;
constexpr size_t WS_Q = WS_B;
constexpr size_t WS_K = WS_B + 64 * MiB;
constexpr size_t WS_VT = WS_B + 80 * MiB;
constexpr size_t WS_ATT = WS_B + 96 * MiB;
constexpr size_t WS_ACT2 = WS_B;
constexpr size_t WS_Y2 = WS_B + (size_t)MAXPANEL * 256 * DEXP * 2;
constexpr size_t WS_END = WS_Y2 + 4 * MiB;
static_assert(WS_WMDN + (size_t)NE * 1024 * DEXP * 2 <= WS_A && WS_A + (size_t)MAXPANEL * 256 * 1024 * 2 <= WS_B, "d_ws map");

constexpr int RING_OFF = 0, RING_BYTES = 131072;
constexpr int LDSCTL_OFF = 155648, MISC_OFF = LDSCTL_OFF + 320;
constexpr int LDS_BYTES = 156672;

#define GAS __attribute__((address_space(1)))
#define LAS __attribute__((address_space(3)))
typedef unsigned short bf16;
typedef unsigned v4u __attribute__((ext_vector_type(4)));
typedef unsigned v2u __attribute__((ext_vector_type(2)));
typedef float f32x4 __attribute__((ext_vector_type(4)));
typedef short bf16x8 __attribute__((ext_vector_type(8)));
typedef GAS unsigned gu32;
#define RLX_AGENT __ATOMIC_RELAXED, __HIP_MEMORY_SCOPE_AGENT
#define LDS_WAIT() asm volatile("s_waitcnt lgkmcnt(0)" ::: "memory")
#define VM_WAIT() asm volatile("s_waitcnt vmcnt(0)" ::: "memory")
#define MFMA16(a, b, c) __builtin_amdgcn_mfma_f32_16x16x32_bf16((a), (b), (c), 0, 0, 0)
__device__ __forceinline__ unsigned pk2(float lo, float hi) { return pg8::cvt_pk_bf16(lo, hi); }
__device__ __forceinline__ float bflo(unsigned w) { return __uint_as_float(w << 16); }
__device__ __forceinline__ float bfhi(unsigned w) { return __uint_as_float(w & 0xffff0000u); }
__device__ __forceinline__ float wave_sum(float v) {
#pragma unroll
    for (int o = 1; o < 64; o <<= 1) v += __shfl_xor(v, o);
    return v;
}

#define XB_TMO      128
#define XB_XCNT(j)  (256  + 64 * (j))
#define XB_XSUB(j)  (1280 + 64 * (j))
#define XB_XGEN(j)  (2304 + 64 * (j))
#define XB_TOP      3328
#define XB_TOPGEN   3392
#define XCD_BAR_WORDS 3456
#define XB_SPIN_CAP (1u << 18)

__device__ __forceinline__ unsigned xb_ld(unsigned* p)              { return __hip_atomic_load(p, __ATOMIC_RELAXED, __HIP_MEMORY_SCOPE_AGENT); }
__device__ __forceinline__ unsigned xb_add(unsigned* p, unsigned v) { return __hip_atomic_fetch_add(p, v, __ATOMIC_RELAXED, __HIP_MEMORY_SCOPE_AGENT); }
__device__ __forceinline__ unsigned xb_xcc_id() { return (unsigned)__builtin_amdgcn_s_getreg((3 << 11) | 20) & 0xFu; }
#define XB_SPIN(cond, bar) do { unsigned _sp = 0; while (cond) { __builtin_amdgcn_s_sleep(1); \
    if ((++_sp & 255u) == 0u) { if (xb_ld(&(bar)[XB_TMO])) break; if (_sp > XB_SPIN_CAP) { atomicAdd(&(bar)[XB_TMO], 1u); break; } } } } while (0)

struct XcdBarrier {
    unsigned* bar; unsigned x;
    volatile LAS unsigned* st;
};

__device__ __forceinline__ XcdBarrier xcd_barrier_post(unsigned* bar, volatile LAS unsigned* st) {
    XcdBarrier b; b.bar = bar; b.x = xb_xcc_id(); b.st = st;
    if (threadIdx.x == 0) (void)xb_add(&bar[XB_XCNT(b.x)], 1u);
    return b;
}
__device__ __forceinline__ void xcd_barrier_complete(unsigned* bar, unsigned x, unsigned& nloc, unsigned& nx) {
    const unsigned G = gridDim.x * gridDim.y * gridDim.z;
    unsigned sum, cnt, mine, sp = 0u;
    for (;;) {
        sum = 0u; cnt = 0u; mine = 0u;
#pragma unroll
        for (unsigned j = 0; j < 16; ++j) { const unsigned c = xb_ld(&bar[XB_XCNT(j)]); sum += c; cnt += (c > 0u) ? 1u : 0u; mine = (j == x) ? c : mine; }
        if (sum == G) break;
        __builtin_amdgcn_s_sleep(1);
        if ((++sp & 255u) == 0u) { if (xb_ld(&bar[XB_TMO])) break; if (sp > XB_SPIN_CAP) { atomicAdd(&bar[XB_TMO], 1u); break; } }
    }
    nloc = mine > 0u ? mine : 1u; nx = cnt > 0u ? cnt : 1u;
}

__device__ __forceinline__ void xcd_barrier(const XcdBarrier& b) {
    asm volatile("s_waitcnt vmcnt(0)" ::: "memory");
    __syncthreads();
    if (threadIdx.x == 0) {
        unsigned* bar = b.bar;
        __builtin_amdgcn_s_waitcnt(0);
        unsigned nloc = b.st[0], nx = b.st[1];
        if (nloc == 0u) { xcd_barrier_complete(bar, b.x, nloc, nx); b.st[0] = nloc; b.st[1] = nx; }
        const unsigned old = xb_add(&bar[XB_XSUB(b.x)], 1u);
        const unsigned gen = old / nloc;
        if (old + 1u == (gen + 1u) * nloc) {
            __builtin_amdgcn_fence(__ATOMIC_RELEASE, "agent");
            asm volatile("s_waitcnt vmcnt(0)" ::: "memory");
            const unsigned og = xb_add(&bar[XB_TOP], 1u);
            const unsigned tg = og / nx;
            if (og + 1u == (tg + 1u) * nx) xb_add(&bar[XB_TOPGEN], 1u);
            else XB_SPIN(xb_ld(&bar[XB_TOPGEN]) == tg, bar);
            __builtin_amdgcn_fence(__ATOMIC_ACQUIRE, "agent");
            xb_add(&bar[XB_XGEN(b.x)], 1u);
            asm volatile("s_waitcnt vmcnt(0)" ::: "memory");
        } else {
            XB_SPIN(xb_ld(&bar[XB_XGEN(b.x)]) == gen, bar);
            __builtin_amdgcn_fence(__ATOMIC_ACQUIRE, "agent");
            asm volatile("s_waitcnt vmcnt(0)" ::: "memory");
        }
    }
    __syncthreads();
}


struct TDesc { const float* src; bf16* dst; const float* gain; int ldw, col0, ncol32, kgrp, ngrp, dst_ld, dst_rpg, mode, F, row_off; float scale; int item0, nitem, f8, pad; };
constexpr int NDESC = SIDEJOB ? 10 : 12;

__device__ __forceinline__ void tdesc_set(LAS TDesc* t, int& run, const float* src, bf16* dst, const float* gain, int ldw, int col0, int ncols, int kgrp, int ngrp, int dst_ld, int dst_rpg, int mode, int F, int row_off, float scale, int f8 = 0) {
    t->f8 = f8; t->pad = 0;
    t->src = src; t->dst = dst; t->gain = gain; t->ldw = ldw; t->col0 = col0; t->ncol32 = ncols / 32; t->kgrp = kgrp; t->ngrp = ngrp; t->dst_ld = dst_ld; t->dst_rpg = dst_rpg; t->mode = mode; t->F = F; t->row_off = row_off; t->scale = scale;
    t->item0 = run; t->nitem = (kgrp * ngrp / 64) * (ncols / 32); run += t->nitem;
}
__device__ __forceinline__ void titem_load(const LAS TDesc* t, int it, int lane, f32x4 (&v)[8]) {
    const int ncol32 = t->ncol32, kb = it / ncol32, nb = it - kb * ncol32;
    const float* src = t->src + (size_t)(kb * 64) * t->ldw + t->col0 + nb * 32;
    const int kr = lane >> 3, c4 = lane & 7;
#pragma unroll
    for (int i = 0; i < 8; ++i) v[i] = *(const f32x4*)(src + (size_t)(8 * i + kr) * t->ldw + 4 * c4);
}
__device__ __forceinline__ void titem_store(const LAS TDesc* t, int it, LAS float* scr, int lane, const f32x4 (&v)[8]) {
    const int ncol32 = t->ncol32, kb = it / ncol32, nb = it - kb * ncol32;
    const int k0g = kb * 64, grp = k0g / t->kgrp, k0 = k0g - grp * t->kgrp, nrel0 = nb * 32;
    const int kr = lane >> 3, c4 = lane & 7;
    const float* gp = t->gain; const float sc = t->scale;
#pragma unroll
    for (int i = 0; i < 8; ++i) { const int kk = 8 * i + kr; const float gsc = gp ? gp[k0 + kk] * sc : sc;
        LAS float* d = scr + kk * 33 + 4 * c4; d[0] = v[i][0] * gsc; d[1] = v[i][1] * gsc; d[2] = v[i][2] * gsc; d[3] = v[i][3] * gsc; }
    LDS_WAIT(); asm volatile("" ::: "memory");
    const int c = lane & 7;
#pragma unroll
    for (int j = 0; j < 4; ++j) { const int n = (lane >> 3) + 8 * j; const LAS float* s = scr + (8 * c) * 33 + n;
        const int nrel = nrel0 + n; int drow;
        if (t->mode == 0) drow = nrel;
        else { const int F = t->F, uu = nrel >= F ? 1 : 0, j2 = nrel - uu * F, jl = j2 & 127;
            drow = 256 * (j2 >> 7) + 128 * ((jl >> 2) & 1) + 32 * (jl >> 5) + 16 * uu + 4 * ((jl >> 3) & 3) + (jl & 3); }
        drow += grp * t->dst_rpg + t->row_off;
        if (t->f8) { v2u o; o.x = pg8::pk4_fp8(s[0 * 33], s[1 * 33], s[2 * 33], s[3 * 33]); o.y = pg8::pk4_fp8(s[4 * 33], s[5 * 33], s[6 * 33], s[7 * 33]); *(v2u*)((unsigned char*)t->dst + (size_t)drow * t->dst_ld + k0 + 8 * c) = o; }
        else { v4u o; o.x = pk2(s[0 * 33], s[1 * 33]); o.y = pk2(s[2 * 33], s[3 * 33]); o.z = pk2(s[4 * 33], s[5 * 33]); o.w = pk2(s[6 * 33], s[7 * 33]); *(v4u*)(t->dst + (size_t)drow * t->dst_ld + k0 + 8 * c) = o; } }
    LDS_WAIT(); asm volatile("" ::: "memory");
}
__device__ __forceinline__ void sincos_d(double x, double& s, double& c) {
    const double n = __builtin_rint(x * 0.63661977236758134308);
    double r = __builtin_fma(-n, 1.57079632679489655800e+00, x); r = __builtin_fma(-n, 6.12323399573676603587e-17, r);
    const double r2 = r * r;
    double sp = -1.0 / 1307674368000.0; sp = sp * r2 + 1.0 / 6227020800.0; sp = sp * r2 - 1.0 / 39916800.0; sp = sp * r2 + 1.0 / 362880.0; sp = sp * r2 - 1.0 / 5040.0; sp = sp * r2 + 1.0 / 120.0; sp = sp * r2 - 1.0 / 6.0; sp = sp * r2 + 1.0;
    const double sr = sp * r;
    double cp = 1.0 / 20922789888000.0; cp = cp * r2 - 1.0 / 87178291200.0; cp = cp * r2 + 1.0 / 479001600.0; cp = cp * r2 - 1.0 / 3628800.0; cp = cp * r2 + 1.0 / 40320.0; cp = cp * r2 - 1.0 / 720.0; cp = cp * r2 + 1.0 / 24.0; cp = cp * r2 - 0.5; cp = cp * r2 + 1.0;
    const int q = ((int)n) & 3;
    s = (q == 0) ? sr : (q == 1) ? cp : (q == 2) ? -sr : -cp;
    c = (q == 0) ? cp : (q == 1) ? -sr : (q == 2) ? -cp : sr;
}
__device__ __forceinline__ double inv_freq_d(int i) {
    switch (i) { case 0: return 1.0; case 1: return 0.44036660267178046; case 2: return 0.19392274474868576; case 3: return 0.085397100285765609; case 4: return 0.037606030930863933;
        case 5: return 0.016560440080994446; case 6: return 0.0072926647372171093; case 7: return 0.0032114459947525909; case 8: return 0.001414213562373095; case 9: return 0.00062277242191459599;
        case 10: return 0.0002742481756762073; case 11: return 0.00012076973741146504; case 12: return 5.3182958969449883e-05; case 13: return 2.3419998961409342e-05; case 14: return 1.031338537721246e-05; default: return 4.5416704806078695e-06; }
}
__device__ __forceinline__ void load_row(const float* row, int lane, f32x4 (&v)[4]) {
    const f32x4* xr = (const f32x4*)row + lane;
#pragma unroll
    for (int j = 0; j < 4; ++j) v[j] = xr[64 * j];
}
__device__ __forceinline__ float row_sumsq(const f32x4 (&v)[4]) {
    float s = 0.f;
#pragma unroll
    for (int j = 0; j < 4; ++j) s += (v[j][0] * v[j][0] + v[j][1] * v[j][1]) + (v[j][2] * v[j][2] + v[j][3] * v[j][3]);
    return wave_sum(s);
}
__device__ __forceinline__ void store_row_bf16(bf16* orow, int lane, const f32x4 (&v)[4], float sc) {
    v2u* o8 = (v2u*)orow + lane;
#pragma unroll
    for (int j = 0; j < 4; ++j) { v2u w; w.x = pk2(v[j][0] * sc, v[j][1] * sc); w.y = pk2(v[j][2] * sc, v[j][3] * sc); o8[64 * j] = w; }
}

__device__ __forceinline__ void store_row_fp8(unsigned char* orow, int lane, const f32x4 (&v)[4], float sc) {
    unsigned* o4 = (unsigned*)orow + lane;
#pragma unroll
    for (int j = 0; j < 4; ++j) o4[64 * j] = pg8::pk4_fp8(v[j][0] * sc, v[j][1] * sc, v[j][2] * sc, v[j][3] * sc);
}

constexpr int ML_QS = 0, ML_KS = 17408, ML_KWT = 34816, ML_VT = 53248, ML_SBF = 62464, ML_DD = 79872, ML_MM = 80128, ML_BC = 80384, ML_NV = 80640, ML_END = 81664;
constexpr int ML_SCR = 81920, ML_TD = 150016;
__device__ __forceinline__ void mlstm_phase(LAS unsigned char* lds, const bf16* QKO, const bf16* KVT, const float* GATES, const float* b_if, bf16* Hout, int vcu, int G, int tid) {
    const LAS TDesc* td2 = (const LAS TDesc*)(lds + ML_TD); const int nitems2 = td2[1].item0 + td2[1].nitem;
    LAS float* scr = (LAS float*)(lds + ML_SCR + (tid >> 6) * 8448); int itw = vcu * 8 + (tid >> 6);
    const int lane = tid & 63, w = __builtin_amdgcn_readfirstlane(tid >> 6), l15 = lane & 15, g = lane >> 4;
    const int tt = w & 3, vh = w >> 2;
    for (int unit = vcu; unit < 256; unit += G) {
        const int bh = unit >> 2, vs = unit & 3, b = bh >> 2, h = bh & 3;
        const size_t tok0 = (size_t)b * SEQ;
        const float bi = b_if[h], bfg = b_if[4 + h];
        f32x4 accS[4];
#pragma unroll
        for (int j = 0; j < 4; ++j) accS[j] = (f32x4){0.f, 0.f, 0.f, 0.f};
        float m_s = 0.f;
        for (int i = tid; i < 17408 / 16; i += 512) *(LAS v4u*)(lds + ML_SBF + i * 16) = (v4u){0u, 0u, 0u, 0u};
        if (tid < 256) *(LAS float*)(lds + ML_NV + tid * 4) = 0.f;
        v4u rq[2], rk[2], rt[2], rv; float gi, gf;
#define ML_LOADS(c_) do { const size_t t0_ = tok0 + (size_t)(c_) * CH; \
        _Pragma("unroll") for (int i_ = 0; i_ < 2; ++i_) { const int p_ = tid + 512 * i_; const int r_ = p_ >> 4, cp_ = p_ & 15; const bf16* s_ = QKO + (t0_ + r_) * 2048 + h * 128 + cp_ * 8; rq[i_] = *(const v4u*)s_; rk[i_] = *(const v4u*)(s_ + 1536); \
            const int kk_ = p_ >> 3, sg_ = p_ & 7; rt[i_] = *(const v4u*)(KVT + (size_t)(h * 128 + kk_) * NTOK + t0_ + 8 * sg_); } \
        rv = *(const v4u*)(KVT + (size_t)(512 + h * 256 + vs * 64 + (tid >> 3)) * NTOK + t0_ + 8 * (tid & 7)); \
        gi = GATES[(t0_ + lane) * 8 + h]; gf = GATES[(t0_ + lane) * 8 + 4 + h]; } while (0)
        ML_LOADS(0);
        for (int c = 0; c < NCH; ++c) {
            const size_t t0 = tok0 + (size_t)c * CH;
            const float igv = gi + bi, xf = gf + bfg;
            const float lgf = fminf(xf, 0.f) - log1pf(__expf(-fabsf(xf)));
            float bc = lgf;
#pragma unroll
            for (int o = 1; o < 64; o <<= 1) { const float t = __shfl_up(bc, o); if (lane >= o) bc += t; }
            const float dd = igv - bc;
            float pm = dd;
#pragma unroll
            for (int o = 1; o < 64; o <<= 1) { const float t = __shfl_up(pm, o); if (lane >= o) pm = fmaxf(pm, t); }
            const float mm = fmaxf(m_s, pm);
            const float g_tot = __shfl(bc, 63), mm63 = __shfl(mm, 63);
            const float wgt = __expf(dd - mm63), decay = __expf(m_s - mm63);
            if (w == 0) { *(LAS float*)(lds + ML_DD + lane * 4) = dd; *(LAS float*)(lds + ML_MM + lane * 4) = mm; *(LAS float*)(lds + ML_BC + lane * 4) = bc; }
            {
                float wv[8];
#pragma unroll
                for (int e = 0; e < 8; ++e) wv[e] = __shfl(wgt, 8 * (tid & 7) + e);
#pragma unroll
                for (int i = 0; i < 2; ++i) { const int p = tid + 512 * i; const int r = p >> 4, cp = p & 15;
                    *(LAS v4u*)(lds + ML_QS + r * 272 + cp * 16) = rq[i]; *(LAS v4u*)(lds + ML_KS + r * 272 + cp * 16) = rk[i];
                    const int kk = p >> 3, sg = p & 7; v4u o;
                    o.x = pk2(bflo(rt[i].x) * wv[0], bfhi(rt[i].x) * wv[1]); o.y = pk2(bflo(rt[i].y) * wv[2], bfhi(rt[i].y) * wv[3]);
                    o.z = pk2(bflo(rt[i].z) * wv[4], bfhi(rt[i].z) * wv[5]); o.w = pk2(bflo(rt[i].w) * wv[6], bfhi(rt[i].w) * wv[7]);
                    *(LAS v4u*)(lds + ML_KWT + kk * 144 + sg * 16) = o; }
                *(LAS v4u*)(lds + ML_VT + (tid >> 3) * 144 + (tid & 7) * 16) = rv;
            }
            __syncthreads();
            if (c + 1 < NCH) ML_LOADS(c + 1);
            const int it2 = itw; itw += G * 8; const bool has2 = SIDEJOB && it2 < nitems2; const int d2 = (has2 && it2 >= td2[1].item0) ? 1 : 0;
            f32x4 tv[8]; if (has2) titem_load(td2 + d2, it2 - td2[d2].item0, lane, tv);
            const int cur = c & 1;
            const int t_loc = 16 * tt + l15;
            bf16x8 qf[4];
#pragma unroll
            for (int kp = 0; kp < 4; ++kp) qf[kp] = *(const LAS bf16x8*)(lds + ML_QS + t_loc * 272 + (32 * kp + 8 * g) * 2);
            const float mmt = *(const LAS float*)(lds + ML_MM + t_loc * 4), bct = *(const LAS float*)(lds + ML_BC + t_loc * 4);
            f32x4 P[4]; float psum = 0.f;
#pragma unroll
            for (int i = 0; i < 4; ++i) {
                P[i] = (f32x4){0.f, 0.f, 0.f, 0.f};
                if (i <= tt) {
                    f32x4 a = (f32x4){0.f, 0.f, 0.f, 0.f};
#pragma unroll
                    for (int kp = 0; kp < 4; ++kp) { const bf16x8 kf = *(const LAS bf16x8*)(lds + ML_KS + (16 * i + l15) * 272 + (32 * kp + 8 * g) * 2); a = MFMA16(kf, qf[kp], a); }
                    const f32x4 ddv = *(const LAS f32x4*)(lds + ML_DD + (16 * i + 4 * g) * 4);
#pragma unroll
                    for (int r = 0; r < 4; ++r) { const int s = 16 * i + 4 * g + r; const float pv = (s <= t_loc) ? a[r] * __expf(ddv[r] - mmt) : 0.f; P[i][r] = pv; psum += pv; }
                }
            }
            psum += __shfl_xor(psum, 16); psum += __shfl_xor(psum, 32);
            bf16x8 pf[2];
#pragma unroll
            for (int kp = 0; kp < 2; ++kp) { v4u o; o.x = pk2(P[2 * kp][0], P[2 * kp][1]); o.y = pk2(P[2 * kp][2], P[2 * kp][3]); o.z = pk2(P[2 * kp + 1][0], P[2 * kp + 1][1]); o.w = pk2(P[2 * kp + 1][2], P[2 * kp + 1][3]);
                pf[kp] = __builtin_bit_cast(bf16x8, o); }
            float nqp = 0.f;
#pragma unroll
            for (int kp = 0; kp < 4; ++kp) { const v4u qw = __builtin_bit_cast(v4u, qf[kp]); const LAS float* nv = (const LAS float*)(lds + ML_NV + cur * 512) + 32 * kp + 8 * g;
                const f32x4 n0 = *(const LAS f32x4*)nv, n1 = *(const LAS f32x4*)(nv + 4);
                nqp += bflo(qw.x) * n0[0] + bfhi(qw.x) * n0[1] + bflo(qw.y) * n0[2] + bfhi(qw.y) * n0[3] + bflo(qw.z) * n1[0] + bfhi(qw.z) * n1[1] + bflo(qw.w) * n1[2] + bfhi(qw.w) * n1[3]; }
            nqp += __shfl_xor(nqp, 16); nqp += __shfl_xor(nqp, 32);
            const float iw = __expf(m_s - mmt);
            const float nq = psum + iw * nqp;
            const float den = fmaxf(fabsf(nq), __expf(-(bct + mmt)));
            const float rden = 1.0f / den;
#pragma unroll
            for (int j = 0; j < 2; ++j) {
                const int v_loc = 32 * vh + 16 * j + l15;
                f32x4 ao = (f32x4){0.f, 0.f, 0.f, 0.f}, ai = (f32x4){0.f, 0.f, 0.f, 0.f};
#pragma unroll
                for (int kp = 0; kp < 2; ++kp) if (2 * kp <= tt) {
                    const v2u lo = *(const LAS v2u*)(lds + ML_VT + v_loc * 144 + (32 * kp + 4 * g) * 2), hi = *(const LAS v2u*)(lds + ML_VT + v_loc * 144 + (32 * kp + 16 + 4 * g) * 2);
                    const v4u vv = (v4u){lo.x, lo.y, hi.x, hi.y};
                    ao = MFMA16(__builtin_bit_cast(bf16x8, vv), pf[kp], ao); }
#pragma unroll
                for (int kp = 0; kp < 4; ++kp) { const bf16x8 sf = *(const LAS bf16x8*)(lds + ML_SBF + v_loc * 272 + (32 * kp + 8 * g) * 2); ai = MFMA16(sf, qf[kp], ai); }
                v2u o; o.x = pk2((ao[0] + iw * ai[0]) * rden, (ao[1] + iw * ai[1]) * rden); o.y = pk2((ao[2] + iw * ai[2]) * rden, (ao[3] + iw * ai[3]) * rden);
                *(v2u*)(Hout + (t0 + t_loc) * 1024 + h * 256 + vs * 64 + 32 * vh + 16 * j + 4 * g) = o;
            }
            {
                bf16x8 kf[2];
#pragma unroll
                for (int kp = 0; kp < 2; ++kp) kf[kp] = *(const LAS bf16x8*)(lds + ML_KWT + (16 * w + l15) * 144 + (32 * kp + 8 * g) * 2);
#pragma unroll
                for (int jv = 0; jv < 4; ++jv) { accS[jv] = accS[jv] * decay;
#pragma unroll
                    for (int kp = 0; kp < 2; ++kp) { const bf16x8 vf = *(const LAS bf16x8*)(lds + ML_VT + (16 * jv + l15) * 144 + (32 * kp + 8 * g) * 2); accS[jv] = MFMA16(kf[kp], vf, accS[jv]); } }
            }
            if (tid < 128) { float s = 0.f;
#pragma unroll
                for (int i = 0; i < 8; ++i) { const v4u x = *(const LAS v4u*)(lds + ML_KWT + tid * 144 + i * 16); s += (bflo(x.x) + bfhi(x.x)) + (bflo(x.y) + bfhi(x.y)) + (bflo(x.z) + bfhi(x.z)) + (bflo(x.w) + bfhi(x.w)); }
                const float nold = *(const LAS float*)(lds + ML_NV + cur * 512 + tid * 4);
                *(LAS float*)(lds + ML_NV + (cur ^ 1) * 512 + tid * 4) = decay * nold + s; }
            __syncthreads();
#pragma unroll
            for (int jv = 0; jv < 4; ++jv) { v2u o; o.x = pk2(accS[jv][0], accS[jv][1]); o.y = pk2(accS[jv][2], accS[jv][3]);
                *(LAS v2u*)(lds + ML_SBF + (16 * jv + l15) * 272 + (16 * w + 4 * g) * 2) = o; }
            if (has2) titem_store(td2 + d2, it2 - td2[d2].item0, scr, lane, tv);
            m_s = g_tot + mm63;
        }
        __syncthreads();
#undef ML_LOADS
    }
}

constexpr int AT_K0 = 0, AT_V0 = 34816, AT_KM = 71680, AT_END = 75776;
__device__ __forceinline__ void moba_phase(LAS unsigned char* lds, const bf16* Qb, const bf16* Kb, const bf16* VT, const float* KM, bf16* ATT, int vcu, int G, int tid) {
    const int lane = tid & 63, w = __builtin_amdgcn_readfirstlane(tid >> 6), l15 = lane & 15, g = lane >> 4;
    constexpr float SC2 = 0.08838834764831845f * 1.4426950408889634f;
    const float NEG = -__builtin_inff();
    for (int item = vcu; item < 512; item += G) {
        const int bh = item >> 2, pr = item & 3, b = bh >> 3, h = bh & 7, kvh = h >> 2;
        for (int half = 0; half < 2; ++half) {
            const int qb = half ? pr : 7 - pr;
            const size_t row0 = (size_t)b * SEQ + 256 * qb + 32 * w;
            bf16x8 qf[2][4];
#pragma unroll
            for (int u = 0; u < 2; ++u)
#pragma unroll
                for (int kp = 0; kp < 4; ++kp) qf[u][kp] = *(const bf16x8*)(Qb + (row0 + 16 * u + l15) * 1024 + h * 128 + 32 * kp + 8 * g);
            for (int i = tid; i < 1024; i += 512) { const int n = i >> 7, d = i & 127; *(LAS float*)(lds + AT_KM + i * 4) = KM[(size_t)(b * 8 + n) * 256 + kvh * 128 + d] * (1.0f / 256.0f); }
            const int ntile = 4 * (qb + 1);
            v4u rk[2], rv[2];
#define AT_LOADS(j_) do { const int n_ = (j_) >> 2, kt_ = (j_) & 3; const size_t key0_ = (size_t)b * SEQ + 256 * n_ + 64 * kt_; \
            _Pragma("unroll") for (int i_ = 0; i_ < 2; ++i_) { const int p_ = tid + 512 * i_; rk[i_] = *(const v4u*)(Kb + (key0_ + (p_ >> 4)) * 256 + kvh * 128 + 8 * (p_ & 15)); \
                rv[i_] = *(const v4u*)(VT + (size_t)(kvh * 128 + (p_ >> 3)) * NTOK + key0_ + 8 * (p_ & 7)); } } while (0)
#define AT_STAGE(buf_) do { _Pragma("unroll") for (int i_ = 0; i_ < 2; ++i_) { const int p_ = tid + 512 * i_; \
                *(LAS v4u*)(lds + AT_K0 + (buf_) * 17408 + (p_ >> 4) * 272 + (p_ & 15) * 16) = rk[i_]; \
                const int sg_ = p_ & 7, vo_ = (p_ >> 3) * 144 + (sg_ >> 2) * 64 + (sg_ & 1) * 32 + ((sg_ >> 1) & 1) * 8;     \
                *(LAS v2u*)(lds + AT_V0 + (buf_) * 18432 + vo_) = (v2u){rv[i_].x, rv[i_].y}; *(LAS v2u*)(lds + AT_V0 + (buf_) * 18432 + vo_ + 16) = (v2u){rv[i_].z, rv[i_].w}; } } while (0)
            AT_LOADS(0);
            __syncthreads();
            AT_STAGE(0);
            __syncthreads();
            unsigned sel[2];
#pragma unroll
            for (int u = 0; u < 2; ++u) {
                float gate[7];
#pragma unroll
                for (int n = 0; n < 7; ++n) { gate[n] = NEG;
                    if (n < qb) { float s = 0.f;
#pragma unroll
                        for (int kp = 0; kp < 4; ++kp) { const v4u qw = __builtin_bit_cast(v4u, qf[u][kp]); const LAS float* kmp = (const LAS float*)(lds + AT_KM) + n * 128 + 32 * kp + 8 * g;
                            const f32x4 k0 = *(const LAS f32x4*)kmp, k1 = *(const LAS f32x4*)(kmp + 4);
                            s += bflo(qw.x) * k0[0] + bfhi(qw.x) * k0[1] + bflo(qw.y) * k0[2] + bfhi(qw.y) * k0[3] + bflo(qw.z) * k1[0] + bfhi(qw.z) * k1[1] + bflo(qw.w) * k1[2] + bfhi(qw.w) * k1[3]; }
                        s += __shfl_xor(s, 16); s += __shfl_xor(s, 32); gate[n] = s; } }
                unsigned sm = 0u;
                if (qb <= 3) sm = (1u << qb) - 1u;
                else {
#pragma unroll
                    for (int rnd = 0; rnd < 3; ++rnd) { float bv = NEG; int bi = 0;
#pragma unroll
                        for (int n = 0; n < 7; ++n) { const bool ok = (n < qb) && !((sm >> n) & 1u) && (gate[n] > bv); bv = ok ? gate[n] : bv; bi = ok ? n : bi; }
                        sm |= 1u << bi; }
                }
                sel[u] = sm;
            }
            f32x4 accO[2][8]; float m_run[2], l_run[2];
#pragma unroll
            for (int u = 0; u < 2; ++u) { m_run[u] = -1e30f; l_run[u] = 0.f;
#pragma unroll
                for (int jd = 0; jd < 8; ++jd) accO[u][jd] = (f32x4){0.f, 0.f, 0.f, 0.f}; }
            for (int j = 0; j < ntile; ++j) {
                if (j + 1 < ntile) AT_LOADS(j + 1);
                const int buf = j & 1, n = j >> 2, kt = j & 3; const bool own = (n == qb);
                const bool active = !own || (64 * kt <= 32 * w + 31);
                if (active) {
                    const LAS unsigned char* kb = lds + AT_K0 + buf * 17408; const LAS unsigned char* vb = lds + AT_V0 + buf * 18432;
                    f32x4 S[2][4];
#pragma unroll
                    for (int i = 0; i < 4; ++i) { bf16x8 kf[4];
#pragma unroll
                        for (int kp = 0; kp < 4; ++kp) kf[kp] = *(const LAS bf16x8*)(kb + (16 * i + l15) * 272 + (32 * kp + 8 * g) * 2);
#pragma unroll
                        for (int u = 0; u < 2; ++u) { f32x4 a = (f32x4){0.f, 0.f, 0.f, 0.f};
#pragma unroll
                            for (int kp = 0; kp < 4; ++kp) a = MFMA16(kf[kp], qf[u][kp], a);
                            S[u][i] = a; } }
                    bf16x8 pf[2][2];
#pragma unroll
                    for (int u = 0; u < 2; ++u) {
                        const bool allowed = own || ((sel[u] >> n) & 1u);
                        if (own && (64 * kt + 63 > 32 * w + 16 * u)) {
                            const int qpos = 32 * w + 16 * u + l15;
#pragma unroll
                            for (int i = 0; i < 4; ++i)
#pragma unroll
                                for (int r = 0; r < 4; ++r) { const int kpos = 64 * kt + 16 * i + 4 * g + r; S[u][i][r] = (kpos <= qpos) ? S[u][i][r] : NEG; }
                        }
                        float mx = fmaxf(fmaxf(S[u][0][0], S[u][0][1]), fmaxf(S[u][0][2], S[u][0][3]));
#pragma unroll
                        for (int i = 1; i < 4; ++i) mx = fmaxf(mx, fmaxf(fmaxf(S[u][i][0], S[u][i][1]), fmaxf(S[u][i][2], S[u][i][3])));
                        mx = fmaxf(mx, __shfl_xor(mx, 16)); mx = fmaxf(mx, __shfl_xor(mx, 32));
                        mx = allowed ? mx : NEG;
                        if (__any((mx - m_run[u]) * SC2 > 8.f)) {
                            const float mn = fmaxf(m_run[u], mx);
                            const float alpha = __builtin_amdgcn_exp2f((m_run[u] - mn) * SC2);
                            m_run[u] = mn; l_run[u] *= alpha;
#pragma unroll
                            for (int jd = 0; jd < 8; ++jd) accO[u][jd] = accO[u][jd] * alpha;
                        }
                        const float mb = allowed ? m_run[u] * SC2 : __builtin_inff(); float ps = 0.f;
#pragma unroll
                        for (int i = 0; i < 4; ++i)
#pragma unroll
                            for (int r = 0; r < 4; ++r) { const float p = __builtin_amdgcn_exp2f(S[u][i][r] * SC2 - mb); S[u][i][r] = p; ps += p; }
                        ps += __shfl_xor(ps, 16); ps += __shfl_xor(ps, 32);
                        l_run[u] += ps;
#pragma unroll
                        for (int kp = 0; kp < 2; ++kp) { v4u o; o.x = pk2(S[u][2 * kp][0], S[u][2 * kp][1]); o.y = pk2(S[u][2 * kp][2], S[u][2 * kp][3]); o.z = pk2(S[u][2 * kp + 1][0], S[u][2 * kp + 1][1]); o.w = pk2(S[u][2 * kp + 1][2], S[u][2 * kp + 1][3]);
                            pf[u][kp] = __builtin_bit_cast(bf16x8, o); }
                    }
#pragma unroll
                    for (int jd = 0; jd < 8; ++jd)
#pragma unroll
                        for (int kp = 0; kp < 2; ++kp) {
                            const bf16x8 vf = *(const LAS bf16x8*)(vb + (16 * jd + l15) * 144 + kp * 64 + g * 16);
                            accO[0][jd] = MFMA16(vf, pf[0][kp], accO[0][jd]); accO[1][jd] = MFMA16(vf, pf[1][kp], accO[1][jd]); }
                }
                if (j + 1 < ntile) AT_STAGE(buf ^ 1);
                __syncthreads();
            }
#pragma unroll
            for (int u = 0; u < 2; ++u) { const float rl = 1.0f / l_run[u]; bf16* orow = ATT + (row0 + 16 * u + l15) * 1024 + h * 128 + 4 * g;
#pragma unroll
                for (int jd = 0; jd < 8; ++jd) { v2u o; o.x = pk2(accO[u][jd][0] * rl, accO[u][jd][1] * rl); o.y = pk2(accO[u][jd][2] * rl, accO[u][jd][3] * rl); *(v2u*)(orow + 16 * jd) = o; } }
#undef AT_LOADS
#undef AT_STAGE
        }
    }
}

struct Args { const float* in[18]; float* out; unsigned char* ws; int ph_lo, ph_hi, bar_region, pad; };
__global__ void __launch_bounds__(NWAVES * 64, 2) yoco_fwd(Args args) {
    extern __shared__ __attribute__((aligned(16))) unsigned char lds_raw[];
    LAS unsigned char* lds = (LAS unsigned char*)lds_raw;
    volatile LAS unsigned* MISC = (volatile LAS unsigned*)(lds + MISC_OFF);
    const int tid = threadIdx.x, lane = tid & 63, wave = __builtin_amdgcn_readfirstlane(tid >> 6);
    const int G = gridDim.x; const int bx = blockIdx.x; const int vcu = (G % 8 == 0) ? (bx % 8) * (G / 8) + bx / 8 : bx;
    const int gw = vcu * NWAVES + wave, NGW = G * NWAVES;
    unsigned char* ws = args.ws;
    gu32* ctl = (gu32*)(ws + WS_CTL);
    const float* x_in = args.in[0]; const float* mlstm_norm = args.in[1]; const float* mlstm_w_in = args.in[2]; const float* mlstm_b_if = args.in[3]; const float* mlstm_out_norm = args.in[4];
    const float* mlstm_w_out = args.in[5]; const float* ffn_norm = args.in[6]; const float* dense_w_gu = args.in[7]; const float* dense_w_down = args.in[8]; const float* moe_router = args.in[9];
    const float* moe_w_gu = args.in[10]; const float* moe_w_down = args.in[11]; const float* kv_norm = args.in[12]; const float* kv_w = args.in[13]; const float* moba_norm = args.in[14];
    const float* moba_w_q = args.in[15]; const float* moba_w_o = args.in[16]; const float* final_norm = args.in[17];
    float* X = args.out;
    bf16* Win_t = (bf16*)(ws + WS_WIN); bf16* Wout_t = (bf16*)(ws + WS_WOUT); bf16* Wgu_t = (bf16*)(ws + WS_WGU); bf16* Wdn_t = (bf16*)(ws + WS_WDN);
    bf16* Wqkv_t = (bf16*)(ws + WS_WQKV); bf16* Wo_t = (bf16*)(ws + WS_WO); bf16* Wmgu_t = (bf16*)(ws + WS_WMGU); bf16* Wmdn_t = (bf16*)(ws + WS_WMDN);
    bf16* XN = (bf16*)(ws + WS_A); bf16* XB = (bf16*)(ws + WS_A + 64 * MiB); float* PART = (float*)(ws + WS_PART); float* RS = (float*)(ws + WS_RS); float* MS = (float*)(ws + WS_MS); bf16* APERM = (bf16*)(ws + WS_A); bf16* Y = (bf16*)(ws + WS_A);
    bf16* QKO = (bf16*)(ws + WS_QKO); bf16* KVT = (bf16*)(ws + WS_KVT); bf16* Hb = (bf16*)(ws + WS_H); bf16* ACT = (bf16*)(ws + WS_ACT);
    bf16* Qb = (bf16*)(ws + WS_Q); bf16* Kb = (bf16*)(ws + WS_K); bf16* VTb = (bf16*)(ws + WS_VT); bf16* ATT = (bf16*)(ws + WS_ATT); bf16* ACT2 = (bf16*)(ws + WS_ACT2); bf16* Y2 = (bf16*)(ws + WS_Y2);
    float* KM = (float*)(ws + WS_KM); float* ROPE = (float*)(ws + WS_ROPE); float* GATES = (float*)(ws + WS_GATES);
    unsigned* ME = (unsigned*)(ws + WS_ME); float* MW = (float*)(ws + WS_MW); unsigned* MR = (unsigned*)(ws + WS_MR); unsigned* MP = (unsigned*)(ws + WS_MP);
    unsigned* HIST = (unsigned*)(ws + WS_HIST); unsigned* PB = (unsigned*)(ws + WS_PB);

    for (int u = tid; u < (LDS_BYTES - LDSCTL_OFF) / 4; u += NWAVES * 64) ((LAS unsigned*)(lds + LDSCTL_OFF))[u] = 0u;
    __syncthreads();
    unsigned* barw = (unsigned*)(ctl + CW_BAR) + args.bar_region * XCD_BAR_WORDS;
    XcdBarrier bar; bar.bar = barw; bar.x = 0; bar.st = nullptr;
    if (!MK_PER_PHASE) bar = xcd_barrier_post(barw, MISC + 8);
    const int lo = args.ph_lo, hi = args.ph_hi;
#define IN(k) (lo <= (k) && (k) < hi)
#define SEAM(k) do { if (IN(k) && IN((k) + 1)) { if (MK_PER_PHASE) { if (tid == 0) __hip_atomic_store(ctl, 0xBADBA0u, RLX_AGENT); } else xcd_barrier(bar); } } while (0)

    if (IN(0)) {
        LAS TDesc* td = (LAS TDesc*)(lds + 8 * 8448);
        if (tid == 0) { int run = 0;
            tdesc_set(td + 0, run, dense_w_gu, Wgu_t, ffn_norm, 5632, 0, 5632, 1024, 1, 1024, 0, 1, DFF, 0, DENSE_F8 ? WGU_SC : 1.f, DENSE_F8);
            tdesc_set(td + 1, run, dense_w_down, Wdn_t, nullptr, 1024, 0, 1024, DFF, 1, DFF, 0, 0, 0, 0, DOWN_F8 ? WDN_SC : 1.f, DOWN_F8);
            tdesc_set(td + 2, run, mlstm_w_in, Win_t, mlstm_norm, WIN_LD, 0, 512, 1024, 1, 1024, 0, 0, 0, 0, 0.08838834764831845f);
            tdesc_set(td + 3, run, mlstm_w_in, Win_t, mlstm_norm, WIN_LD, 512, 512, 1024, 1, 1024, 0, 0, 0, 1536, 1.f);
            tdesc_set(td + 4, run, mlstm_w_in, Win_t, mlstm_norm, WIN_LD, 1024, 1024, 1024, 1, 1024, 0, 0, 0, 2048, 1.f);
            tdesc_set(td + 5, run, mlstm_w_in, Win_t, mlstm_norm, WIN_LD, 2048, 1024, 1024, 1, 1024, 0, 0, 0, 512, 1.f);
            tdesc_set(td + 6, run, mlstm_w_out, Wout_t, nullptr, 1024, 0, 1024, 1024, 1, 1024, 0, 0, 0, 0, 1.f);
            tdesc_set(td + 7, run, moba_w_q, Wqkv_t, moba_norm, 1024, 0, 1024, 1024, 1, 1024, 0, 0, 0, 0, 1.f);
            tdesc_set(td + 8, run, kv_w, Wqkv_t, kv_norm, 512, 0, 512, 1024, 1, 1024, 0, 0, 0, 1024, 1.f);
            tdesc_set(td + 9, run, moba_w_o, Wo_t, nullptr, 1024, 0, 1024, 1024, 1, 1024, 0, 0, 0, 0, 1.f);
            if (!SIDEJOB) {
                tdesc_set(td + 10, run, moe_w_gu, Wmgu_t, ffn_norm + 1024, 7168, 0, 7168, 1024, 8, 1024, 7168, 1, DEXP, 0, MOE_F8 ? WGU_SC : 1.f, MOE_F8);
                tdesc_set(td + 11, run, moe_w_down, Wmdn_t, nullptr, 1024, 0, 1024, DEXP, 8, DEXP, 1024, 0, 0, 0, MOE_F8 ? WDN_SC : 1.f, MOE_F8); }
        }
        __syncthreads();
        const int nitems = td[NDESC - 1].item0 + td[NDESC - 1].nitem;
        LAS float* scr = (LAS float*)(lds + wave * 8448);
        {
            f32x4 va[8], vb[8]; int it = gw, da = 0, db = 0;
#define TD_FIND(it_, d_) do { d_ = 0; _Pragma("unroll") for (int q = 1; q < NDESC; ++q) d_ += ((it_) >= td[q].item0) ? 1 : 0; } while (0)
            if (it < nitems) { TD_FIND(it, da); titem_load(td + da, it - td[da].item0, lane, va); }
            while (it < nitems) {
                int nx = it + NGW;
                if (nx < nitems) { TD_FIND(nx, db); titem_load(td + db, nx - td[db].item0, lane, vb); }
                titem_store(td + da, it - td[da].item0, scr, lane, va);
                it = nx; if (it >= nitems) break;
                nx = it + NGW;
                if (nx < nitems) { TD_FIND(nx, da); titem_load(td + da, nx - td[da].item0, lane, va); }
                titem_store(td + db, it - td[db].item0, scr, lane, vb);
                it = nx;
            }
#undef TD_FIND
        }
        for (int i = vcu * 512 + tid; i < 2048 * 16; i += G * 512) { const int pos = i >> 4, fi = i & 15; double s, c; sincos_d((double)pos * inv_freq_d(fi), s, c); ROPE[pos * 32 + fi] = (float)c; ROPE[pos * 32 + 16 + fi] = (float)s; }
        {
            float wg[4][4][8];
#pragma unroll
            for (int j = 0; j < 4; ++j)
#pragma unroll
                for (int e = 0; e < 4; ++e) { const int k = 4 * lane + 256 * j + e; const float gk = mlstm_norm[k]; const f32x4 a = *(const f32x4*)(mlstm_w_in + (size_t)k * WIN_LD + 3072), bq = *(const f32x4*)(mlstm_w_in + (size_t)k * WIN_LD + 3076);
#pragma unroll
                    for (int c = 0; c < 4; ++c) { wg[j][e][c] = a[c] * gk; wg[j][e][4 + c] = bq[c] * gk; } }
            for (int m = gw; m < NTOK; m += NGW) {
                f32x4 v[4]; load_row(x_in + (size_t)m * DM, lane, v);
                const float rinv = 1.0f / sqrtf(row_sumsq(v) * (1.0f / DM) + EPS);
                store_row_bf16(XN + (size_t)m * DM, lane, v, rinv);
                float gs[8];
#pragma unroll
                for (int c = 0; c < 8; ++c) { float s = 0.f;
#pragma unroll
                    for (int j = 0; j < 4; ++j)
#pragma unroll
                        for (int e = 0; e < 4; ++e) s += v[j][e] * wg[j][e][c];
                    gs[c] = wave_sum(s) * rinv; }
                float mine = gs[0];
#pragma unroll
                for (int c = 1; c < 8; ++c) mine = (lane == c) ? gs[c] : mine;
                if (lane < 8) GATES[(size_t)m * 8 + lane] = mine;
            }
        }
    }
    SEAM(0);

    if (IN(1)) {
        { pg8::Gemm gm{XN, Win_t, NTOK, 2048, DM}; pg8::StaticOrder S; S.init(NTOK, 2048, G, bx); pg8::EpiStore E{QKO, 2048};
          pg8::gemm_phase<pg8::EpiStore, pg8::StaticOrder, true, true>(lds + RING_OFF, gm, S, E); }
        __syncthreads();
        { pg8::Gemm gm{Win_t + (size_t)1536 * DM, XN, 1536, NTOK, DM}; pg8::StaticOrder S; S.init(1536, NTOK, G, bx); pg8::EpiStore E{KVT, NTOK};
          pg8::gemm_phase<pg8::EpiStore, pg8::StaticOrder, true, true>(lds + RING_OFF, gm, S, E); }
    }
    SEAM(1);

    if (IN(2)) { __syncthreads();
        if (tid == 0) { LAS TDesc* td2 = (LAS TDesc*)(lds + ML_TD); int run = 0;
            tdesc_set(td2 + 0, run, moe_w_gu, Wmgu_t, ffn_norm + 1024, 7168, 0, 7168, 1024, 8, 1024, 7168, 1, DEXP, 0, MOE_F8 ? WGU_SC : 1.f, MOE_F8);
            tdesc_set(td2 + 1, run, moe_w_down, Wmdn_t, nullptr, 1024, 0, 1024, DEXP, 8, DEXP, 1024, 0, 0, 0, MOE_F8 ? WDN_SC : 1.f, MOE_F8); }
        __syncthreads();
        if (wave >= 4) __builtin_amdgcn_s_setprio(1);
        mlstm_phase(lds, QKO, KVT, GATES, mlstm_b_if, Hb, vcu, G, tid); __builtin_amdgcn_s_setprio(0); }
    SEAM(2);

    if (IN(3)) {
        float og[16];
#pragma unroll
        for (int i = 0; i < 16; ++i) og[i] = mlstm_out_norm[16 * lane + i];
        for (int m0 = gw; m0 < NTOK; m0 += 2 * NGW) {
            const int mm[2] = {m0, (m0 + NGW < NTOK) ? m0 + NGW : m0};
            v4u hh[2][2], oo[2][2];
#pragma unroll
            for (int r = 0; r < 2; ++r) { const size_t m = (size_t)mm[r];
                hh[r][0] = *(const v4u*)(Hb + m * 1024 + 16 * lane); hh[r][1] = *(const v4u*)(Hb + m * 1024 + 16 * lane + 8);
                oo[r][0] = *(const v4u*)(QKO + m * 2048 + 512 + 16 * lane); oo[r][1] = *(const v4u*)(QKO + m * 2048 + 512 + 16 * lane + 8); }
#pragma unroll
            for (int r = 0; r < 2; ++r) { const size_t m = (size_t)mm[r];
                float hv[16], ov[16];
#pragma unroll
                for (int q = 0; q < 2; ++q) { const v4u hw = hh[r][q], ow = oo[r][q];
                    hv[8 * q + 0] = bflo(hw.x); hv[8 * q + 1] = bfhi(hw.x); hv[8 * q + 2] = bflo(hw.y); hv[8 * q + 3] = bfhi(hw.y); hv[8 * q + 4] = bflo(hw.z); hv[8 * q + 5] = bfhi(hw.z); hv[8 * q + 6] = bflo(hw.w); hv[8 * q + 7] = bfhi(hw.w);
                    ov[8 * q + 0] = bflo(ow.x); ov[8 * q + 1] = bfhi(ow.x); ov[8 * q + 2] = bflo(ow.y); ov[8 * q + 3] = bfhi(ow.y); ov[8 * q + 4] = bflo(ow.z); ov[8 * q + 5] = bfhi(ow.z); ov[8 * q + 6] = bflo(ow.w); ov[8 * q + 7] = bfhi(ow.w); }
                float s = 0.f;
#pragma unroll
                for (int i = 0; i < 16; ++i) s += hv[i] * hv[i];
                s += __shfl_xor(s, 1); s += __shfl_xor(s, 2); s += __shfl_xor(s, 4); s += __shfl_xor(s, 8);
                const float rinv = 1.0f / sqrtf(s * (1.0f / DV) + EPS);
                float rr[16];
#pragma unroll
                for (int i = 0; i < 16; ++i) rr[i] = hv[i] * rinv * og[i] * __builtin_amdgcn_rcpf(1.0f + __expf(-ov[i]));
                v4u w0, w1; w0.x = pk2(rr[0], rr[1]); w0.y = pk2(rr[2], rr[3]); w0.z = pk2(rr[4], rr[5]); w0.w = pk2(rr[6], rr[7]); w1.x = pk2(rr[8], rr[9]); w1.y = pk2(rr[10], rr[11]); w1.z = pk2(rr[12], rr[13]); w1.w = pk2(rr[14], rr[15]);
                *(v4u*)(XN + m * 1024 + 16 * lane) = w0; *(v4u*)(XN + m * 1024 + 16 * lane + 8) = w1; }
        }
    }
    SEAM(3);

    if (IN(4)) { pg8::Gemm gm{XN, Wout_t, NTOK, DM, DM}; pg8::StaticOrder S; S.init(NTOK, DM, G, bx); pg8::EpiRes<true> E{x_in, X, XB, PART};
        pg8::gemm_phase<pg8::EpiRes<true>, pg8::StaticOrder, true, true>(lds + RING_OFF, gm, S, E); }
    SEAM(4);

#define ROW_SCALES() do { for (int row = vcu * 512 + tid; row < NTOK; row += G * 512) { const f32x4* pp = (const f32x4*)(PART + (size_t)row * 16); const f32x4 p0 = pp[0], p1 = pp[1], p2 = pp[2], p3 = pp[3]; \
        const float s_ = (((p0[0] + p0[1]) + (p0[2] + p0[3])) + ((p1[0] + p1[1]) + (p1[2] + p1[3]))) + (((p2[0] + p2[1]) + (p2[2] + p2[3])) + ((p3[0] + p3[1]) + (p3[2] + p3[3]))); \
        const float ms_ = s_ * (1.0f / DM) + EPS; MS[row] = ms_; RS[row] = 1.0f / sqrtf(ms_); } } while (0)
    if (IN(5)) { ROW_SCALES(); }
    SEAM(5);

    if (IN(6)) { pg8::Gemm gm{XB, Wgu_t, NTOK, 2 * DFF, DM}; pg8::StaticOrder S; S.init(NTOK, 2 * DFF, G, bx); pg8::EpiSwiglu<DOWN_F8 != 0, true> E{ACT, DFF, 1.f, DOWN_F8 ? ACT_SC : 1.f, RS, MS};
        pg8::gemm_phase<pg8::EpiSwiglu<DOWN_F8 != 0, true>, pg8::StaticOrder, true, true>(lds + RING_OFF, gm, S, E); }
    SEAM(6);

    if (IN(7)) { pg8::Gemm gm{ACT, Wdn_t, NTOK, DM, DOWN_F8 ? DFF / 2 : DFF}; pg8::StaticOrder S; S.init(NTOK, DM, G, bx); pg8::EpiRes<true, DOWN_F8 ? 10 : 0> E{X, X, XB, PART};
        static_assert(ACT_SC * WDN_SC == 1024.f, "P7 epilogue shift");
        pg8::gemm_phase<pg8::EpiRes<true, DOWN_F8 ? 10 : 0>, pg8::StaticOrder, true, true, DOWN_F8 != 0>(lds + RING_OFF, gm, S, E); }
    SEAM(7);

    if (IN(8)) { ROW_SCALES(); }
    SEAM(8);

    if (IN(9)) {
        constexpr long TSTEP = 256L * DM * 2;
        constexpr long WS_XB = (long)WS_A + 64L * 1048576L;
        static_assert(((long)WS_WQKV + 1280L * DM * 2 - WS_XB) % TSTEP == 0 && (WS_XB - (long)WS_WQKV) % TSTEP == 0, "swapped-unit tile offsets");
        pg8::QkvOrder S; S.so.init(NTOK, 1280, G, bx); S.G = G; S.c = bx; S.nnorm = (NTOK / 256) * 5; S.nsw = NTOK / 256;
        S.swA = (int)(((long)WS_WQKV + 1280L * DM * 2 - WS_XB) / TSTEP); S.swB = (int)((WS_XB - (long)WS_WQKV) / TSTEP);
        pg8::Gemm gm{XB, Wqkv_t, NTOK, 1280, DM}; pg8::EpiRope E{Qb, Kb, KM, ROPE, VTb, NTOK, S.swB, RS};
        pg8::gemm_phase<pg8::EpiRope, pg8::QkvOrder, true, true>(lds + RING_OFF, gm, S, E);
    }
    SEAM(9);

    if (IN(10)) { __syncthreads(); if (wave >= 4) __builtin_amdgcn_s_setprio(1);
        moba_phase(lds, Qb, Kb, VTb, KM, ATT, vcu, G, tid); __builtin_amdgcn_s_setprio(0); }
    SEAM(10);

    if (IN(11)) { pg8::Gemm gm{ATT, Wo_t, NTOK, DM, DM}; pg8::StaticOrder S; S.init(NTOK, DM, G, bx); pg8::EpiRes<false> E{X, X, nullptr, nullptr};
        pg8::gemm_phase<pg8::EpiRes<false>, pg8::StaticOrder, true, true>(lds + RING_OFF, gm, S, E); }
    SEAM(11);

    constexpr int ROWC_OFF = 16384;
    const bool rowcache = MOE_F8 && G == 256 && IN(12) && IN(13);
    if (IN(12)) {
        __syncthreads();
        float wr8[4][4][8];
#pragma unroll
        for (int j = 0; j < 4; ++j)
#pragma unroll
            for (int e = 0; e < 4; ++e) { const int k = 4 * lane + 256 * j + e; const float gk = ffn_norm[1024 + k]; const f32x4 a = *(const f32x4*)(moe_router + (size_t)k * 8), bq = *(const f32x4*)(moe_router + (size_t)k * 8 + 4);
#pragma unroll
                for (int c = 0; c < 4; ++c) { wr8[j][e][c] = a[c] * gk; wr8[j][e][4 + c] = bq[c] * gk; } }
        LAS unsigned* le = (LAS unsigned*)lds;
        for (int chunk = vcu; chunk < 256; chunk += G) {
            for (int i = 0; i < 16; ++i) { const int tl = 16 * wave + i; const size_t m = (size_t)chunk * 128 + tl;
                f32x4 v[4]; load_row(X + m * DM, lane, v);
                const float rinv = 1.0f / sqrtf(row_sumsq(v) * (1.0f / DM) + EPS);
                float lg[8];
#pragma unroll
                for (int c = 0; c < 8; ++c) { float s = 0.f;
#pragma unroll
                    for (int j = 0; j < 4; ++j)
#pragma unroll
                        for (int e = 0; e < 4; ++e) s += v[j][e] * wr8[j][e][c];
                    lg[c] = wave_sum(s) * rinv; }
                int e1 = 0; float l1 = lg[0];
#pragma unroll
                for (int c = 1; c < 8; ++c) { const bool gt = lg[c] > l1; l1 = gt ? lg[c] : l1; e1 = gt ? c : e1; }
                int e2 = -1; float l2 = -__builtin_inff();
#pragma unroll
                for (int c = 0; c < 8; ++c) { const bool gt = (c != e1) && (lg[c] > l2); l2 = gt ? lg[c] : l2; e2 = gt ? c : e2; }
                const float w2 = 1.0f / (1.0f + __expf(l1 - l2)), w1 = 1.0f - w2;
                if (rowcache) { LAS unsigned* rc = (LAS unsigned*)(lds + ROWC_OFF + tl * 1024) + lane; const float qs = rinv * XA_SC;
#pragma unroll
                    for (int j = 0; j < 4; ++j) rc[64 * j] = pg8::pk4_fp8(v[j][0] * qs, v[j][1] * qs, v[j][2] * qs, v[j][3] * qs); }
                if (lane == 0) { le[tl] = (unsigned)e1 | ((unsigned)e2 << 8); ME[m] = (unsigned)e1 | ((unsigned)e2 << 8); MW[2 * m] = w1; MW[2 * m + 1] = w2; }
            }
            __syncthreads();
            if (tid < 128) { const unsigned mine = le[tid]; const unsigned a1 = mine & 255u, a2 = mine >> 8; unsigned r1 = 0, r2 = 0;
                for (int j = 0; j < tid; ++j) { const unsigned o = le[j]; const unsigned b1 = o & 255u, b2 = o >> 8; r1 += (b1 == a1) + (b2 == a1); r2 += (b1 == a2) + (b2 == a2); }
                MR[(size_t)chunk * 128 + tid] = r1 | (r2 << 16); }
            else if (tid < 136) { const unsigned ex = tid - 128; unsigned cnt = 0;
                for (int j = 0; j < 128; ++j) { const unsigned o = le[j]; cnt += ((o & 255u) == ex) + ((o >> 8) == ex); }
                HIST[chunk * 8 + ex] = cnt; }
            __syncthreads();
        }
    }
    SEAM(12);

    if (IN(13)) {
        __syncthreads();
        LAS unsigned* lh = (LAS unsigned*)lds;
        LAS unsigned* pre4 = (LAS unsigned*)(lds + 8192);
        LAS unsigned* cnt = (LAS unsigned*)(lds + 8192 + 2048);
        LAS unsigned* cpre = (LAS unsigned*)(lds + 8192 + 2048 + 64);
        for (int i = tid; i < 2048; i += 512) lh[i] = HIST[i];
        __syncthreads();
        { const int ex = wave; unsigned s4 = lh[(4 * lane) * 8 + ex] + lh[(4 * lane + 1) * 8 + ex] + lh[(4 * lane + 2) * 8 + ex] + lh[(4 * lane + 3) * 8 + ex]; unsigned inc = s4;
#pragma unroll
          for (int o = 1; o < 64; o <<= 1) { const unsigned t = __shfl_up(inc, o); if (lane >= o) inc += t; }
          pre4[ex * 64 + lane] = inc - s4; if (lane == 63) cnt[ex] = inc; }
        __syncthreads();
        unsigned mybase = 0u; { unsigned run = 0;
#pragma unroll
            for (int e = 0; e < 8; ++e) { if (e == tid) mybase = run; run += (cnt[e] + 255u) & ~255u; }
            if (vcu == 0 && tid < 8) PB[tid] = mybase >> 8;
            if (vcu == 0 && tid == 0) PB[8] = run >> 8; }
        for (int chunk = vcu; chunk < 256; chunk += G) {
            if (tid < 8) { unsigned p = pre4[tid * 64 + (chunk >> 2)]; for (int c2 = chunk & ~3; c2 < chunk; ++c2) p += lh[c2 * 8 + tid]; cpre[tid] = p + mybase; }
            __syncthreads();
            for (int i = 0; i < 16; ++i) { const size_t m = (size_t)chunk * 128 + 16 * wave + i;
                const unsigned me = ME[m], mr = MR[m]; const unsigned e1 = me & 255u, e2 = me >> 8;
                const unsigned s1 = cpre[e1] + (mr & 0xffffu), s2 = cpre[e2] + (mr >> 16);
                if (rowcache) { const LAS unsigned* rc = (const LAS unsigned*)(lds + ROWC_OFF + (16 * wave + i) * 1024) + lane;
                    unsigned* o1 = (unsigned*)((unsigned char*)APERM + (size_t)s1 * DM) + lane; unsigned* o2 = (unsigned*)((unsigned char*)APERM + (size_t)s2 * DM) + lane;
#pragma unroll
                    for (int j = 0; j < 4; ++j) { const unsigned w = rc[64 * j]; o1[64 * j] = w; o2[64 * j] = w; } }
                else {
                f32x4 v[4]; load_row(X + m * DM, lane, v);
                const float rinv = 1.0f / sqrtf(row_sumsq(v) * (1.0f / DM) + EPS);
                if (MOE_F8) { store_row_fp8((unsigned char*)APERM + (size_t)s1 * DM, lane, v, rinv * XA_SC); store_row_fp8((unsigned char*)APERM + (size_t)s2 * DM, lane, v, rinv * XA_SC); }
                else { store_row_bf16(APERM + (size_t)s1 * DM, lane, v, rinv); store_row_bf16(APERM + (size_t)s2 * DM, lane, v, rinv); } }
                if (lane == 0) { MP[2 * m] = s1; MP[2 * m + 1] = s2; } }
            __syncthreads();
        }
    }
    SEAM(13);

    if (IN(14)) { const int npan = (int)PB[8];
        pg8::MoeOrder S; S.so.init(npan * 256, 2 * DEXP, G, bx); S.nct = 2 * DEXP / 256; S.pb1 = PB[1]; S.pb2 = PB[2]; S.pb3 = PB[3]; S.pb4 = PB[4]; S.pb5 = PB[5]; S.pb6 = PB[6]; S.pb7 = PB[7];
        pg8::Gemm gm{APERM, Wmgu_t, npan * 256, 2 * DEXP, MOE_F8 ? DM / 2 : DM};
#ifdef PROBE_NULL_EPI
        if (args.pad) { pg8::EpiNull E{(float*)(ws + WS_PART)}; pg8::gemm_phase<pg8::EpiNull, pg8::MoeOrder, true, true, MOE_F8 != 0>(lds + RING_OFF, gm, S, E); } else
#endif
        { pg8::EpiSwiglu<MOE_F8 != 0> E{ACT2, DEXP, MOE_F8 ? 1.f / (XA_SC * WGU_SC) : 1.f, MOE_F8 ? ACT_SC : 1.f, nullptr, nullptr};
        pg8::gemm_phase<pg8::EpiSwiglu<MOE_F8 != 0>, pg8::MoeOrder, true, true, MOE_F8 != 0>(lds + RING_OFF, gm, S, E); } }
    SEAM(14);

    if (IN(15)) { const int npan = (int)PB[8]; const int nmain = npan < 256 ? npan : 256; constexpr int KU = MOE_F8 ? DEXP / 2 : DEXP;
        { pg8::MoeOrder S; S.so.init(nmain * 256, DM, G, bx); S.nct = DM / 256; S.pb1 = PB[1]; S.pb2 = PB[2]; S.pb3 = PB[3]; S.pb4 = PB[4]; S.pb5 = PB[5]; S.pb6 = PB[6]; S.pb7 = PB[7];
          pg8::Gemm gm{ACT2, Wmdn_t, nmain * 256, DM, KU}; pg8::EpiStore E{Y, DM};
          pg8::gemm_phase<pg8::EpiStore, pg8::MoeOrder, true, true, MOE_F8 != 0>(lds + RING_OFF, gm, S, E); }
        if (npan > nmain) {
            __syncthreads();
            pg8::TailOrder T; T.c = bx; T.ntail = (npan - nmain) * 4; T.pm0 = nmain; T.nct = DM / 256; T.pb1 = PB[1]; T.pb2 = PB[2]; T.pb3 = PB[3]; T.pb4 = PB[4]; T.pb5 = PB[5]; T.pb6 = PB[6]; T.pb7 = PB[7];
            const int half = bx & 1; const size_t koff = half ? (size_t)(KU / 2) : 0;
            pg8::Gemm gt{ACT2 + koff, Wmdn_t + koff, npan * 256, DM, KU, KU / 2};
            pg8::EpiStore E2{half ? Y2 - (size_t)nmain * 256 * DM : Y, DM};
            pg8::gemm_phase<pg8::EpiStore, pg8::TailOrder, true, true, MOE_F8 != 0>(lds + RING_OFF, gt, T, E2);
        }
    }
    SEAM(15);

    if (IN(16)) {
        f32x4 fg[4]; load_row(final_norm, lane, fg);
        const bool bad = (__hip_atomic_load(ctl, RLX_AGENT) != 0u) || (__hip_atomic_load((gu32*)(barw + XB_TMO), RLX_AGENT) != 0u);
        const float ysc = MOE_F8 ? 1.f / (ACT_SC * WDN_SC) : 1.f;
        for (int m0 = gw; m0 < NTOK; m0 += 2 * NGW) {
            const int mm[2] = {m0, (m0 + NGW < NTOK) ? m0 + NGW : m0};
            f32x4 v[2][4]; v2u ya[2][4], yb[2][4]; float w1[2], w2[2]; unsigned s1v[2], s2v[2];
#pragma unroll
            for (int r = 0; r < 2; ++r) { const size_t m = (size_t)mm[r]; load_row(X + m * DM, lane, v[r]);
                const unsigned s1 = MP[2 * m], s2 = MP[2 * m + 1]; s1v[r] = s1; s2v[r] = s2; w1[r] = MW[2 * m] * ysc; w2[r] = MW[2 * m + 1] * ysc;
                const v2u* y1 = (const v2u*)(Y + (size_t)s1 * DM) + lane; const v2u* y2 = (const v2u*)(Y + (size_t)s2 * DM) + lane;
#pragma unroll
                for (int j = 0; j < 4; ++j) { ya[r][j] = y1[64 * j]; yb[r][j] = y2[64 * j]; } }
#pragma unroll
            for (int r = 0; r < 2; ++r) {
#pragma unroll
                for (int j = 0; j < 4; ++j) { const v2u a = ya[r][j], bq = yb[r][j];
                    v[r][j][0] += w1[r] * bflo(a.x) + w2[r] * bflo(bq.x); v[r][j][1] += w1[r] * bfhi(a.x) + w2[r] * bfhi(bq.x); v[r][j][2] += w1[r] * bflo(a.y) + w2[r] * bflo(bq.y); v[r][j][3] += w1[r] * bfhi(a.y) + w2[r] * bfhi(bq.y); }
                if (s1v[r] >= 65536u) { const v2u* t = (const v2u*)(Y2 + (size_t)(s1v[r] - 65536u) * DM) + lane;
#pragma unroll
                    for (int j = 0; j < 4; ++j) { const v2u a = t[64 * j]; v[r][j][0] += w1[r] * bflo(a.x); v[r][j][1] += w1[r] * bfhi(a.x); v[r][j][2] += w1[r] * bflo(a.y); v[r][j][3] += w1[r] * bfhi(a.y); } }
                if (s2v[r] >= 65536u) { const v2u* t = (const v2u*)(Y2 + (size_t)(s2v[r] - 65536u) * DM) + lane;
#pragma unroll
                    for (int j = 0; j < 4; ++j) { const v2u a = t[64 * j]; v[r][j][0] += w2[r] * bflo(a.x); v[r][j][1] += w2[r] * bfhi(a.x); v[r][j][2] += w2[r] * bflo(a.y); v[r][j][3] += w2[r] * bfhi(a.y); } }
                const float rinv = 1.0f / sqrtf(row_sumsq(v[r]) * (1.0f / DM) + EPS);
                f32x4* o = (f32x4*)(X + (size_t)mm[r] * DM) + lane;
#pragma unroll
                for (int j = 0; j < 4; ++j) { f32x4 rr = v[r][j] * rinv * fg[j]; if (bad) rr = (f32x4){__builtin_nanf(""), __builtin_nanf(""), __builtin_nanf(""), __builtin_nanf("")}; o[64 * j] = rr; } }
        }
    }
#undef IN
#undef SEAM
}

extern "C" void kernel_launch(void* const* d_in, const int* in_sizes, int n_in, void* d_out, int out_size, void* d_ws, size_t ws_size, hipStream_t stream) {
    static int grid = 0;
    if (grid == 0) {
        if (n_in != 18 || in_sizes[0] != NTOK * DM || out_size != NTOK * DM || ws_size < WS_END) { fprintf(stderr, "kernel_launch: unexpected shapes / workspace (n_in %d, in0 %d, out %d, ws %zu, need %zu)\n", n_in, n_in > 0 ? in_sizes[0] : -1, out_size, ws_size, (size_t)WS_END); grid = -1; return; }
        int dev = 0, cus = 0, per_cu = 0;
        if (hipGetDevice(&dev) != hipSuccess || hipDeviceGetAttribute(&cus, hipDeviceAttributeMultiprocessorCount, dev) != hipSuccess) { grid = -1; return; }
        if (hipFuncSetAttribute((const void*)yoco_fwd, hipFuncAttributeMaxDynamicSharedMemorySize, LDS_BYTES) != hipSuccess) { fprintf(stderr, "kernel_launch: hipFuncSetAttribute failed\n"); grid = -1; return; }
        if (hipOccupancyMaxActiveBlocksPerMultiprocessor(&per_cu, (const void*)yoco_fwd, NWAVES * 64, LDS_BYTES) != hipSuccess || per_cu < 1) fprintf(stderr, "kernel_launch: occupancy query reports %d workgroups per CU\n", per_cu);
        (void)hipGetLastError();
        grid = cus < 256 ? cus : 256;
    }
    if (grid < 0) return;
    if (hipMemsetAsync((char*)d_ws + WS_CTL, 0, CTL_ZERO_BYTES, stream) != hipSuccess) return;
    Args a{};
    for (int i = 0; i < 18; ++i) a.in[i] = (const float*)d_in[i];
    a.out = (float*)d_out; a.ws = (unsigned char*)d_ws;
#if MK_PER_PHASE
    for (int p = 0; p < NPHASE; ++p) { a.ph_lo = p; a.ph_hi = p + 1; hipLaunchKernelGGL(yoco_fwd, dim3(grid), dim3(NWAVES * 64), LDS_BYTES, stream, a); }
#elif MK_DUP >= 0
#ifndef MK_DUP_N
#define MK_DUP_N 1
#endif
    a.ph_lo = 0; a.ph_hi = MK_DUP + 1; a.bar_region = 0; hipLaunchKernelGGL(yoco_fwd, dim3(grid), dim3(NWAVES * 64), LDS_BYTES, stream, a);
    for (int r = 0; r < MK_DUP_N; ++r) { a.ph_lo = MK_DUP; a.ph_hi = MK_DUP + 1; a.bar_region = 1;
#ifdef PROBE_NULL_EPI
        a.pad = 1;
#endif
        hipLaunchKernelGGL(yoco_fwd, dim3(grid), dim3(NWAVES * 64), LDS_BYTES, stream, a); }
    a.pad = 0;
    if (MK_DUP + 1 < NPHASE) { a.ph_lo = MK_DUP + 1; a.ph_hi = NPHASE; a.bar_region = 2; hipLaunchKernelGGL(yoco_fwd, dim3(grid), dim3(NWAVES * 64), LDS_BYTES, stream, a); }
#else
    a.ph_lo = 0; a.ph_hi = NPHASE; hipLaunchKernelGGL(yoco_fwd, dim3(grid), dim3(NWAVES * 64), LDS_BYTES, stream, a);
#endif
}
```

```cpp
#include <hip/hip_runtime.h>
#include <cstdio>
#include <cstdint>
namespace pg8 {
#define PG8_LAS __attribute__((address_space(3)))
typedef unsigned short bf16_t;
typedef short bf16x8 __attribute__((ext_vector_type(8)));
typedef float f32x4 __attribute__((ext_vector_type(4)));
typedef unsigned u32x4 __attribute__((ext_vector_type(4)));
constexpr int BM = 256, BK = 64, HALF = 128, HTB = HALF * BK * 2  , STAGE_BYTES = 8 * HTB, NXCD = 8, WGM = 8;

__host__ __device__ __forceinline__ int lds_byte(int r, int c) { const int st = (r >> 4) * 2 + (c >> 5), rr = r & 15, cc = c & 31, ob = rr * 64 + cc * 2; return st * 1024 + (ob ^ (((ob >> 9) & 1) << 5)); }
__host__ __device__ __forceinline__ void stage_rc(int b, int& R, int& C) { const int st = b / 1024, sb = b % 1024, swz = sb ^ (((sb >> 9) & 1) << 5); R = (st >> 1) * 16 + swz / 64; C = (st & 1) * 32 + (swz % 64) / 2; }
__host__ __device__ __forceinline__ int perm32(int rho) { const int n = rho >> 4, i = rho & 15; return 8 * (i >> 2) + 4 * n + (i & 3); }

struct Unit { int pm, pn, pc; };
struct Gemm { const bf16_t* A; const bf16_t* Bt; int M, N, K, Kext; };

struct StaticOrder {
    int nM, nN, nwg, G, c;
    __host__ __device__ __forceinline__ void init(int M, int N, int G_, int c_) { nM = M / BM; nN = N / BM; nwg = nM * nN; G = G_; c = c_; }
    __host__ __device__ __forceinline__ bool next(int i, Unit& u) const {
        const long L = (long)i * G + c; if (L >= nwg) return false;
        int wgid = (int)L; { const int q = nwg / NXCD, r = nwg % NXCD, xcd = wgid % NXCD, off = wgid / NXCD; wgid = (xcd < r ? xcd * (q + 1) : r * (q + 1) + (xcd - r) * q) + off; }
        const int nig = WGM * nN, gid = wgid / nig, fm = gid * WGM, gsz = (nM - fm) < WGM ? (nM - fm) : WGM;
        u.pm = fm + ((wgid % nig) % gsz); u.pn = (wgid % nig) / gsz; u.pc = u.pn; return true;
    }
    __device__ __forceinline__ void a_ready(const Unit&) const {}
    __device__ __forceinline__ void done(const Unit&) const {}
};

__device__ __forceinline__ unsigned cvt_pk_bf16(float lo, float hi) { unsigned r; asm volatile("v_cvt_pk_bf16_f32 %0, %1, %2" : "=v"(r) : "v"(lo), "v"(hi)); return r; }
typedef float f32x2 __attribute__((ext_vector_type(2)));
typedef unsigned u32x2 __attribute__((ext_vector_type(2)));
struct EpiStore {
    static constexpr bool PERM = true, AFTER_DRAIN = false;
    bf16_t* O; int ldc;
    __device__ __forceinline__ void operator()(const f32x4 (&acc)[2][2][4][2], const Unit& u, int wr, int wc, int fr, int fq) const {
        const int row0 = u.pm * BM + wr * 64 + fr; const int col0 = u.pc * BM + wc * 32 + 8 * fq;
#pragma unroll
        for (int ai = 0; ai < 2; ++ai)
#pragma unroll
            for (int m = 0; m < 4; ++m) { bf16_t* rowp = O + (size_t)(row0 + ai * HALF + m * 16) * ldc + col0;
#pragma unroll
                for (int bj = 0; bj < 2; ++bj) { const f32x4 v0 = acc[ai][bj][m][0], v1 = acc[ai][bj][m][1];
                    u32x4 w; w.x = cvt_pk_bf16(v0[0], v0[1]); w.y = cvt_pk_bf16(v0[2], v0[3]); w.z = cvt_pk_bf16(v1[0], v1[1]); w.w = cvt_pk_bf16(v1[2], v1[3]);
                    *(u32x4*)(rowp + bj * HALF) = w; } }
    }
};
template <bool XB, int SHIFT = 0> struct EpiRes {
    static constexpr bool PERM = false, AFTER_DRAIN = false;
    const float* base; float* out; bf16_t* xb; float* part; static constexpr int ldc = 1024;
    __device__ __forceinline__ void operator()(const f32x4 (&acc)[2][2][4][2], const Unit& u, int wr, int wc, int fr, int fq) const {
        const int col0 = u.pc * BM + wc * 32 + 4 * fq;
#pragma unroll
        for (int ai = 0; ai < 2; ++ai)
#pragma unroll
            for (int m = 0; m < 4; ++m) { const int row = u.pm * BM + ai * HALF + wr * 64 + m * 16 + fr; const size_t off = (size_t)row * ldc + col0; float ss = 0.f;
#pragma unroll
                for (int bj = 0; bj < 2; ++bj)
#pragma unroll
                    for (int n = 0; n < 2; ++n) { const f32x4 bs = *(const f32x4*)(base + off + bj * HALF + n * 16); const f32x4 o = bs + acc[ai][bj][m][n] * (1.0f / (float)(1 << SHIFT)); *(f32x4*)(out + off + bj * HALF + n * 16) = o;
                        if constexpr (XB) { u32x2 w; w.x = cvt_pk_bf16(o[0], o[1]); w.y = cvt_pk_bf16(o[2], o[3]); *(u32x2*)(xb + off + bj * HALF + n * 16) = w; ss += (o[0] * o[0] + o[1] * o[1]) + (o[2] * o[2] + o[3] * o[3]); } }
                if constexpr (XB) { ss += __shfl_xor(ss, 16); ss += __shfl_xor(ss, 32); if (fq == 0) part[(size_t)row * 16 + u.pc * 4 + wc] = ss; }
                if (m & 1) asm volatile("" ::: "memory"); }
    }
};
__device__ __forceinline__ unsigned pk4_fp8(float a, float b, float c, float d) {
    a = __builtin_amdgcn_fmed3f(a, -448.f, 448.f); b = __builtin_amdgcn_fmed3f(b, -448.f, 448.f); c = __builtin_amdgcn_fmed3f(c, -448.f, 448.f); d = __builtin_amdgcn_fmed3f(d, -448.f, 448.f);
    int r = __builtin_amdgcn_cvt_pk_fp8_f32(a, b, 0, false); r = __builtin_amdgcn_cvt_pk_fp8_f32(c, d, r, true); return (unsigned)r;
}
template <bool F8OUT, bool ROWSC = false> struct EpiSwiglu {
    static constexpr bool PERM = false, AFTER_DRAIN = false;
    void* O; int ldc; float isc, osc; const float* rs; const float* ms;
    __device__ __forceinline__ void operator()(const f32x4 (&acc)[2][2][4][2], const Unit& u, int wr, int wc, int fr, int fq) const {
        const int j0 = u.pc * 128 + wc * 32 + 8 * fq; const float c1 = -1.4426950408889634f * isc, c2i = 1.0f / (isc * isc * osc);
#pragma unroll
        for (int ai = 0; ai < 2; ++ai)
#pragma unroll
            for (int m = 0; m < 4; ++m) { const int row = u.pm * BM + ai * HALF + wr * 64 + m * 16 + fr; const size_t off = (size_t)row * ldc + j0;
                float c1r = c1, c2r = c2i; if constexpr (ROWSC) { c1r = c1 * rs[row]; c2r = c2i * ms[row]; }
                f32x4 a[2];
#pragma unroll
                for (int bj = 0; bj < 2; ++bj) { const f32x4 g = acc[ai][bj][m][0], uu = acc[ai][bj][m][1];
#pragma unroll
                    for (int e = 0; e < 4; e += 2) { const f32x2 g2 = (f32x2){g[e], g[e + 1]}, u2 = (f32x2){uu[e], uu[e + 1]};
                        const f32x2 t2 = g2 * c1r; f32x2 ex; ex.x = __builtin_amdgcn_exp2f(t2.x); ex.y = __builtin_amdgcn_exp2f(t2.y);
                        const f32x2 d2 = ex * c2r + c2r; f32x2 r2; r2.x = __builtin_amdgcn_rcpf(d2.x); r2.y = __builtin_amdgcn_rcpf(d2.y);
                        const f32x2 o2 = (g2 * u2) * r2; a[bj][e] = o2.x; a[bj][e + 1] = o2.y; } }
                if constexpr (F8OUT) { u32x2 w; w.x = pk4_fp8(a[0][0], a[0][1], a[0][2], a[0][3]); w.y = pk4_fp8(a[1][0], a[1][1], a[1][2], a[1][3]); *(u32x2*)((unsigned char*)O + off) = w; }
                else { u32x4 w; w.x = cvt_pk_bf16(a[0][0], a[0][1]); w.y = cvt_pk_bf16(a[0][2], a[0][3]); w.z = cvt_pk_bf16(a[1][0], a[1][1]); w.w = cvt_pk_bf16(a[1][2], a[1][3]); *(u32x4*)((bf16_t*)O + off) = w; }
                if (m & 1) __builtin_amdgcn_sched_barrier(0); }
    }
};
struct EpiRope {
    static constexpr bool PERM = false, AFTER_DRAIN = false;
    bf16_t* Q; bf16_t* Kb; float* KM; const float* rope;
    bf16_t* VT; int vt_ld, vt_pn0; const float* rs;
    __device__ __forceinline__ void operator()(const f32x4 (&acc)[2][2][4][2], const Unit& u, int wr, int wc, int fr, int fq) const {
        const bool isk = (u.pc == 4), isv = (u.pc == 5);
        bf16_t* base = Q + (isv ? (long)(VT - Q) : (isk ? (long)(Kb - Q) : 0L)); const int ldc = isv ? vt_ld : (isk ? 256 : 1024); const int colt = isv ? (u.pn - vt_pn0) * BM : (isk ? 0 : u.pc * BM);
        const int rowt = isv ? 0 : u.pm * BM; const bool rot = (wc == 0) && !isv;
        const int col0 = colt + wc * 32 + 4 * fq;
        f32x4 cs[2][2];
#pragma unroll
        for (int bj = 0; bj < 2; ++bj)
#pragma unroll
            for (int n = 0; n < 2; ++n) cs[bj][n] = (f32x4){0.f, 0.f, 0.f, 0.f};
#pragma unroll
        for (int ai = 0; ai < 2; ++ai)
#pragma unroll
            for (int m = 0; m < 4; ++m) { const int r = rowt + ai * HALF + wr * 64 + m * 16 + fr; bf16_t* rowp = base + (size_t)r * ldc + col0;
                f32x4 c4 = (f32x4){1.f, 1.f, 1.f, 1.f}, s4 = (f32x4){0.f, 0.f, 0.f, 0.f};
                if (rot) { const float* rp = rope + (size_t)(r & 2047) * 32 + 4 * fq; c4 = *(const f32x4*)rp; s4 = *(const f32x4*)(rp + 16); }
                const float rsr = isv ? 1.f : rs[r];
#pragma unroll
                for (int bj = 0; bj < 2; ++bj) { f32x4 x1 = acc[ai][bj][m][0] * rsr, x2 = acc[ai][bj][m][1] * rsr;
                    if (isv) { x1 = x1 * *(const f32x4*)(rs + col0 + bj * HALF); x2 = x2 * *(const f32x4*)(rs + col0 + bj * HALF + 16); }
                    if (rot) { const f32x4 y1 = x1 * c4 - x2 * s4, y2 = x2 * c4 + x1 * s4; x1 = y1; x2 = y2; }
                    if (isk) { cs[bj][0] += x1; cs[bj][1] += x2; }
                    u32x2 w; w.x = cvt_pk_bf16(x1[0], x1[1]); w.y = cvt_pk_bf16(x1[2], x1[3]); *(u32x2*)(rowp + bj * HALF) = w;
                    w.x = cvt_pk_bf16(x2[0], x2[1]); w.y = cvt_pk_bf16(x2[2], x2[3]); *(u32x2*)(rowp + bj * HALF + 16) = w; } }
        if (isk) {
#pragma unroll
            for (int bj = 0; bj < 2; ++bj)
#pragma unroll
                for (int n = 0; n < 2; ++n)
#pragma unroll
                    for (int e = 0; e < 4; ++e) { float s = cs[bj][n][e]; s += __shfl_xor(s, 1); s += __shfl_xor(s, 2); s += __shfl_xor(s, 4); s += __shfl_xor(s, 8);
                        if (fr == 0) atomicAdd(KM + (size_t)u.pm * 256 + bj * HALF + wc * 32 + n * 16 + 4 * fq + e, s); }
        }
    }
};
struct QkvOrder {
    StaticOrder so; int G, c, nnorm, nsw, swA, swB;
    __device__ __forceinline__ bool next(int i, Unit& u) const {
        if (so.next(i, u)) return true;
        const int j = i * G + c - nnorm; if (j >= nsw) return false;
        u.pm = swA; u.pn = swB + j; u.pc = 5; return true;
    }
    __device__ __forceinline__ void a_ready(const Unit&) const {}
    __device__ __forceinline__ void done(const Unit&) const {}
};
struct TailOrder {
    int c, ntail, pm0, nct; int pb1, pb2, pb3, pb4, pb5, pb6, pb7;
    __device__ __forceinline__ bool next(int i, Unit& u) const {
        const int j = c >> 1; if (i > 0 || j >= ntail) return false;
        u.pm = pm0 + (j >> 2); u.pc = j & 3;
        const int e = (u.pm >= pb1) + (u.pm >= pb2) + (u.pm >= pb3) + (u.pm >= pb4) + (u.pm >= pb5) + (u.pm >= pb6) + (u.pm >= pb7);
        u.pn = e * nct + u.pc; return true;
    }
    __device__ __forceinline__ void a_ready(const Unit&) const {}
    __device__ __forceinline__ void done(const Unit&) const {}
};
struct EpiNull {
    static constexpr bool PERM = false, AFTER_DRAIN = false;
    float* junk;
    __device__ __forceinline__ void operator()(const f32x4 (&acc)[2][2][4][2], const Unit& u, int wr, int wc, int fr, int fq) const {
        f32x4 s = (f32x4){0.f, 0.f, 0.f, 0.f};
#pragma unroll
        for (int ai = 0; ai < 2; ++ai)
#pragma unroll
            for (int bj = 0; bj < 2; ++bj)
#pragma unroll
                for (int m = 0; m < 4; ++m)
#pragma unroll
                    for (int n = 0; n < 2; ++n) s += acc[ai][bj][m][n];
        if (s[0] + s[1] + s[2] + s[3] == 1.2345e-30f) junk[u.pm + wr + wc + fr + fq] = s[0];
    }
};
struct MoeOrder {
    StaticOrder so; int nct; int pb1, pb2, pb3, pb4, pb5, pb6, pb7;
    __device__ __forceinline__ bool next(int i, Unit& u) const {
        if (!so.next(i, u)) return false;
        const int e = (u.pm >= pb1) + (u.pm >= pb2) + (u.pm >= pb3) + (u.pm >= pb4) + (u.pm >= pb5) + (u.pm >= pb6) + (u.pm >= pb7);
        u.pc = u.pn; u.pn = e * nct + u.pc; return true;
    }
    __device__ __forceinline__ void a_ready(const Unit&) const {}
    __device__ __forceinline__ void done(const Unit&) const {}
};
typedef int i32x4 __attribute__((ext_vector_type(4)));
typedef int i32x8 __attribute__((ext_vector_type(8)));
template <class Epi, class Sched, bool ALIGN_EPI = false, bool SP2 = false, bool FP8 = false>
__device__ __forceinline__ void gemm_phase(PG8_LAS unsigned char* lds, const Gemm g, const Sched& S, const Epi& E) {
    const int tid = threadIdx.x, wid = __builtin_amdgcn_readfirstlane(tid >> 6), lane = tid & 63, wr = wid >> 2, wc = wid & 3, fr = lane & 15, fq = lane >> 4;
    const int K = g.K, nt = (g.Kext ? g.Kext : K) / BK;
    unsigned voffA[2], voffB[2];
#pragma unroll
    for (int i = 0; i < 2; ++i) { int R, C; stage_rc(tid * 16 + i * 8192, R, C); const int Rb = Epi::PERM ? ((R & ~31) + perm32(R & 31)) : R;
        voffA[i] = (unsigned)(R * K + C) * 2u; voffB[i] = (unsigned)(Rb * K + C) * 2u; }
    const size_t kstep = (size_t)(BK * 2);
    const size_t hstep = (size_t)HALF * K * 2;
    const size_t tstep = 2 * hstep;
    const unsigned ldsw = (unsigned)wid * 1024u;
    const int aoff = lds_byte(wr * 64 + fr, fq * 8), boff = lds_byte(wc * 32 + fr, fq * 8);
#define PG8_SA(b, h) (((b) * 2 + (h)) * HTB)
#define PG8_SB(b, h) ((4 + (b) * 2 + (h)) * HTB)
#define PG8_STAGE(bufoff, gbase, voff) do { _Pragma("unroll") for (int _i = 0; _i < 2; ++_i) \
        __builtin_amdgcn_global_load_lds((const unsigned*)((const char*)(gbase) + (voff)[_i]), (PG8_LAS unsigned*)(lds + (bufoff) + ldsw + _i * 8192), 16, 0, 0); } while (0)
#define PG8_LDA(dst, b, h) do { if constexpr (FP8) { _Pragma("unroll") for (int m = 0; m < 4; ++m) { const i32x4 lo_ = *(const PG8_LAS i32x4*)(lds + PG8_SA(b, h) + aoff + m * 2048), hi_ = *(const PG8_LAS i32x4*)(lds + PG8_SA(b, h) + aoff + m * 2048 + 1024); dst##8[m] = __builtin_shufflevector(lo_, hi_, 0, 1, 2, 3, 4, 5, 6, 7); } } \
    else { _Pragma("unroll") for (int m = 0; m < 4; ++m) _Pragma("unroll") for (int k = 0; k < 2; ++k) dst[m][k] = *(const PG8_LAS bf16x8*)(lds + PG8_SA(b, h) + aoff + m * 2048 + k * 1024); } } while (0)
#define PG8_LDB(dst, b, h) do { if constexpr (FP8) { _Pragma("unroll") for (int n = 0; n < 2; ++n) { const i32x4 lo_ = *(const PG8_LAS i32x4*)(lds + PG8_SB(b, h) + boff + n * 2048), hi_ = *(const PG8_LAS i32x4*)(lds + PG8_SB(b, h) + boff + n * 2048 + 1024); dst##8[n] = __builtin_shufflevector(lo_, hi_, 0, 1, 2, 3, 4, 5, 6, 7); } } \
    else { _Pragma("unroll") for (int n = 0; n < 2; ++n) _Pragma("unroll") for (int k = 0; k < 2; ++k) dst[n][k] = *(const PG8_LAS bf16x8*)(lds + PG8_SB(b, h) + boff + n * 2048 + k * 1024); } } while (0)
#define PG8_MMA(ai, bj, At, Bt) do { __builtin_amdgcn_s_setprio(1); \
        if constexpr (FP8) { asm volatile("s_nop 1\n\t" \
            "v_mfma_scale_f32_16x16x128_f8f6f4 %0, %12, %8, %0, %14, %14 op_sel_hi:[0,0,0]\n\t" \
            "v_mfma_scale_f32_16x16x128_f8f6f4 %1, %13, %8, %1, %14, %14 op_sel_hi:[0,0,0]\n\t" \
            "v_mfma_scale_f32_16x16x128_f8f6f4 %2, %12, %9, %2, %14, %14 op_sel_hi:[0,0,0]\n\t" \
            "v_mfma_scale_f32_16x16x128_f8f6f4 %3, %13, %9, %3, %14, %14 op_sel_hi:[0,0,0]\n\t" \
            "v_mfma_scale_f32_16x16x128_f8f6f4 %4, %12, %10, %4, %14, %14 op_sel_hi:[0,0,0]\n\t" \
            "v_mfma_scale_f32_16x16x128_f8f6f4 %5, %13, %10, %5, %14, %14 op_sel_hi:[0,0,0]\n\t" \
            "v_mfma_scale_f32_16x16x128_f8f6f4 %6, %12, %11, %6, %14, %14 op_sel_hi:[0,0,0]\n\t" \
            "v_mfma_scale_f32_16x16x128_f8f6f4 %7, %13, %11, %7, %14, %14 op_sel_hi:[0,0,0]\n\t" \
            : "+v"(acc[ai][bj][0][0]), "+v"(acc[ai][bj][0][1]), "+v"(acc[ai][bj][1][0]), "+v"(acc[ai][bj][1][1]), "+v"(acc[ai][bj][2][0]), "+v"(acc[ai][bj][2][1]), "+v"(acc[ai][bj][3][0]), "+v"(acc[ai][bj][3][1]) \
            : "v"(At##8[0]), "v"(At##8[1]), "v"(At##8[2]), "v"(At##8[3]), "v"(Bt##8[0]), "v"(Bt##8[1]), "v"(scl8)); } \
        else { _Pragma("unroll") for (int m = 0; m < 4; ++m) _Pragma("unroll") for (int n = 0; n < 2; ++n) _Pragma("unroll") for (int k = 0; k < 2; ++k) \
            acc[ai][bj][m][n] = __builtin_amdgcn_mfma_f32_16x16x32_bf16(Bt[n][k], At[m][k], acc[ai][bj][m][n], 0, 0, 0); } \
        __builtin_amdgcn_s_setprio(0); } while (0)
#define PG8_WAIT_V(n) asm volatile("s_waitcnt vmcnt(" #n ")" ::: "memory")
#define PG8_WAIT_L(n) asm volatile("s_waitcnt lgkmcnt(" #n ")" ::: "memory")
#define PG8_BAR __builtin_amdgcn_s_barrier()
#define PG8_SCHED __builtin_amdgcn_sched_barrier(0)
    Unit cur, nxt; int ui = 0;
    if (!S.next(0, cur)) return;
    f32x4 acc[2][2][4][2];
#pragma unroll
    for (int a = 0; a < 2; ++a)
#pragma unroll
        for (int b = 0; b < 2; ++b)
#pragma unroll
            for (int m = 0; m < 4; ++m)
#pragma unroll
                for (int n = 0; n < 2; ++n) { acc[a][b][m][n] = (f32x4){0.f, 0.f, 0.f, 0.f}; }
    const int scl8 = 0x7f7f7f7f;
    bf16x8 At[4][2], B0[2][2], B1[2][2]; i32x8 At8[4], B08[2], B18[2];
    const char* cA = (const char*)g.A + (size_t)cur.pm * tstep; const char* cB = (const char*)g.Bt + (size_t)cur.pn * tstep;
    S.a_ready(cur);
    if constexpr (SP2) {
        PG8_STAGE(PG8_SB(0, 0), cB, voffB); PG8_STAGE(PG8_SB(0, 1), cB + hstep, voffB); PG8_STAGE(PG8_SA(0, 0), cA, voffA); PG8_STAGE(PG8_SA(0, 1), cA + hstep, voffA);
        if (wr == 1) PG8_BAR;
        PG8_WAIT_V(2); PG8_BAR;
        PG8_STAGE(PG8_SB(1, 0), cB + kstep, voffB); PG8_STAGE(PG8_SA(1, 0), cA + kstep, voffA); PG8_STAGE(PG8_SB(1, 1), cB + hstep + kstep, voffB);
        PG8_WAIT_V(6); PG8_BAR;
    } else {
        PG8_STAGE(PG8_SB(0, 0), cB, voffB); PG8_STAGE(PG8_SA(0, 0), cA, voffA); PG8_STAGE(PG8_SB(0, 1), cB + hstep, voffB); PG8_STAGE(PG8_SA(0, 1), cA + hstep, voffA);
        if (wr == 1) PG8_BAR;
        PG8_WAIT_V(4); PG8_BAR;
        PG8_STAGE(PG8_SB(1, 0), cB + kstep, voffB); PG8_STAGE(PG8_SA(1, 0), cA + kstep, voffA); PG8_STAGE(PG8_SB(1, 1), cB + hstep + kstep, voffB);
        PG8_WAIT_V(6); PG8_BAR;
    }
    for (;;) {
        const bool has_next = S.next(ui + 1, nxt);
        const char* nA = has_next ? (const char*)g.A + (size_t)nxt.pm * tstep : cA; const char* nB = has_next ? (const char*)g.Bt + (size_t)nxt.pn * tstep : cB;
        for (int t = 0; t < nt; t += 2) {
            const bool last = (t == nt - 2);
            const char* a1 = cA + (size_t)(t + 1) * kstep;
            const char* a2 = last ? nA : cA + (size_t)(t + 2) * kstep; const char* b2 = last ? nB : cB + (size_t)(t + 2) * kstep;
            const char* a3 = a2 + kstep; const char* b3 = b2 + kstep;
            if (last && has_next) S.a_ready(nxt);
            if constexpr (SP2) {
            PG8_LDB(B0, 0, 0); PG8_LDB(B1, 0, 1); PG8_SCHED; PG8_LDA(At, 0, 0); PG8_STAGE(PG8_SA(1, 1), a1 + hstep, voffA);
            PG8_WAIT_V(8); PG8_WAIT_L(0); PG8_BAR; PG8_MMA(0, 0, At, B0); PG8_MMA(0, 1, At, B1); PG8_BAR; PG8_SCHED;
            PG8_LDA(At, 0, 1); PG8_STAGE(PG8_SB(0, 0), b2, voffB); PG8_STAGE(PG8_SB(0, 1), b2 + hstep, voffB); PG8_STAGE(PG8_SA(0, 0), a2, voffA);
            PG8_WAIT_V(8); PG8_WAIT_L(0); PG8_BAR; PG8_MMA(1, 0, At, B0); PG8_MMA(1, 1, At, B1); PG8_BAR; PG8_SCHED;
            PG8_LDB(B0, 1, 0); PG8_LDB(B1, 1, 1); PG8_SCHED; PG8_LDA(At, 1, 0); PG8_STAGE(PG8_SA(0, 1), a2 + hstep, voffA);
            PG8_WAIT_V(8); PG8_WAIT_L(0); PG8_BAR; PG8_MMA(0, 0, At, B0); PG8_MMA(0, 1, At, B1); PG8_BAR; PG8_SCHED;
            PG8_LDA(At, 1, 1); PG8_STAGE(PG8_SB(1, 0), b3, voffB); PG8_STAGE(PG8_SB(1, 1), b3 + hstep, voffB); PG8_STAGE(PG8_SA(1, 0), a3, voffA);
            PG8_WAIT_V(8); PG8_WAIT_L(0); PG8_BAR; PG8_MMA(1, 0, At, B0); PG8_MMA(1, 1, At, B1); PG8_BAR; PG8_SCHED;
            } else {
            PG8_LDB(B0, 0, 0); PG8_SCHED; PG8_LDA(At, 0, 0); PG8_STAGE(PG8_SA(1, 1), a1 + hstep, voffA);
            PG8_WAIT_L(8); PG8_BAR; PG8_WAIT_L(0); PG8_MMA(0, 0, At, B0); PG8_BAR; PG8_SCHED;
            PG8_LDB(B1, 0, 1); PG8_STAGE(PG8_SB(0, 0), b2, voffB);
            PG8_BAR; PG8_WAIT_L(0); PG8_MMA(0, 1, At, B1); PG8_BAR;
            PG8_LDA(At, 0, 1); PG8_STAGE(PG8_SA(0, 0), a2, voffA);
            PG8_BAR; PG8_WAIT_L(0); PG8_MMA(1, 0, At, B0); PG8_BAR; PG8_SCHED;
            PG8_STAGE(PG8_SB(0, 1), b2 + hstep, voffB);
            PG8_WAIT_V(6); PG8_BAR; PG8_MMA(1, 1, At, B1); PG8_BAR;
            PG8_LDB(B0, 1, 0); PG8_SCHED; PG8_LDA(At, 1, 0); PG8_STAGE(PG8_SA(0, 1), a2 + hstep, voffA);
            PG8_WAIT_L(8); PG8_BAR; PG8_WAIT_L(0); PG8_MMA(0, 0, At, B0); PG8_BAR; PG8_SCHED;
            PG8_LDB(B1, 1, 1); PG8_STAGE(PG8_SB(1, 0), b3, voffB);
            PG8_BAR; PG8_WAIT_L(0); PG8_MMA(0, 1, At, B1); PG8_BAR;
            PG8_LDA(At, 1, 1); PG8_STAGE(PG8_SA(1, 0), a3, voffA);
            PG8_BAR; PG8_WAIT_L(0); PG8_MMA(1, 0, At, B0); PG8_BAR; PG8_SCHED;
            PG8_STAGE(PG8_SB(1, 1), b3 + hstep, voffB);
            PG8_WAIT_V(6); PG8_BAR; PG8_MMA(1, 1, At, B1); PG8_BAR;
            }
        }
        if constexpr (FP8) asm volatile("s_nop 15\n\ts_nop 15" : "+v"(acc[1][0][0][0]), "+v"(acc[1][0][0][1]), "+v"(acc[1][0][1][0]), "+v"(acc[1][0][1][1]), "+v"(acc[1][0][2][0]), "+v"(acc[1][0][2][1]), "+v"(acc[1][0][3][0]), "+v"(acc[1][0][3][1]),
            "+v"(acc[1][1][0][0]), "+v"(acc[1][1][0][1]), "+v"(acc[1][1][1][0]), "+v"(acc[1][1][1][1]), "+v"(acc[1][1][2][0]), "+v"(acc[1][1][2][1]), "+v"(acc[1][1][3][0]), "+v"(acc[1][1][3][1]));
        if constexpr (ALIGN_EPI) { if (wr == 0) PG8_BAR; }
        if constexpr (!Epi::AFTER_DRAIN) { E(acc, cur, wr, wc, fr, fq); S.done(cur); }
        if (!has_next) break;
#pragma unroll
        for (int a = 0; a < 2; ++a)
#pragma unroll
            for (int b = 0; b < 2; ++b)
#pragma unroll
                for (int m = 0; m < 4; ++m)
#pragma unroll
                    for (int n = 0; n < 2; ++n) { acc[a][b][m][n] = (f32x4){0.f, 0.f, 0.f, 0.f}; }
        cur = nxt; cA = nA; cB = nB; ++ui;
        if constexpr (ALIGN_EPI) { if (wr == 1) PG8_BAR; }
    }
    PG8_WAIT_V(0);
    if constexpr (!ALIGN_EPI) { if (wr == 0) PG8_BAR; }
    PG8_BAR;
    if constexpr (Epi::AFTER_DRAIN) { E.fused(acc, cur, wr, wc, fr, fq, lds, wid, lane); S.done(cur); }
#undef PG8_SA
#undef PG8_SB
#undef PG8_STAGE
#undef PG8_LDA
#undef PG8_LDB
#undef PG8_MMA
#undef PG8_WAIT_V
#undef PG8_WAIT_L
#undef PG8_BAR
#undef PG8_SCHED
}
}
#ifndef MK_PER_PHASE
#define MK_PER_PHASE 0
#endif
#ifndef MK_DUP
#define MK_DUP (-1)
#endif
#ifndef MOBA_DMA
#define MOBA_DMA 1
#endif
#ifndef SIDEJOB
#define SIDEJOB 0
#endif
#ifndef DOWN_F8
#define DOWN_F8 1
#endif
#ifndef DENSE_F8
#define DENSE_F8 0
#endif
#ifndef MOE_F8
#define MOE_F8 1
#endif
constexpr float XA_SC = 8.f, WGU_SC = 64.f, ACT_SC = 8.f, WDN_SC = 128.f;
constexpr int NWAVES = 8;
constexpr int NPHASE = 17;

constexpr int DM = 1024, BATCH = 16, SEQ = 2048, NTOK = BATCH * SEQ;
constexpr int MH = 4, DQK = 128, DV = 256, CH = 64, NCH = SEQ / CH;
constexpr int WIN_LD = 3080;
constexpr int AH = 8, AKV = 2, HD = 128, NBLK = 8;
constexpr int DFF = 2816, NE = 8, DEXP = 3584;
constexpr int MAXPANEL = 264;
constexpr float EPS = 1e-6f;

constexpr size_t MiB = 1u << 20;
constexpr size_t WS_CTL = 0, CTL_ZERO_BYTES = 1 * MiB;
constexpr int CW_BAR = 4096;
constexpr size_t WS_KM = 256 * 1024;
constexpr size_t WS_ROPE = 1 * MiB;
constexpr size_t WS_GATES = 2 * MiB;
constexpr size_t WS_ME = 4 * MiB;
constexpr size_t WS_MW = 5 * MiB;
constexpr size_t WS_MR = 6 * MiB;
constexpr size_t WS_MP = 7 * MiB;
constexpr size_t WS_HIST = 8 * MiB;
constexpr size_t WS_PB = 8 * MiB + 64 * 1024;
constexpr size_t WS_PART = 9 * MiB;
constexpr size_t WS_RS = 12 * MiB, WS_MS = 13 * MiB;
constexpr size_t WS_WIN = 16 * MiB;
constexpr size_t WS_WOUT = 22 * MiB;
constexpr size_t WS_WGU = 24 * MiB;
constexpr size_t WS_WDN = 35 * MiB;
constexpr size_t WS_WQKV = 41 * MiB;
constexpr size_t WS_WO = 44 * MiB;
constexpr size_t WS_WMGU = 46 * MiB;
constexpr size_t WS_WMDN = 158 * MiB;
constexpr size_t WS_A = 224 * MiB;
constexpr size_t WS_B = 360 * MiB;
constexpr size_t WS_QKO = WS_B;
constexpr size_t WS_KVT = WS_B + 128 * MiB;
constexpr size_t WS_H = WS_B + 224 * MiB;
constexpr size_t WS_ACT = WS_B;
constexpr size_t WS_Q = WS_B;
constexpr size_t WS_K = WS_B + 64 * MiB;
constexpr size_t WS_VT = WS_B + 80 * MiB;
constexpr size_t WS_ATT = WS_B + 96 * MiB;
constexpr size_t WS_ACT2 = WS_B;
constexpr size_t WS_Y2 = WS_B + (size_t)MAXPANEL * 256 * DEXP * 2;
constexpr size_t WS_END = WS_Y2 + 4 * MiB;
static_assert(WS_WMDN + (size_t)NE * 1024 * DEXP * 2 <= WS_A && WS_A + (size_t)MAXPANEL * 256 * 1024 * 2 <= WS_B, "d_ws map");

constexpr int RING_OFF = 0, RING_BYTES = 131072;
constexpr int LDSCTL_OFF = 155648, MISC_OFF = LDSCTL_OFF + 320;
constexpr int LDS_BYTES = 156672;

#define GAS __attribute__((address_space(1)))
#define LAS __attribute__((address_space(3)))
typedef unsigned short bf16;
typedef unsigned v4u __attribute__((ext_vector_type(4)));
typedef unsigned v2u __attribute__((ext_vector_type(2)));
typedef float f32x4 __attribute__((ext_vector_type(4)));
typedef short bf16x8 __attribute__((ext_vector_type(8)));
typedef GAS unsigned gu32;
#define RLX_AGENT __ATOMIC_RELAXED, __HIP_MEMORY_SCOPE_AGENT
#define LDS_WAIT() asm volatile("s_waitcnt lgkmcnt(0)" ::: "memory")
#define VM_WAIT() asm volatile("s_waitcnt vmcnt(0)" ::: "memory")
#define MFMA16(a, b, c) __builtin_amdgcn_mfma_f32_16x16x32_bf16((a), (b), (c), 0, 0, 0)
__device__ __forceinline__ unsigned pk2(float lo, float hi) { return pg8::cvt_pk_bf16(lo, hi); }
__device__ __forceinline__ float bflo(unsigned w) { return __uint_as_float(w << 16); }
__device__ __forceinline__ float bfhi(unsigned w) { return __uint_as_float(w & 0xffff0000u); }
__device__ __forceinline__ float wave_sum(float v) {
#pragma unroll
    for (int o = 1; o < 64; o <<= 1) v += __shfl_xor(v, o);
    return v;
}

#define XB_TMO      128
#define XB_XCNT(j)  (256  + 64 * (j))
#define XB_XSUB(j)  (1280 + 64 * (j))
#define XB_XGEN(j)  (2304 + 64 * (j))
#define XB_TOP      3328
#define XB_TOPGEN   3392
#define XCD_BAR_WORDS 3456
#define XB_SPIN_CAP (1u << 18)

__device__ __forceinline__ unsigned xb_ld(unsigned* p)              { return __hip_atomic_load(p, __ATOMIC_RELAXED, __HIP_MEMORY_SCOPE_AGENT); }
__device__ __forceinline__ unsigned xb_add(unsigned* p, unsigned v) { return __hip_atomic_fetch_add(p, v, __ATOMIC_RELAXED, __HIP_MEMORY_SCOPE_AGENT); }
__device__ __forceinline__ unsigned xb_xcc_id() { return (unsigned)__builtin_amdgcn_s_getreg((3 << 11) | 20) & 0xFu; }
#define XB_SPIN(cond, bar) do { unsigned _sp = 0; while (cond) { __builtin_amdgcn_s_sleep(1); \
    if ((++_sp & 255u) == 0u) { if (xb_ld(&(bar)[XB_TMO])) break; if (_sp > XB_SPIN_CAP) { atomicAdd(&(bar)[XB_TMO], 1u); break; } } } } while (0)

struct XcdBarrier {
    unsigned* bar; unsigned x;
    volatile LAS unsigned* st;
};

__device__ __forceinline__ XcdBarrier xcd_barrier_post(unsigned* bar, volatile LAS unsigned* st) {
    XcdBarrier b; b.bar = bar; b.x = xb_xcc_id(); b.st = st;
    if (threadIdx.x == 0) (void)xb_add(&bar[XB_XCNT(b.x)], 1u);
    return b;
}
__device__ __forceinline__ void xcd_barrier_complete(unsigned* bar, unsigned x, unsigned& nloc, unsigned& nx) {
    const unsigned G = gridDim.x * gridDim.y * gridDim.z;
    unsigned sum, cnt, mine, sp = 0u;
    for (;;) {
        sum = 0u; cnt = 0u; mine = 0u;
#pragma unroll
        for (unsigned j = 0; j < 16; ++j) { const unsigned c = xb_ld(&bar[XB_XCNT(j)]); sum += c; cnt += (c > 0u) ? 1u : 0u; mine = (j == x) ? c : mine; }
        if (sum == G) break;
        __builtin_amdgcn_s_sleep(1);
        if ((++sp & 255u) == 0u) { if (xb_ld(&bar[XB_TMO])) break; if (sp > XB_SPIN_CAP) { atomicAdd(&bar[XB_TMO], 1u); break; } }
    }
    nloc = mine > 0u ? mine : 1u; nx = cnt > 0u ? cnt : 1u;
}

__device__ __forceinline__ void xcd_barrier(const XcdBarrier& b) {
    asm volatile("s_waitcnt vmcnt(0)" ::: "memory");
    __syncthreads();
    if (threadIdx.x == 0) {
        unsigned* bar = b.bar;
        __builtin_amdgcn_s_waitcnt(0);
        unsigned nloc = b.st[0], nx = b.st[1];
        if (nloc == 0u) { xcd_barrier_complete(bar, b.x, nloc, nx); b.st[0] = nloc; b.st[1] = nx; }
        const unsigned old = xb_add(&bar[XB_XSUB(b.x)], 1u);
        const unsigned gen = old / nloc;
        if (old + 1u == (gen + 1u) * nloc) {
            __builtin_amdgcn_fence(__ATOMIC_RELEASE, "agent");
            asm volatile("s_waitcnt vmcnt(0)" ::: "memory");
            const unsigned og = xb_add(&bar[XB_TOP], 1u);
            const unsigned tg = og / nx;
            if (og + 1u == (tg + 1u) * nx) xb_add(&bar[XB_TOPGEN], 1u);
            else XB_SPIN(xb_ld(&bar[XB_TOPGEN]) == tg, bar);
            __builtin_amdgcn_fence(__ATOMIC_ACQUIRE, "agent");
            xb_add(&bar[XB_XGEN(b.x)], 1u);
            asm volatile("s_waitcnt vmcnt(0)" ::: "memory");
        } else {
            XB_SPIN(xb_ld(&bar[XB_XGEN(b.x)]) == gen, bar);
            __builtin_amdgcn_fence(__ATOMIC_ACQUIRE, "agent");
            asm volatile("s_waitcnt vmcnt(0)" ::: "memory");
        }
    }
    __syncthreads();
}


struct TDesc { const float* src; bf16* dst; const float* gain; int ldw, col0, ncol32, kgrp, ngrp, dst_ld, dst_rpg, mode, F, row_off; float scale; int item0, nitem, f8, pad; };
constexpr int NDESC = SIDEJOB ? 10 : 12;

__device__ __forceinline__ void tdesc_set(LAS TDesc* t, int& run, const float* src, bf16* dst, const float* gain, int ldw, int col0, int ncols, int kgrp, int ngrp, int dst_ld, int dst_rpg, int mode, int F, int row_off, float scale, int f8 = 0) {
    t->f8 = f8; t->pad = 0;
    t->src = src; t->dst = dst; t->gain = gain; t->ldw = ldw; t->col0 = col0; t->ncol32 = ncols / 32; t->kgrp = kgrp; t->ngrp = ngrp; t->dst_ld = dst_ld; t->dst_rpg = dst_rpg; t->mode = mode; t->F = F; t->row_off = row_off; t->scale = scale;
    t->item0 = run; t->nitem = (kgrp * ngrp / 64) * (ncols / 32); run += t->nitem;
}
__device__ __forceinline__ void titem_load(const LAS TDesc* t, int it, int lane, f32x4 (&v)[8]) {
    const int ncol32 = t->ncol32, kb = it / ncol32, nb = it - kb * ncol32;
    const float* src = t->src + (size_t)(kb * 64) * t->ldw + t->col0 + nb * 32;
    const int kr = lane >> 3, c4 = lane & 7;
#pragma unroll
    for (int i = 0; i < 8; ++i) v[i] = *(const f32x4*)(src + (size_t)(8 * i + kr) * t->ldw + 4 * c4);
}
__device__ __forceinline__ void titem_store(const LAS TDesc* t, int it, LAS float* scr, int lane, const f32x4 (&v)[8]) {
    const int ncol32 = t->ncol32, kb = it / ncol32, nb = it - kb * ncol32;
    const int k0g = kb * 64, grp = k0g / t->kgrp, k0 = k0g - grp * t->kgrp, nrel0 = nb * 32;
    const int kr = lane >> 3, c4 = lane & 7;
    const float* gp = t->gain; const float sc = t->scale;
#pragma unroll
    for (int i = 0; i < 8; ++i) { const int kk = 8 * i + kr; const float gsc = gp ? gp[k0 + kk] * sc : sc;
        LAS float* d = scr + kk * 33 + 4 * c4; d[0] = v[i][0] * gsc; d[1] = v[i][1] * gsc; d[2] = v[i][2] * gsc; d[3] = v[i][3] * gsc; }
    LDS_WAIT(); asm volatile("" ::: "memory");
    const int c = lane & 7;
#pragma unroll
    for (int j = 0; j < 4; ++j) { const int n = (lane >> 3) + 8 * j; const LAS float* s = scr + (8 * c) * 33 + n;
        const int nrel = nrel0 + n; int drow;
        if (t->mode == 0) drow = nrel;
        else { const int F = t->F, uu = nrel >= F ? 1 : 0, j2 = nrel - uu * F, jl = j2 & 127;
            drow = 256 * (j2 >> 7) + 128 * ((jl >> 2) & 1) + 32 * (jl >> 5) + 16 * uu + 4 * ((jl >> 3) & 3) + (jl & 3); }
        drow += grp * t->dst_rpg + t->row_off;
        if (t->f8) { v2u o; o.x = pg8::pk4_fp8(s[0 * 33], s[1 * 33], s[2 * 33], s[3 * 33]); o.y = pg8::pk4_fp8(s[4 * 33], s[5 * 33], s[6 * 33], s[7 * 33]); *(v2u*)((unsigned char*)t->dst + (size_t)drow * t->dst_ld + k0 + 8 * c) = o; }
        else { v4u o; o.x = pk2(s[0 * 33], s[1 * 33]); o.y = pk2(s[2 * 33], s[3 * 33]); o.z = pk2(s[4 * 33], s[5 * 33]); o.w = pk2(s[6 * 33], s[7 * 33]); *(v4u*)(t->dst + (size_t)drow * t->dst_ld + k0 + 8 * c) = o; } }
    LDS_WAIT(); asm volatile("" ::: "memory");
}
__device__ __forceinline__ void sincos_d(double x, double& s, double& c) {
    const double n = __builtin_rint(x * 0.63661977236758134308);
    double r = __builtin_fma(-n, 1.57079632679489655800e+00, x); r = __builtin_fma(-n, 6.12323399573676603587e-17, r);
    const double r2 = r * r;
    double sp = -1.0 / 1307674368000.0; sp = sp * r2 + 1.0 / 6227020800.0; sp = sp * r2 - 1.0 / 39916800.0; sp = sp * r2 + 1.0 / 362880.0; sp = sp * r2 - 1.0 / 5040.0; sp = sp * r2 + 1.0 / 120.0; sp = sp * r2 - 1.0 / 6.0; sp = sp * r2 + 1.0;
    const double sr = sp * r;
    double cp = 1.0 / 20922789888000.0; cp = cp * r2 - 1.0 / 87178291200.0; cp = cp * r2 + 1.0 / 479001600.0; cp = cp * r2 - 1.0 / 3628800.0; cp = cp * r2 + 1.0 / 40320.0; cp = cp * r2 - 1.0 / 720.0; cp = cp * r2 + 1.0 / 24.0; cp = cp * r2 - 0.5; cp = cp * r2 + 1.0;
    const int q = ((int)n) & 3;
    s = (q == 0) ? sr : (q == 1) ? cp : (q == 2) ? -sr : -cp;
    c = (q == 0) ? cp : (q == 1) ? -sr : (q == 2) ? -cp : sr;
}
__device__ __forceinline__ double inv_freq_d(int i) {
    switch (i) { case 0: return 1.0; case 1: return 0.44036660267178046; case 2: return 0.19392274474868576; case 3: return 0.085397100285765609; case 4: return 0.037606030930863933;
        case 5: return 0.016560440080994446; case 6: return 0.0072926647372171093; case 7: return 0.0032114459947525909; case 8: return 0.001414213562373095; case 9: return 0.00062277242191459599;
        case 10: return 0.0002742481756762073; case 11: return 0.00012076973741146504; case 12: return 5.3182958969449883e-05; case 13: return 2.3419998961409342e-05; case 14: return 1.031338537721246e-05; default: return 4.5416704806078695e-06; }
}
__device__ __forceinline__ void load_row(const float* row, int lane, f32x4 (&v)[4]) {
    const f32x4* xr = (const f32x4*)row + lane;
#pragma unroll
    for (int j = 0; j < 4; ++j) v[j] = xr[64 * j];
}
__device__ __forceinline__ float row_sumsq(const f32x4 (&v)[4]) {
    float s = 0.f;
#pragma unroll
    for (int j = 0; j < 4; ++j) s += (v[j][0] * v[j][0] + v[j][1] * v[j][1]) + (v[j][2] * v[j][2] + v[j][3] * v[j][3]);
    return wave_sum(s);
}
__device__ __forceinline__ void store_row_bf16(bf16* orow, int lane, const f32x4 (&v)[4], float sc) {
    v2u* o8 = (v2u*)orow + lane;
#pragma unroll
    for (int j = 0; j < 4; ++j) { v2u w; w.x = pk2(v[j][0] * sc, v[j][1] * sc); w.y = pk2(v[j][2] * sc, v[j][3] * sc); o8[64 * j] = w; }
}

__device__ __forceinline__ void store_row_fp8(unsigned char* orow, int lane, const f32x4 (&v)[4], float sc) {
    unsigned* o4 = (unsigned*)orow + lane;
#pragma unroll
    for (int j = 0; j < 4; ++j) o4[64 * j] = pg8::pk4_fp8(v[j][0] * sc, v[j][1] * sc, v[j][2] * sc, v[j][3] * sc);
}

constexpr int ML_QS = 0, ML_KS = 17408, ML_KWT = 34816, ML_VT = 53248, ML_SBF = 62464, ML_DD = 79872, ML_MM = 80128, ML_BC = 80384, ML_NV = 80640, ML_END = 81664;
constexpr int ML_SCR = 81920, ML_TD = 150016;
__device__ __forceinline__ void mlstm_phase(LAS unsigned char* lds, const bf16* QKO, const bf16* KVT, const float* GATES, const float* b_if, bf16* Hout, int vcu, int G, int tid) {
    const LAS TDesc* td2 = (const LAS TDesc*)(lds + ML_TD); const int nitems2 = td2[1].item0 + td2[1].nitem;
    LAS float* scr = (LAS float*)(lds + ML_SCR + (tid >> 6) * 8448); int itw = vcu * 8 + (tid >> 6);
    const int lane = tid & 63, w = __builtin_amdgcn_readfirstlane(tid >> 6), l15 = lane & 15, g = lane >> 4;
    const int tt = w & 3, vh = w >> 2;
    for (int unit = vcu; unit < 256; unit += G) {
        const int bh = unit >> 2, vs = unit & 3, b = bh >> 2, h = bh & 3;
        const size_t tok0 = (size_t)b * SEQ;
        const float bi = b_if[h], bfg = b_if[4 + h];
        f32x4 accS[4];
#pragma unroll
        for (int j = 0; j < 4; ++j) accS[j] = (f32x4){0.f, 0.f, 0.f, 0.f};
        float m_s = 0.f;
        for (int i = tid; i < 17408 / 16; i += 512) *(LAS v4u*)(lds + ML_SBF + i * 16) = (v4u){0u, 0u, 0u, 0u};
        if (tid < 256) *(LAS float*)(lds + ML_NV + tid * 4) = 0.f;
        v4u rq[2], rk[2], rt[2], rv; float gi, gf;
#define ML_LOADS(c_) do { const size_t t0_ = tok0 + (size_t)(c_) * CH; \
        _Pragma("unroll") for (int i_ = 0; i_ < 2; ++i_) { const int p_ = tid + 512 * i_; const int r_ = p_ >> 4, cp_ = p_ & 15; const bf16* s_ = QKO + (t0_ + r_) * 2048 + h * 128 + cp_ * 8; rq[i_] = *(const v4u*)s_; rk[i_] = *(const v4u*)(s_ + 1536); \
            const int kk_ = p_ >> 3, sg_ = p_ & 7; rt[i_] = *(const v4u*)(KVT + (size_t)(h * 128 + kk_) * NTOK + t0_ + 8 * sg_); } \
        rv = *(const v4u*)(KVT + (size_t)(512 + h * 256 + vs * 64 + (tid >> 3)) * NTOK + t0_ + 8 * (tid & 7)); \
        gi = GATES[(t0_ + lane) * 8 + h]; gf = GATES[(t0_ + lane) * 8 + 4 + h]; } while (0)
        ML_LOADS(0);
        for (int c = 0; c < NCH; ++c) {
            const size_t t0 = tok0 + (size_t)c * CH;
            const float igv = gi + bi, xf = gf + bfg;
            const float lgf = fminf(xf, 0.f) - log1pf(__expf(-fabsf(xf)));
            float bc = lgf;
#pragma unroll
            for (int o = 1; o < 64; o <<= 1) { const float t = __shfl_up(bc, o); if (lane >= o) bc += t; }
            const float dd = igv - bc;
            float pm = dd;
#pragma unroll
            for (int o = 1; o < 64; o <<= 1) { const float t = __shfl_up(pm, o); if (lane >= o) pm = fmaxf(pm, t); }
            const float mm = fmaxf(m_s, pm);
            const float g_tot = __shfl(bc, 63), mm63 = __shfl(mm, 63);
            const float wgt = __expf(dd - mm63), decay = __expf(m_s - mm63);
            if (w == 0) { *(LAS float*)(lds + ML_DD + lane * 4) = dd; *(LAS float*)(lds + ML_MM + lane * 4) = mm; *(LAS float*)(lds + ML_BC + lane * 4) = bc; }
            {
                float wv[8];
#pragma unroll
                for (int e = 0; e < 8; ++e) wv[e] = __shfl(wgt, 8 * (tid & 7) + e);
#pragma unroll
                for (int i = 0; i < 2; ++i) { const int p = tid + 512 * i; const int r = p >> 4, cp = p & 15;
                    *(LAS v4u*)(lds + ML_QS + r * 272 + cp * 16) = rq[i]; *(LAS v4u*)(lds + ML_KS + r * 272 + cp * 16) = rk[i];
                    const int kk = p >> 3, sg = p & 7; v4u o;
                    o.x = pk2(bflo(rt[i].x) * wv[0], bfhi(rt[i].x) * wv[1]); o.y = pk2(bflo(rt[i].y) * wv[2], bfhi(rt[i].y) * wv[3]);
                    o.z = pk2(bflo(rt[i].z) * wv[4], bfhi(rt[i].z) * wv[5]); o.w = pk2(bflo(rt[i].w) * wv[6], bfhi(rt[i].w) * wv[7]);
                    *(LAS v4u*)(lds + ML_KWT + kk * 144 + sg * 16) = o; }
                *(LAS v4u*)(lds + ML_VT + (tid >> 3) * 144 + (tid & 7) * 16) = rv;
            }
            __syncthreads();
            if (c + 1 < NCH) ML_LOADS(c + 1);
            const int it2 = itw; itw += G * 8; const bool has2 = SIDEJOB && it2 < nitems2; const int d2 = (has2 && it2 >= td2[1].item0) ? 1 : 0;
            f32x4 tv[8]; if (has2) titem_load(td2 + d2, it2 - td2[d2].item0, lane, tv);
            const int cur = c & 1;
            const int t_loc = 16 * tt + l15;
            bf16x8 qf[4];
#pragma unroll
            for (int kp = 0; kp < 4; ++kp) qf[kp] = *(const LAS bf16x8*)(lds + ML_QS + t_loc * 272 + (32 * kp + 8 * g) * 2);
            const float mmt = *(const LAS float*)(lds + ML_MM + t_loc * 4), bct = *(const LAS float*)(lds + ML_BC + t_loc * 4);
            f32x4 P[4]; float psum = 0.f;
#pragma unroll
            for (int i = 0; i < 4; ++i) {
                P[i] = (f32x4){0.f, 0.f, 0.f, 0.f};
                if (i <= tt) {
                    f32x4 a = (f32x4){0.f, 0.f, 0.f, 0.f};
#pragma unroll
                    for (int kp = 0; kp < 4; ++kp) { const bf16x8 kf = *(const LAS bf16x8*)(lds + ML_KS + (16 * i + l15) * 272 + (32 * kp + 8 * g) * 2); a = MFMA16(kf, qf[kp], a); }
                    const f32x4 ddv = *(const LAS f32x4*)(lds + ML_DD + (16 * i + 4 * g) * 4);
#pragma unroll
                    for (int r = 0; r < 4; ++r) { const int s = 16 * i + 4 * g + r; const float pv = (s <= t_loc) ? a[r] * __expf(ddv[r] - mmt) : 0.f; P[i][r] = pv; psum += pv; }
                }
            }
            psum += __shfl_xor(psum, 16); psum += __shfl_xor(psum, 32);
            bf16x8 pf[2];
#pragma unroll
            for (int kp = 0; kp < 2; ++kp) { v4u o; o.x = pk2(P[2 * kp][0], P[2 * kp][1]); o.y = pk2(P[2 * kp][2], P[2 * kp][3]); o.z = pk2(P[2 * kp + 1][0], P[2 * kp + 1][1]); o.w = pk2(P[2 * kp + 1][2], P[2 * kp + 1][3]);
                pf[kp] = __builtin_bit_cast(bf16x8, o); }
            float nqp = 0.f;
#pragma unroll
            for (int kp = 0; kp < 4; ++kp) { const v4u qw = __builtin_bit_cast(v4u, qf[kp]); const LAS float* nv = (const LAS float*)(lds + ML_NV + cur * 512) + 32 * kp + 8 * g;
                const f32x4 n0 = *(const LAS f32x4*)nv, n1 = *(const LAS f32x4*)(nv + 4);
                nqp += bflo(qw.x) * n0[0] + bfhi(qw.x) * n0[1] + bflo(qw.y) * n0[2] + bfhi(qw.y) * n0[3] + bflo(qw.z) * n1[0] + bfhi(qw.z) * n1[1] + bflo(qw.w) * n1[2] + bfhi(qw.w) * n1[3]; }
            nqp += __shfl_xor(nqp, 16); nqp += __shfl_xor(nqp, 32);
            const float iw = __expf(m_s - mmt);
            const float nq = psum + iw * nqp;
            const float den = fmaxf(fabsf(nq), __expf(-(bct + mmt)));
            const float rden = 1.0f / den;
#pragma unroll
            for (int j = 0; j < 2; ++j) {
                const int v_loc = 32 * vh + 16 * j + l15;
                f32x4 ao = (f32x4){0.f, 0.f, 0.f, 0.f}, ai = (f32x4){0.f, 0.f, 0.f, 0.f};
#pragma unroll
                for (int kp = 0; kp < 2; ++kp) if (2 * kp <= tt) {
                    const v2u lo = *(const LAS v2u*)(lds + ML_VT + v_loc * 144 + (32 * kp + 4 * g) * 2), hi = *(const LAS v2u*)(lds + ML_VT + v_loc * 144 + (32 * kp + 16 + 4 * g) * 2);
                    const v4u vv = (v4u){lo.x, lo.y, hi.x, hi.y};
                    ao = MFMA16(__builtin_bit_cast(bf16x8, vv), pf[kp], ao); }
#pragma unroll
                for (int kp = 0; kp < 4; ++kp) { const bf16x8 sf = *(const LAS bf16x8*)(lds + ML_SBF + v_loc * 272 + (32 * kp + 8 * g) * 2); ai = MFMA16(sf, qf[kp], ai); }
                v2u o; o.x = pk2((ao[0] + iw * ai[0]) * rden, (ao[1] + iw * ai[1]) * rden); o.y = pk2((ao[2] + iw * ai[2]) * rden, (ao[3] + iw * ai[3]) * rden);
                *(v2u*)(Hout + (t0 + t_loc) * 1024 + h * 256 + vs * 64 + 32 * vh + 16 * j + 4 * g) = o;
            }
            {
                bf16x8 kf[2];
#pragma unroll
                for (int kp = 0; kp < 2; ++kp) kf[kp] = *(const LAS bf16x8*)(lds + ML_KWT + (16 * w + l15) * 144 + (32 * kp + 8 * g) * 2);
#pragma unroll
                for (int jv = 0; jv < 4; ++jv) { accS[jv] = accS[jv] * decay;
#pragma unroll
                    for (int kp = 0; kp < 2; ++kp) { const bf16x8 vf = *(const LAS bf16x8*)(lds + ML_VT + (16 * jv + l15) * 144 + (32 * kp + 8 * g) * 2); accS[jv] = MFMA16(kf[kp], vf, accS[jv]); } }
            }
            if (tid < 128) { float s = 0.f;
#pragma unroll
                for (int i = 0; i < 8; ++i) { const v4u x = *(const LAS v4u*)(lds + ML_KWT + tid * 144 + i * 16); s += (bflo(x.x) + bfhi(x.x)) + (bflo(x.y) + bfhi(x.y)) + (bflo(x.z) + bfhi(x.z)) + (bflo(x.w) + bfhi(x.w)); }
                const float nold = *(const LAS float*)(lds + ML_NV + cur * 512 + tid * 4);
                *(LAS float*)(lds + ML_NV + (cur ^ 1) * 512 + tid * 4) = decay * nold + s; }
            __syncthreads();
#pragma unroll
            for (int jv = 0; jv < 4; ++jv) { v2u o; o.x = pk2(accS[jv][0], accS[jv][1]); o.y = pk2(accS[jv][2], accS[jv][3]);
                *(LAS v2u*)(lds + ML_SBF + (16 * jv + l15) * 272 + (16 * w + 4 * g) * 2) = o; }
            if (has2) titem_store(td2 + d2, it2 - td2[d2].item0, scr, lane, tv);
            m_s = g_tot + mm63;
        }
        __syncthreads();
#undef ML_LOADS
    }
}

constexpr int AT_K0 = 0, AT_V0 = 34816, AT_KM = 71680, AT_END = 75776;
__device__ __forceinline__ void moba_phase(LAS unsigned char* lds, const bf16* Qb, const bf16* Kb, const bf16* VT, const float* KM, bf16* ATT, int vcu, int G, int tid) {
    const int lane = tid & 63, w = __builtin_amdgcn_readfirstlane(tid >> 6), l15 = lane & 15, g = lane >> 4;
    constexpr float SC2 = 0.08838834764831845f * 1.4426950408889634f;
    const float NEG = -__builtin_inff();
    for (int item = vcu; item < 512; item += G) {
        const int bh = item >> 2, pr = item & 3, b = bh >> 3, h = bh & 7, kvh = h >> 2;
        for (int half = 0; half < 2; ++half) {
            const int qb = half ? pr : 7 - pr;
            const size_t row0 = (size_t)b * SEQ + 256 * qb + 32 * w;
            bf16x8 qf[2][4];
#pragma unroll
            for (int u = 0; u < 2; ++u)
#pragma unroll
                for (int kp = 0; kp < 4; ++kp) qf[u][kp] = *(const bf16x8*)(Qb + (row0 + 16 * u + l15) * 1024 + h * 128 + 32 * kp + 8 * g);
            for (int i = tid; i < 1024; i += 512) { const int n = i >> 7, d = i & 127; *(LAS float*)(lds + AT_KM + i * 4) = KM[(size_t)(b * 8 + n) * 256 + kvh * 128 + d] * (1.0f / 256.0f); }
            const int ntile = 4 * (qb + 1);
            v4u rk[2], rv[2];
#define AT_LOADS(j_) do { const int n_ = (j_) >> 2, kt_ = (j_) & 3; const size_t key0_ = (size_t)b * SEQ + 256 * n_ + 64 * kt_; \
            _Pragma("unroll") for (int i_ = 0; i_ < 2; ++i_) { const int p_ = tid + 512 * i_; rk[i_] = *(const v4u*)(Kb + (key0_ + (p_ >> 4)) * 256 + kvh * 128 + 8 * (p_ & 15)); \
                rv[i_] = *(const v4u*)(VT + (size_t)(kvh * 128 + (p_ >> 3)) * NTOK + key0_ + 8 * (p_ & 7)); } } while (0)
#define AT_STAGE(buf_) do { _Pragma("unroll") for (int i_ = 0; i_ < 2; ++i_) { const int p_ = tid + 512 * i_; \
                *(LAS v4u*)(lds + AT_K0 + (buf_) * 17408 + (p_ >> 4) * 272 + (p_ & 15) * 16) = rk[i_]; \
                const int sg_ = p_ & 7, vo_ = (p_ >> 3) * 144 + (sg_ >> 2) * 64 + (sg_ & 1) * 32 + ((sg_ >> 1) & 1) * 8;     \
                *(LAS v2u*)(lds + AT_V0 + (buf_) * 18432 + vo_) = (v2u){rv[i_].x, rv[i_].y}; *(LAS v2u*)(lds + AT_V0 + (buf_) * 18432 + vo_ + 16) = (v2u){rv[i_].z, rv[i_].w}; } } while (0)
            AT_LOADS(0);
            __syncthreads();
            AT_STAGE(0);
            __syncthreads();
            unsigned sel[2];
#pragma unroll
            for (int u = 0; u < 2; ++u) {
                float gate[7];
#pragma unroll
                for (int n = 0; n < 7; ++n) { gate[n] = NEG;
                    if (n < qb) { float s = 0.f;
#pragma unroll
                        for (int kp = 0; kp < 4; ++kp) { const v4u qw = __builtin_bit_cast(v4u, qf[u][kp]); const LAS float* kmp = (const LAS float*)(lds + AT_KM) + n * 128 + 32 * kp + 8 * g;
                            const f32x4 k0 = *(const LAS f32x4*)kmp, k1 = *(const LAS f32x4*)(kmp + 4);
                            s += bflo(qw.x) * k0[0] + bfhi(qw.x) * k0[1] + bflo(qw.y) * k0[2] + bfhi(qw.y) * k0[3] + bflo(qw.z) * k1[0] + bfhi(qw.z) * k1[1] + bflo(qw.w) * k1[2] + bfhi(qw.w) * k1[3]; }
                        s += __shfl_xor(s, 16); s += __shfl_xor(s, 32); gate[n] = s; } }
                unsigned sm = 0u;
                if (qb <= 3) sm = (1u << qb) - 1u;
                else {
#pragma unroll
                    for (int rnd = 0; rnd < 3; ++rnd) { float bv = NEG; int bi = 0;
#pragma unroll
                        for (int n = 0; n < 7; ++n) { const bool ok = (n < qb) && !((sm >> n) & 1u) && (gate[n] > bv); bv = ok ? gate[n] : bv; bi = ok ? n : bi; }
                        sm |= 1u << bi; }
                }
                sel[u] = sm;
            }
            f32x4 accO[2][8]; float m_run[2], l_run[2];
#pragma unroll
            for (int u = 0; u < 2; ++u) { m_run[u] = -1e30f; l_run[u] = 0.f;
#pragma unroll
                for (int jd = 0; jd < 8; ++jd) accO[u][jd] = (f32x4){0.f, 0.f, 0.f, 0.f}; }
            for (int j = 0; j < ntile; ++j) {
                if (j + 1 < ntile) AT_LOADS(j + 1);
                const int buf = j & 1, n = j >> 2, kt = j & 3; const bool own = (n == qb);
                const bool active = !own || (64 * kt <= 32 * w + 31);
                if (active) {
                    const LAS unsigned char* kb = lds + AT_K0 + buf * 17408; const LAS unsigned char* vb = lds + AT_V0 + buf * 18432;
                    f32x4 S[2][4];
#pragma unroll
                    for (int i = 0; i < 4; ++i) { bf16x8 kf[4];
#pragma unroll
                        for (int kp = 0; kp < 4; ++kp) kf[kp] = *(const LAS bf16x8*)(kb + (16 * i + l15) * 272 + (32 * kp + 8 * g) * 2);
#pragma unroll
                        for (int u = 0; u < 2; ++u) { f32x4 a = (f32x4){0.f, 0.f, 0.f, 0.f};
#pragma unroll
                            for (int kp = 0; kp < 4; ++kp) a = MFMA16(kf[kp], qf[u][kp], a);
                            S[u][i] = a; } }
                    bf16x8 pf[2][2];
#pragma unroll
                    for (int u = 0; u < 2; ++u) {
                        const bool allowed = own || ((sel[u] >> n) & 1u);
                        if (own && (64 * kt + 63 > 32 * w + 16 * u)) {
                            const int qpos = 32 * w + 16 * u + l15;
#pragma unroll
                            for (int i = 0; i < 4; ++i)
#pragma unroll
                                for (int r = 0; r < 4; ++r) { const int kpos = 64 * kt + 16 * i + 4 * g + r; S[u][i][r] = (kpos <= qpos) ? S[u][i][r] : NEG; }
                        }
                        float mx = fmaxf(fmaxf(S[u][0][0], S[u][0][1]), fmaxf(S[u][0][2], S[u][0][3]));
#pragma unroll
                        for (int i = 1; i < 4; ++i) mx = fmaxf(mx, fmaxf(fmaxf(S[u][i][0], S[u][i][1]), fmaxf(S[u][i][2], S[u][i][3])));
                        mx = fmaxf(mx, __shfl_xor(mx, 16)); mx = fmaxf(mx, __shfl_xor(mx, 32));
                        mx = allowed ? mx : NEG;
                        if (__any((mx - m_run[u]) * SC2 > 8.f)) {
                            const float mn = fmaxf(m_run[u], mx);
                            const float alpha = __builtin_amdgcn_exp2f((m_run[u] - mn) * SC2);
                            m_run[u] = mn; l_run[u] *= alpha;
#pragma unroll
                            for (int jd = 0; jd < 8; ++jd) accO[u][jd] = accO[u][jd] * alpha;
                        }
                        const float mb = allowed ? m_run[u] * SC2 : __builtin_inff(); float ps = 0.f;
#pragma unroll
                        for (int i = 0; i < 4; ++i)
#pragma unroll
                            for (int r = 0; r < 4; ++r) { const float p = __builtin_amdgcn_exp2f(S[u][i][r] * SC2 - mb); S[u][i][r] = p; ps += p; }
                        ps += __shfl_xor(ps, 16); ps += __shfl_xor(ps, 32);
                        l_run[u] += ps;
#pragma unroll
                        for (int kp = 0; kp < 2; ++kp) { v4u o; o.x = pk2(S[u][2 * kp][0], S[u][2 * kp][1]); o.y = pk2(S[u][2 * kp][2], S[u][2 * kp][3]); o.z = pk2(S[u][2 * kp + 1][0], S[u][2 * kp + 1][1]); o.w = pk2(S[u][2 * kp + 1][2], S[u][2 * kp + 1][3]);
                            pf[u][kp] = __builtin_bit_cast(bf16x8, o); }
                    }
#pragma unroll
                    for (int jd = 0; jd < 8; ++jd)
#pragma unroll
                        for (int kp = 0; kp < 2; ++kp) {
                            const bf16x8 vf = *(const LAS bf16x8*)(vb + (16 * jd + l15) * 144 + kp * 64 + g * 16);
                            accO[0][jd] = MFMA16(vf, pf[0][kp], accO[0][jd]); accO[1][jd] = MFMA16(vf, pf[1][kp], accO[1][jd]); }
                }
                if (j + 1 < ntile) AT_STAGE(buf ^ 1);
                __syncthreads();
            }
#pragma unroll
            for (int u = 0; u < 2; ++u) { const float rl = 1.0f / l_run[u]; bf16* orow = ATT + (row0 + 16 * u + l15) * 1024 + h * 128 + 4 * g;
#pragma unroll
                for (int jd = 0; jd < 8; ++jd) { v2u o; o.x = pk2(accO[u][jd][0] * rl, accO[u][jd][1] * rl); o.y = pk2(accO[u][jd][2] * rl, accO[u][jd][3] * rl); *(v2u*)(orow + 16 * jd) = o; } }
#undef AT_LOADS
#undef AT_STAGE
        }
    }
}

constexpr int AT3_K = 0, AT3_V = 49152, AT3_KM = 98304;
__device__ __forceinline__ void moba_phase_dma(LAS unsigned char* lds, const bf16* Qb, const bf16* Kb, const bf16* VT, const float* KM, bf16* ATT, int vcu, int G, int tid) {
    const int lane = tid & 63, w = __builtin_amdgcn_readfirstlane(tid >> 6), l15 = lane & 15, g = lane >> 4;
    constexpr float SC2 = 0.08838834764831845f * 1.4426950408889634f;
    const float NEG = -__builtin_inff();
    int kofs[2], vofs[2];
#pragma unroll
    for (int i = 0; i < 2; ++i) { const int p = (w * 2 + i) * 64 + lane; { const int r = p >> 4, c = (p & 15) ^ (r & 15); kofs[i] = r * 256 + c * 8; }
        { const int d = p >> 3, c = (p & 7) ^ ((d >> 1) & 7); vofs[i] = d * NTOK + c * 8; } }
    const int kl = 8 * (l15 >> 2) + (l15 & 3);
    const int vsw = (l15 >> 1) & 7;
    for (int item = vcu; item < 512; item += G) {
        const int bh = item >> 2, pr = item & 3, b = bh >> 3, h = bh & 7, kvh = h >> 2;
        for (int half = 0; half < 2; ++half) {
            const int qb = half ? pr : 7 - pr;
            const size_t row0 = (size_t)b * SEQ + 256 * qb + 32 * w;
            bf16x8 qf[2][4];
#pragma unroll
            for (int u = 0; u < 2; ++u)
#pragma unroll
                for (int kp = 0; kp < 4; ++kp) qf[u][kp] = *(const bf16x8*)(Qb + (row0 + 16 * u + l15) * 1024 + h * 128 + 32 * kp + 8 * g);
            for (int i = tid; i < 1024; i += 512) { const int n = i >> 7, d = i & 127; *(LAS float*)(lds + AT3_KM + i * 4) = KM[(size_t)(b * 8 + n) * 256 + kvh * 128 + d] * (1.0f / 256.0f); }
            const int ntile = 4 * (qb + 1);
#define AT_DMA(j_, slot_) do { const int n_ = (j_) >> 2, kt_ = (j_) & 3; const size_t key0_ = (size_t)b * SEQ + 256 * n_ + 64 * kt_; \
            _Pragma("unroll") for (int i_ = 0; i_ < 2; ++i_) { \
                __builtin_amdgcn_global_load_lds((const unsigned*)(Kb + key0_ * 256 + kvh * 128 + kofs[i_]), (LAS unsigned*)(lds + AT3_K + (slot_) * 16384 + (w * 2 + i_) * 1024), 16, 0, 0); \
                __builtin_amdgcn_global_load_lds((const unsigned*)(VT + (size_t)kvh * 128 * NTOK + key0_ + vofs[i_]), (LAS unsigned*)(lds + AT3_V + (slot_) * 16384 + (w * 2 + i_) * 1024), 16, 0, 0); } } while (0)
            asm volatile("s_waitcnt vmcnt(0) lgkmcnt(0)" ::: "memory"); __builtin_amdgcn_s_barrier(); asm volatile("" ::: "memory");
            AT_DMA(0, 0); AT_DMA(1, 1);
            asm volatile("s_waitcnt lgkmcnt(0)" ::: "memory"); __builtin_amdgcn_s_barrier(); asm volatile("" ::: "memory");
            unsigned sel[2];
#pragma unroll
            for (int u = 0; u < 2; ++u) {
                float gate[7];
#pragma unroll
                for (int n = 0; n < 7; ++n) { gate[n] = NEG;
                    if (n < qb) { float s = 0.f;
#pragma unroll
                        for (int kp = 0; kp < 4; ++kp) { const v4u qw = __builtin_bit_cast(v4u, qf[u][kp]); const LAS float* kmp = (const LAS float*)(lds + AT3_KM) + n * 128 + 32 * kp + 8 * g;
                            const f32x4 k0 = *(const LAS f32x4*)kmp, k1 = *(const LAS f32x4*)(kmp + 4);
                            s += bflo(qw.x) * k0[0] + bfhi(qw.x) * k0[1] + bflo(qw.y) * k0[2] + bfhi(qw.y) * k0[3] + bflo(qw.z) * k1[0] + bfhi(qw.z) * k1[1] + bflo(qw.w) * k1[2] + bfhi(qw.w) * k1[3]; }
                        s += __shfl_xor(s, 16); s += __shfl_xor(s, 32); gate[n] = s; } }
                unsigned sm = 0u;
                if (qb <= 3) sm = (1u << qb) - 1u;
                else {
#pragma unroll
                    for (int rnd = 0; rnd < 3; ++rnd) { float bv = NEG; int bi = 0;
#pragma unroll
                        for (int n = 0; n < 7; ++n) { const bool ok = (n < qb) && !((sm >> n) & 1u) && (gate[n] > bv); bv = ok ? gate[n] : bv; bi = ok ? n : bi; }
                        sm |= 1u << bi; }
                }
                sel[u] = sm;
            }
            f32x4 accO[2][8]; float m_run[2], l_run[2];
#pragma unroll
            for (int u = 0; u < 2; ++u) { m_run[u] = -1e30f; l_run[u] = 0.f;
#pragma unroll
                for (int jd = 0; jd < 8; ++jd) accO[u][jd] = (f32x4){0.f, 0.f, 0.f, 0.f}; }
            int slot = 0;
            for (int j = 0; j < ntile; ++j) {
                if (j + 1 < ntile) asm volatile("s_waitcnt vmcnt(4)" ::: "memory"); else asm volatile("s_waitcnt vmcnt(0)" ::: "memory");
                __builtin_amdgcn_s_barrier(); asm volatile("" ::: "memory");
                if (j + 2 < ntile) { const int s2 = slot == 0 ? 2 : slot - 1; AT_DMA(j + 2, s2); }
                const int n = j >> 2, kt = j & 3; const bool own = (n == qb);
                const bool active = !own || (64 * kt <= 32 * w + 31);
                if (active) {
                    const LAS unsigned char* kb = lds + AT3_K + slot * 16384; const LAS unsigned char* vb = lds + AT3_V + slot * 16384;
                    f32x4 S[2][4];
#pragma unroll
                    for (int i = 0; i < 4; ++i) { bf16x8 kf[4];
#pragma unroll
                        for (int kp = 0; kp < 4; ++kp) kf[kp] = *(const LAS bf16x8*)(kb + (kl + 32 * (i >> 1) + 4 * (i & 1)) * 256 + (((4 * kp + g) ^ ((kl & 15) | (4 * (i & 1)))) << 4));
#pragma unroll
                        for (int u = 0; u < 2; ++u) { f32x4 a = (f32x4){0.f, 0.f, 0.f, 0.f};
#pragma unroll
                            for (int kp = 0; kp < 4; ++kp) a = MFMA16(kf[kp], qf[u][kp], a);
                            S[u][i] = a; } }
                    bf16x8 pf[2][2];
#pragma unroll
                    for (int u = 0; u < 2; ++u) {
                        const bool allowed = own || ((sel[u] >> n) & 1u);
                        if (own && (64 * kt + 63 > 32 * w + 16 * u)) {
                            const int qpos = 32 * w + 16 * u + l15;
#pragma unroll
                            for (int i = 0; i < 4; ++i)
#pragma unroll
                                for (int r = 0; r < 4; ++r) { const int kpos = 64 * kt + 32 * (i >> 1) + 8 * g + 4 * (i & 1) + r; S[u][i][r] = (kpos <= qpos) ? S[u][i][r] : NEG; }
                        }
                        float mx = fmaxf(fmaxf(S[u][0][0], S[u][0][1]), fmaxf(S[u][0][2], S[u][0][3]));
#pragma unroll
                        for (int i = 1; i < 4; ++i) mx = fmaxf(mx, fmaxf(fmaxf(S[u][i][0], S[u][i][1]), fmaxf(S[u][i][2], S[u][i][3])));
                        mx = fmaxf(mx, __shfl_xor(mx, 16)); mx = fmaxf(mx, __shfl_xor(mx, 32));
                        mx = allowed ? mx : NEG;
                        if (__any((mx - m_run[u]) * SC2 > 8.f)) {
                            const float mn = fmaxf(m_run[u], mx);
                            const float alpha = __builtin_amdgcn_exp2f((m_run[u] - mn) * SC2);
                            m_run[u] = mn; l_run[u] *= alpha;
#pragma unroll
                            for (int jd = 0; jd < 8; ++jd) accO[u][jd] = accO[u][jd] * alpha;
                        }
                        const float mb = allowed ? m_run[u] * SC2 : __builtin_inff(); float ps = 0.f;
#pragma unroll
                        for (int i = 0; i < 4; ++i)
#pragma unroll
                            for (int r = 0; r < 4; ++r) { const float p = __builtin_amdgcn_exp2f(S[u][i][r] * SC2 - mb); S[u][i][r] = p; ps += p; }
                        ps += __shfl_xor(ps, 16); ps += __shfl_xor(ps, 32);
                        l_run[u] += ps;
#pragma unroll
                        for (int kp = 0; kp < 2; ++kp) { v4u o; o.x = pk2(S[u][2 * kp][0], S[u][2 * kp][1]); o.y = pk2(S[u][2 * kp][2], S[u][2 * kp][3]); o.z = pk2(S[u][2 * kp + 1][0], S[u][2 * kp + 1][1]); o.w = pk2(S[u][2 * kp + 1][2], S[u][2 * kp + 1][3]);
                            pf[u][kp] = __builtin_bit_cast(bf16x8, o); }
                    }
#pragma unroll
                    for (int jd = 0; jd < 8; ++jd)
#pragma unroll
                        for (int kp = 0; kp < 2; ++kp) {
                            const bf16x8 vf = *(const LAS bf16x8*)(vb + (16 * jd + l15) * 128 + (((4 * kp + g) ^ vsw) << 4));
                            accO[0][jd] = MFMA16(vf, pf[0][kp], accO[0][jd]); accO[1][jd] = MFMA16(vf, pf[1][kp], accO[1][jd]); }
                }
                slot = slot == 2 ? 0 : slot + 1;
            }
#pragma unroll
            for (int u = 0; u < 2; ++u) { const float rl = 1.0f / l_run[u]; bf16* orow = ATT + (row0 + 16 * u + l15) * 1024 + h * 128 + 4 * g;
#pragma unroll
                for (int jd = 0; jd < 8; ++jd) { v2u o; o.x = pk2(accO[u][jd][0] * rl, accO[u][jd][1] * rl); o.y = pk2(accO[u][jd][2] * rl, accO[u][jd][3] * rl); *(v2u*)(orow + 16 * jd) = o; } }
#undef AT_DMA
        }
    }
}

struct Args { const float* in[18]; float* out; unsigned char* ws; int ph_lo, ph_hi, bar_region, pad; };
__global__ void __launch_bounds__(NWAVES * 64, 2) yoco_fwd(Args args) {
    extern __shared__ __attribute__((aligned(16))) unsigned char lds_raw[];
    LAS unsigned char* lds = (LAS unsigned char*)lds_raw;
    volatile LAS unsigned* MISC = (volatile LAS unsigned*)(lds + MISC_OFF);
    const int tid = threadIdx.x, lane = tid & 63, wave = __builtin_amdgcn_readfirstlane(tid >> 6);
    const int G = gridDim.x; const int bx = blockIdx.x; const int vcu = (G % 8 == 0) ? (bx % 8) * (G / 8) + bx / 8 : bx;
    const int gw = vcu * NWAVES + wave, NGW = G * NWAVES;
    unsigned char* ws = args.ws;
    gu32* ctl = (gu32*)(ws + WS_CTL);
    const float* x_in = args.in[0]; const float* mlstm_norm = args.in[1]; const float* mlstm_w_in = args.in[2]; const float* mlstm_b_if = args.in[3]; const float* mlstm_out_norm = args.in[4];
    const float* mlstm_w_out = args.in[5]; const float* ffn_norm = args.in[6]; const float* dense_w_gu = args.in[7]; const float* dense_w_down = args.in[8]; const float* moe_router = args.in[9];
    const float* moe_w_gu = args.in[10]; const float* moe_w_down = args.in[11]; const float* kv_norm = args.in[12]; const float* kv_w = args.in[13]; const float* moba_norm = args.in[14];
    const float* moba_w_q = args.in[15]; const float* moba_w_o = args.in[16]; const float* final_norm = args.in[17];
    float* X = args.out;
    bf16* Win_t = (bf16*)(ws + WS_WIN); bf16* Wout_t = (bf16*)(ws + WS_WOUT); bf16* Wgu_t = (bf16*)(ws + WS_WGU); bf16* Wdn_t = (bf16*)(ws + WS_WDN);
    bf16* Wqkv_t = (bf16*)(ws + WS_WQKV); bf16* Wo_t = (bf16*)(ws + WS_WO); bf16* Wmgu_t = (bf16*)(ws + WS_WMGU); bf16* Wmdn_t = (bf16*)(ws + WS_WMDN);
    bf16* XN = (bf16*)(ws + WS_A); bf16* XB = (bf16*)(ws + WS_A + 64 * MiB); float* PART = (float*)(ws + WS_PART); float* RS = (float*)(ws + WS_RS); float* MS = (float*)(ws + WS_MS); bf16* APERM = (bf16*)(ws + WS_A); bf16* Y = (bf16*)(ws + WS_A);
    bf16* QKO = (bf16*)(ws + WS_QKO); bf16* KVT = (bf16*)(ws + WS_KVT); bf16* Hb = (bf16*)(ws + WS_H); bf16* ACT = (bf16*)(ws + WS_ACT);
    bf16* Qb = (bf16*)(ws + WS_Q); bf16* Kb = (bf16*)(ws + WS_K); bf16* VTb = (bf16*)(ws + WS_VT); bf16* ATT = (bf16*)(ws + WS_ATT); bf16* ACT2 = (bf16*)(ws + WS_ACT2); bf16* Y2 = (bf16*)(ws + WS_Y2);
    float* KM = (float*)(ws + WS_KM); float* ROPE = (float*)(ws + WS_ROPE); float* GATES = (float*)(ws + WS_GATES);
    unsigned* ME = (unsigned*)(ws + WS_ME); float* MW = (float*)(ws + WS_MW); unsigned* MR = (unsigned*)(ws + WS_MR); unsigned* MP = (unsigned*)(ws + WS_MP);
    unsigned* HIST = (unsigned*)(ws + WS_HIST); unsigned* PB = (unsigned*)(ws + WS_PB);

    for (int u = tid; u < (LDS_BYTES - LDSCTL_OFF) / 4; u += NWAVES * 64) ((LAS unsigned*)(lds + LDSCTL_OFF))[u] = 0u;
    __syncthreads();
    unsigned* barw = (unsigned*)(ctl + CW_BAR) + args.bar_region * XCD_BAR_WORDS;
    XcdBarrier bar; bar.bar = barw; bar.x = 0; bar.st = nullptr;
    if (!MK_PER_PHASE) bar = xcd_barrier_post(barw, MISC + 8);
    const int lo = args.ph_lo, hi = args.ph_hi;
#define IN(k) (lo <= (k) && (k) < hi)
#define SEAM(k) do { if (IN(k) && IN((k) + 1)) { if (MK_PER_PHASE) { if (tid == 0) __hip_atomic_store(ctl, 0xBADBA0u, RLX_AGENT); } else xcd_barrier(bar); } } while (0)

    if (IN(0)) {
        LAS TDesc* td = (LAS TDesc*)(lds + 8 * 8448);
        if (tid == 0) { int run = 0;
            tdesc_set(td + 0, run, dense_w_gu, Wgu_t, ffn_norm, 5632, 0, 5632, 1024, 1, 1024, 0, 1, DFF, 0, DENSE_F8 ? WGU_SC : 1.f, DENSE_F8);
            tdesc_set(td + 1, run, dense_w_down, Wdn_t, nullptr, 1024, 0, 1024, DFF, 1, DFF, 0, 0, 0, 0, DOWN_F8 ? WDN_SC : 1.f, DOWN_F8);
            tdesc_set(td + 2, run, mlstm_w_in, Win_t, mlstm_norm, WIN_LD, 0, 512, 1024, 1, 1024, 0, 0, 0, 0, 0.08838834764831845f);
            tdesc_set(td + 3, run, mlstm_w_in, Win_t, mlstm_norm, WIN_LD, 512, 512, 1024, 1, 1024, 0, 0, 0, 1536, 1.f);
            tdesc_set(td + 4, run, mlstm_w_in, Win_t, mlstm_norm, WIN_LD, 1024, 1024, 1024, 1, 1024, 0, 0, 0, 2048, 1.f);
            tdesc_set(td + 5, run, mlstm_w_in, Win_t, mlstm_norm, WIN_LD, 2048, 1024, 1024, 1, 1024, 0, 0, 0, 512, 1.f);
            tdesc_set(td + 6, run, mlstm_w_out, Wout_t, nullptr, 1024, 0, 1024, 1024, 1, 1024, 0, 0, 0, 0, 1.f);
            tdesc_set(td + 7, run, moba_w_q, Wqkv_t, moba_norm, 1024, 0, 1024, 1024, 1, 1024, 0, 0, 0, 0, 1.f);
            tdesc_set(td + 8, run, kv_w, Wqkv_t, kv_norm, 512, 0, 512, 1024, 1, 1024, 0, 0, 0, 1024, 1.f);
            tdesc_set(td + 9, run, moba_w_o, Wo_t, nullptr, 1024, 0, 1024, 1024, 1, 1024, 0, 0, 0, 0, 1.f);
            if (!SIDEJOB) {
                tdesc_set(td + 10, run, moe_w_gu, Wmgu_t, ffn_norm + 1024, 7168, 0, 7168, 1024, 8, 1024, 7168, 1, DEXP, 0, MOE_F8 ? WGU_SC : 1.f, MOE_F8);
                tdesc_set(td + 11, run, moe_w_down, Wmdn_t, nullptr, 1024, 0, 1024, DEXP, 8, DEXP, 1024, 0, 0, 0, MOE_F8 ? WDN_SC : 1.f, MOE_F8); }
        }
        __syncthreads();
        const int nitems = td[NDESC - 1].item0 + td[NDESC - 1].nitem;
        LAS float* scr = (LAS float*)(lds + wave * 8448);
        {
            f32x4 va[8], vb[8]; int it = gw, da = 0, db = 0;
#define TD_FIND(it_, d_) do { d_ = 0; _Pragma("unroll") for (int q = 1; q < NDESC; ++q) d_ += ((it_) >= td[q].item0) ? 1 : 0; } while (0)
            if (it < nitems) { TD_FIND(it, da); titem_load(td + da, it - td[da].item0, lane, va); }
            while (it < nitems) {
                int nx = it + NGW;
                if (nx < nitems) { TD_FIND(nx, db); titem_load(td + db, nx - td[db].item0, lane, vb); }
                titem_store(td + da, it - td[da].item0, scr, lane, va);
                it = nx; if (it >= nitems) break;
                nx = it + NGW;
                if (nx < nitems) { TD_FIND(nx, da); titem_load(td + da, nx - td[da].item0, lane, va); }
                titem_store(td + db, it - td[db].item0, scr, lane, vb);
                it = nx;
            }
#undef TD_FIND
        }
        for (int i = vcu * 512 + tid; i < 2048 * 16; i += G * 512) { const int pos = i >> 4, fi = i & 15; double s, c; sincos_d((double)pos * inv_freq_d(fi), s, c); ROPE[pos * 32 + fi] = (float)c; ROPE[pos * 32 + 16 + fi] = (float)s; }
        {
            float wg[4][4][8];
#pragma unroll
            for (int j = 0; j < 4; ++j)
#pragma unroll
                for (int e = 0; e < 4; ++e) { const int k = 4 * lane + 256 * j + e; const float gk = mlstm_norm[k]; const f32x4 a = *(const f32x4*)(mlstm_w_in + (size_t)k * WIN_LD + 3072), bq = *(const f32x4*)(mlstm_w_in + (size_t)k * WIN_LD + 3076);
#pragma unroll
                    for (int c = 0; c < 4; ++c) { wg[j][e][c] = a[c] * gk; wg[j][e][4 + c] = bq[c] * gk; } }
            for (int m = gw; m < NTOK; m += NGW) {
                f32x4 v[4]; load_row(x_in + (size_t)m * DM, lane, v);
                const float rinv = 1.0f / sqrtf(row_sumsq(v) * (1.0f / DM) + EPS);
                store_row_bf16(XN + (size_t)m * DM, lane, v, rinv);
                float gs[8];
#pragma unroll
                for (int c = 0; c < 8; ++c) { float s = 0.f;
#pragma unroll
                    for (int j = 0; j < 4; ++j)
#pragma unroll
                        for (int e = 0; e < 4; ++e) s += v[j][e] * wg[j][e][c];
                    gs[c] = wave_sum(s) * rinv; }
                float mine = gs[0];
#pragma unroll
                for (int c = 1; c < 8; ++c) mine = (lane == c) ? gs[c] : mine;
                if (lane < 8) GATES[(size_t)m * 8 + lane] = mine;
            }
        }
    }
    SEAM(0);
#ifdef PROBE_BARRIERS
    if (!MK_PER_PHASE && IN(0) && IN(1)) { for (int r = 0; r < PROBE_BARRIERS; ++r) xcd_barrier(bar); }
#endif

    if (IN(1)) {
        { pg8::Gemm gm{XN, Win_t, NTOK, 2048, DM}; pg8::StaticOrder S; S.init(NTOK, 2048, G, bx); pg8::EpiStore E{QKO, 2048};
          pg8::gemm_phase<pg8::EpiStore, pg8::StaticOrder, true, true>(lds + RING_OFF, gm, S, E); }
        __syncthreads();
        { pg8::Gemm gm{Win_t + (size_t)1536 * DM, XN, 1536, NTOK, DM}; pg8::StaticOrder S; S.init(1536, NTOK, G, bx); pg8::EpiStore E{KVT, NTOK};
          pg8::gemm_phase<pg8::EpiStore, pg8::StaticOrder, true, true>(lds + RING_OFF, gm, S, E); }
    }
    SEAM(1);

    if (IN(2)) { __syncthreads();
        if (tid == 0) { LAS TDesc* td2 = (LAS TDesc*)(lds + ML_TD); int run = 0;
            tdesc_set(td2 + 0, run, moe_w_gu, Wmgu_t, ffn_norm + 1024, 7168, 0, 7168, 1024, 8, 1024, 7168, 1, DEXP, 0, MOE_F8 ? WGU_SC : 1.f, MOE_F8);
            tdesc_set(td2 + 1, run, moe_w_down, Wmdn_t, nullptr, 1024, 0, 1024, DEXP, 8, DEXP, 1024, 0, 0, 0, MOE_F8 ? WDN_SC : 1.f, MOE_F8); }
        __syncthreads();
        if (wave >= 4) __builtin_amdgcn_s_setprio(1);
        mlstm_phase(lds, QKO, KVT, GATES, mlstm_b_if, Hb, vcu, G, tid); __builtin_amdgcn_s_setprio(0); }
    SEAM(2);

    if (IN(3)) {
        float og[16];
#pragma unroll
        for (int i = 0; i < 16; ++i) og[i] = mlstm_out_norm[16 * lane + i];
        for (int m0 = gw; m0 < NTOK; m0 += 2 * NGW) {
            const int mm[2] = {m0, (m0 + NGW < NTOK) ? m0 + NGW : m0};
            v4u hh[2][2], oo[2][2];
#pragma unroll
            for (int r = 0; r < 2; ++r) { const size_t m = (size_t)mm[r];
                hh[r][0] = *(const v4u*)(Hb + m * 1024 + 16 * lane); hh[r][1] = *(const v4u*)(Hb + m * 1024 + 16 * lane + 8);
                oo[r][0] = *(const v4u*)(QKO + m * 2048 + 512 + 16 * lane); oo[r][1] = *(const v4u*)(QKO + m * 2048 + 512 + 16 * lane + 8); }
#pragma unroll
            for (int r = 0; r < 2; ++r) { const size_t m = (size_t)mm[r];
                float hv[16], ov[16];
#pragma unroll
                for (int q = 0; q < 2; ++q) { const v4u hw = hh[r][q], ow = oo[r][q];
                    hv[8 * q + 0] = bflo(hw.x); hv[8 * q + 1] = bfhi(hw.x); hv[8 * q + 2] = bflo(hw.y); hv[8 * q + 3] = bfhi(hw.y); hv[8 * q + 4] = bflo(hw.z); hv[8 * q + 5] = bfhi(hw.z); hv[8 * q + 6] = bflo(hw.w); hv[8 * q + 7] = bfhi(hw.w);
                    ov[8 * q + 0] = bflo(ow.x); ov[8 * q + 1] = bfhi(ow.x); ov[8 * q + 2] = bflo(ow.y); ov[8 * q + 3] = bfhi(ow.y); ov[8 * q + 4] = bflo(ow.z); ov[8 * q + 5] = bfhi(ow.z); ov[8 * q + 6] = bflo(ow.w); ov[8 * q + 7] = bfhi(ow.w); }
                float s = 0.f;
#pragma unroll
                for (int i = 0; i < 16; ++i) s += hv[i] * hv[i];
                s += __shfl_xor(s, 1); s += __shfl_xor(s, 2); s += __shfl_xor(s, 4); s += __shfl_xor(s, 8);
                const float rinv = 1.0f / sqrtf(s * (1.0f / DV) + EPS);
                float rr[16];
#pragma unroll
                for (int i = 0; i < 16; ++i) rr[i] = hv[i] * rinv * og[i] * __builtin_amdgcn_rcpf(1.0f + __expf(-ov[i]));
                v4u w0, w1; w0.x = pk2(rr[0], rr[1]); w0.y = pk2(rr[2], rr[3]); w0.z = pk2(rr[4], rr[5]); w0.w = pk2(rr[6], rr[7]); w1.x = pk2(rr[8], rr[9]); w1.y = pk2(rr[10], rr[11]); w1.z = pk2(rr[12], rr[13]); w1.w = pk2(rr[14], rr[15]);
                *(v4u*)(XN + m * 1024 + 16 * lane) = w0; *(v4u*)(XN + m * 1024 + 16 * lane + 8) = w1; }
        }
    }
    SEAM(3);

    if (IN(4)) { pg8::Gemm gm{XN, Wout_t, NTOK, DM, DM}; pg8::StaticOrder S; S.init(NTOK, DM, G, bx); pg8::EpiRes<true> E{x_in, X, XB, PART};
        pg8::gemm_phase<pg8::EpiRes<true>, pg8::StaticOrder, true, true>(lds + RING_OFF, gm, S, E); }
    SEAM(4);

#define ROW_SCALES() do { for (int row = vcu * 512 + tid; row < NTOK; row += G * 512) { const f32x4* pp = (const f32x4*)(PART + (size_t)row * 16); const f32x4 p0 = pp[0], p1 = pp[1], p2 = pp[2], p3 = pp[3]; \
        const float s_ = (((p0[0] + p0[1]) + (p0[2] + p0[3])) + ((p1[0] + p1[1]) + (p1[2] + p1[3]))) + (((p2[0] + p2[1]) + (p2[2] + p2[3])) + ((p3[0] + p3[1]) + (p3[2] + p3[3]))); \
        const float ms_ = s_ * (1.0f / DM) + EPS; MS[row] = ms_; RS[row] = 1.0f / sqrtf(ms_); } } while (0)
    if (IN(5)) { ROW_SCALES(); }
    SEAM(5);

    if (IN(6)) { pg8::Gemm gm{XB, Wgu_t, NTOK, 2 * DFF, DM}; pg8::StaticOrder S; S.init(NTOK, 2 * DFF, G, bx); pg8::EpiSwiglu<DOWN_F8 != 0, true> E{ACT, DFF, 1.f, DOWN_F8 ? ACT_SC : 1.f, RS, MS};
        pg8::gemm_phase<pg8::EpiSwiglu<DOWN_F8 != 0, true>, pg8::StaticOrder, true, true>(lds + RING_OFF, gm, S, E); }
    SEAM(6);

    if (IN(7)) { pg8::Gemm gm{ACT, Wdn_t, NTOK, DM, DOWN_F8 ? DFF / 2 : DFF}; pg8::StaticOrder S; S.init(NTOK, DM, G, bx); pg8::EpiRes<true, DOWN_F8 ? 10 : 0> E{X, X, XB, PART};
        static_assert(ACT_SC * WDN_SC == 1024.f, "P7 epilogue shift");
        pg8::gemm_phase<pg8::EpiRes<true, DOWN_F8 ? 10 : 0>, pg8::StaticOrder, true, true, DOWN_F8 != 0>(lds + RING_OFF, gm, S, E); }
    SEAM(7);

    if (IN(8)) { ROW_SCALES(); }
    SEAM(8);

    if (IN(9)) {
        constexpr long TSTEP = 256L * DM * 2;
        constexpr long WS_XB = (long)WS_A + 64L * 1048576L;
        static_assert(((long)WS_WQKV + 1280L * DM * 2 - WS_XB) % TSTEP == 0 && (WS_XB - (long)WS_WQKV) % TSTEP == 0, "swapped-unit tile offsets");
        pg8::QkvOrder S; S.so.init(NTOK, 1280, G, bx); S.G = G; S.c = bx; S.nnorm = (NTOK / 256) * 5; S.nsw = NTOK / 256;
        S.swA = (int)(((long)WS_WQKV + 1280L * DM * 2 - WS_XB) / TSTEP); S.swB = (int)((WS_XB - (long)WS_WQKV) / TSTEP);
        pg8::Gemm gm{XB, Wqkv_t, NTOK, 1280, DM}; pg8::EpiRope E{Qb, Kb, KM, ROPE, VTb, NTOK, S.swB, RS};
        pg8::gemm_phase<pg8::EpiRope, pg8::QkvOrder, true, true>(lds + RING_OFF, gm, S, E);
    }
    SEAM(9);

    if (IN(10)) { __syncthreads(); if (wave >= 4) __builtin_amdgcn_s_setprio(1);
        if (MOBA_DMA) moba_phase_dma(lds, Qb, Kb, VTb, KM, ATT, vcu, G, tid); else moba_phase(lds, Qb, Kb, VTb, KM, ATT, vcu, G, tid);
        __builtin_amdgcn_s_setprio(0); }
    SEAM(10);

    if (IN(11)) { pg8::Gemm gm{ATT, Wo_t, NTOK, DM, DM}; pg8::StaticOrder S; S.init(NTOK, DM, G, bx); pg8::EpiRes<false> E{X, X, nullptr, nullptr};
        pg8::gemm_phase<pg8::EpiRes<false>, pg8::StaticOrder, true, true>(lds + RING_OFF, gm, S, E); }
    SEAM(11);

    constexpr int ROWC_OFF = 16384;
    const bool rowcache = MOE_F8 && G == 256 && IN(12) && IN(13);
    if (IN(12)) {
        __syncthreads();
        float wr8[4][4][8];
#pragma unroll
        for (int j = 0; j < 4; ++j)
#pragma unroll
            for (int e = 0; e < 4; ++e) { const int k = 4 * lane + 256 * j + e; const float gk = ffn_norm[1024 + k]; const f32x4 a = *(const f32x4*)(moe_router + (size_t)k * 8), bq = *(const f32x4*)(moe_router + (size_t)k * 8 + 4);
#pragma unroll
                for (int c = 0; c < 4; ++c) { wr8[j][e][c] = a[c] * gk; wr8[j][e][4 + c] = bq[c] * gk; } }
        LAS unsigned* le = (LAS unsigned*)lds;
        for (int chunk = vcu; chunk < 256; chunk += G) {
            for (int i = 0; i < 16; ++i) { const int tl = 16 * wave + i; const size_t m = (size_t)chunk * 128 + tl;
                f32x4 v[4]; load_row(X + m * DM, lane, v);
                const float rinv = 1.0f / sqrtf(row_sumsq(v) * (1.0f / DM) + EPS);
                float lg[8];
#pragma unroll
                for (int c = 0; c < 8; ++c) { float s = 0.f;
#pragma unroll
                    for (int j = 0; j < 4; ++j)
#pragma unroll
                        for (int e = 0; e < 4; ++e) s += v[j][e] * wr8[j][e][c];
                    lg[c] = wave_sum(s) * rinv; }
                int e1 = 0; float l1 = lg[0];
#pragma unroll
                for (int c = 1; c < 8; ++c) { const bool gt = lg[c] > l1; l1 = gt ? lg[c] : l1; e1 = gt ? c : e1; }
                int e2 = -1; float l2 = -__builtin_inff();
#pragma unroll
                for (int c = 0; c < 8; ++c) { const bool gt = (c != e1) && (lg[c] > l2); l2 = gt ? lg[c] : l2; e2 = gt ? c : e2; }
                const float w2 = 1.0f / (1.0f + __expf(l1 - l2)), w1 = 1.0f - w2;
                if (rowcache) { LAS unsigned* rc = (LAS unsigned*)(lds + ROWC_OFF + tl * 1024) + lane; const float qs = rinv * XA_SC;
#pragma unroll
                    for (int j = 0; j < 4; ++j) rc[64 * j] = pg8::pk4_fp8(v[j][0] * qs, v[j][1] * qs, v[j][2] * qs, v[j][3] * qs); }
                if (lane == 0) { le[tl] = (unsigned)e1 | ((unsigned)e2 << 8); ME[m] = (unsigned)e1 | ((unsigned)e2 << 8); MW[2 * m] = w1; MW[2 * m + 1] = w2; }
            }
            __syncthreads();
            if (tid < 128) { const unsigned mine = le[tid]; const unsigned a1 = mine & 255u, a2 = mine >> 8; unsigned r1 = 0, r2 = 0;
                for (int j = 0; j < tid; ++j) { const unsigned o = le[j]; const unsigned b1 = o & 255u, b2 = o >> 8; r1 += (b1 == a1) + (b2 == a1); r2 += (b1 == a2) + (b2 == a2); }
                MR[(size_t)chunk * 128 + tid] = r1 | (r2 << 16); }
            else if (tid < 136) { const unsigned ex = tid - 128; unsigned cnt = 0;
                for (int j = 0; j < 128; ++j) { const unsigned o = le[j]; cnt += ((o & 255u) == ex) + ((o >> 8) == ex); }
                HIST[chunk * 8 + ex] = cnt; }
            __syncthreads();
        }
    }
    SEAM(12);

    if (IN(13)) {
        __syncthreads();
        LAS unsigned* lh = (LAS unsigned*)lds;
        LAS unsigned* pre4 = (LAS unsigned*)(lds + 8192);
        LAS unsigned* cnt = (LAS unsigned*)(lds + 8192 + 2048);
        LAS unsigned* cpre = (LAS unsigned*)(lds + 8192 + 2048 + 64);
        for (int i = tid; i < 2048; i += 512) lh[i] = HIST[i];
        __syncthreads();
        { const int ex = wave; unsigned s4 = lh[(4 * lane) * 8 + ex] + lh[(4 * lane + 1) * 8 + ex] + lh[(4 * lane + 2) * 8 + ex] + lh[(4 * lane + 3) * 8 + ex]; unsigned inc = s4;
#pragma unroll
          for (int o = 1; o < 64; o <<= 1) { const unsigned t = __shfl_up(inc, o); if (lane >= o) inc += t; }
          pre4[ex * 64 + lane] = inc - s4; if (lane == 63) cnt[ex] = inc; }
        __syncthreads();
        unsigned mybase = 0u; { unsigned run = 0;
#pragma unroll
            for (int e = 0; e < 8; ++e) { if (e == tid) mybase = run; run += (cnt[e] + 255u) & ~255u; }
            if (vcu == 0 && tid < 8) PB[tid] = mybase >> 8;
            if (vcu == 0 && tid == 0) PB[8] = run >> 8; }
        for (int chunk = vcu; chunk < 256; chunk += G) {
            if (tid < 8) { unsigned p = pre4[tid * 64 + (chunk >> 2)]; for (int c2 = chunk & ~3; c2 < chunk; ++c2) p += lh[c2 * 8 + tid]; cpre[tid] = p + mybase; }
            __syncthreads();
            for (int i = 0; i < 16; ++i) { const size_t m = (size_t)chunk * 128 + 16 * wave + i;
                const unsigned me = ME[m], mr = MR[m]; const unsigned e1 = me & 255u, e2 = me >> 8;
                const unsigned s1 = cpre[e1] + (mr & 0xffffu), s2 = cpre[e2] + (mr >> 16);
                if (rowcache) { const LAS unsigned* rc = (const LAS unsigned*)(lds + ROWC_OFF + (16 * wave + i) * 1024) + lane;
                    unsigned* o1 = (unsigned*)((unsigned char*)APERM + (size_t)s1 * DM) + lane; unsigned* o2 = (unsigned*)((unsigned char*)APERM + (size_t)s2 * DM) + lane;
#pragma unroll
                    for (int j = 0; j < 4; ++j) { const unsigned w = rc[64 * j]; o1[64 * j] = w; o2[64 * j] = w; } }
                else {
                f32x4 v[4]; load_row(X + m * DM, lane, v);
                const float rinv = 1.0f / sqrtf(row_sumsq(v) * (1.0f / DM) + EPS);
                if (MOE_F8) { store_row_fp8((unsigned char*)APERM + (size_t)s1 * DM, lane, v, rinv * XA_SC); store_row_fp8((unsigned char*)APERM + (size_t)s2 * DM, lane, v, rinv * XA_SC); }
                else { store_row_bf16(APERM + (size_t)s1 * DM, lane, v, rinv); store_row_bf16(APERM + (size_t)s2 * DM, lane, v, rinv); } }
                if (lane == 0) { MP[2 * m] = s1; MP[2 * m + 1] = s2; } }
            __syncthreads();
        }
    }
    SEAM(13);

    if (IN(14)) { const int npan = (int)PB[8];
        pg8::MoeOrder S; S.so.init(npan * 256, 2 * DEXP, G, bx); S.nct = 2 * DEXP / 256; S.pb1 = PB[1]; S.pb2 = PB[2]; S.pb3 = PB[3]; S.pb4 = PB[4]; S.pb5 = PB[5]; S.pb6 = PB[6]; S.pb7 = PB[7];
        pg8::Gemm gm{APERM, Wmgu_t, npan * 256, 2 * DEXP, MOE_F8 ? DM / 2 : DM};
#ifdef PROBE_NULL_EPI
        if (args.pad) { pg8::EpiNull E{(float*)(ws + WS_PART)}; pg8::gemm_phase<pg8::EpiNull, pg8::MoeOrder, true, true, MOE_F8 != 0>(lds + RING_OFF, gm, S, E); } else
#endif
        { pg8::EpiSwiglu<MOE_F8 != 0> E{ACT2, DEXP, MOE_F8 ? 1.f / (XA_SC * WGU_SC) : 1.f, MOE_F8 ? ACT_SC : 1.f, nullptr, nullptr};
        pg8::gemm_phase<pg8::EpiSwiglu<MOE_F8 != 0>, pg8::MoeOrder, true, true, MOE_F8 != 0>(lds + RING_OFF, gm, S, E); } }
    SEAM(14);

    if (IN(15)) { const int npan = (int)PB[8]; const int nmain = npan < 256 ? npan : 256; constexpr int KU = MOE_F8 ? DEXP / 2 : DEXP;
        { pg8::MoeOrder S; S.so.init(nmain * 256, DM, G, bx); S.nct = DM / 256; S.pb1 = PB[1]; S.pb2 = PB[2]; S.pb3 = PB[3]; S.pb4 = PB[4]; S.pb5 = PB[5]; S.pb6 = PB[6]; S.pb7 = PB[7];
          pg8::Gemm gm{ACT2, Wmdn_t, nmain * 256, DM, KU}; pg8::EpiStore E{Y, DM};
          pg8::gemm_phase<pg8::EpiStore, pg8::MoeOrder, true, true, MOE_F8 != 0>(lds + RING_OFF, gm, S, E); }
        if (npan > nmain) {
            __syncthreads();
            pg8::TailOrder T; T.c = bx; T.ntail = (npan - nmain) * 4; T.pm0 = nmain; T.nct = DM / 256; T.pb1 = PB[1]; T.pb2 = PB[2]; T.pb3 = PB[3]; T.pb4 = PB[4]; T.pb5 = PB[5]; T.pb6 = PB[6]; T.pb7 = PB[7];
            const int half = bx & 1; const size_t koff = half ? (size_t)(KU / 2) : 0;
            pg8::Gemm gt{ACT2 + koff, Wmdn_t + koff, npan * 256, DM, KU, KU / 2};
            pg8::EpiStore E2{half ? Y2 - (size_t)nmain * 256 * DM : Y, DM};
            pg8::gemm_phase<pg8::EpiStore, pg8::TailOrder, true, true, MOE_F8 != 0>(lds + RING_OFF, gt, T, E2);
        }
    }
    SEAM(15);

    if (IN(16)) {
        f32x4 fg[4]; load_row(final_norm, lane, fg);
        const bool bad = (__hip_atomic_load(ctl, RLX_AGENT) != 0u) || (__hip_atomic_load((gu32*)(barw + XB_TMO), RLX_AGENT) != 0u);
        const float ysc = MOE_F8 ? 1.f / (ACT_SC * WDN_SC) : 1.f;
        for (int m0 = gw; m0 < NTOK; m0 += 2 * NGW) {
            const int mm[2] = {m0, (m0 + NGW < NTOK) ? m0 + NGW : m0};
            f32x4 v[2][4]; v2u ya[2][4], yb[2][4]; float w1[2], w2[2]; unsigned s1v[2], s2v[2];
#pragma unroll
            for (int r = 0; r < 2; ++r) { const size_t m = (size_t)mm[r]; load_row(X + m * DM, lane, v[r]);
                const unsigned s1 = MP[2 * m], s2 = MP[2 * m + 1]; s1v[r] = s1; s2v[r] = s2; w1[r] = MW[2 * m] * ysc; w2[r] = MW[2 * m + 1] * ysc;
                const v2u* y1 = (const v2u*)(Y + (size_t)s1 * DM) + lane; const v2u* y2 = (const v2u*)(Y + (size_t)s2 * DM) + lane;
#pragma unroll
                for (int j = 0; j < 4; ++j) { ya[r][j] = y1[64 * j]; yb[r][j] = y2[64 * j]; } }
#pragma unroll
            for (int r = 0; r < 2; ++r) {
#pragma unroll
                for (int j = 0; j < 4; ++j) { const v2u a = ya[r][j], bq = yb[r][j];
                    v[r][j][0] += w1[r] * bflo(a.x) + w2[r] * bflo(bq.x); v[r][j][1] += w1[r] * bfhi(a.x) + w2[r] * bfhi(bq.x); v[r][j][2] += w1[r] * bflo(a.y) + w2[r] * bflo(bq.y); v[r][j][3] += w1[r] * bfhi(a.y) + w2[r] * bfhi(bq.y); }
                if (s1v[r] >= 65536u) { const v2u* t = (const v2u*)(Y2 + (size_t)(s1v[r] - 65536u) * DM) + lane;
#pragma unroll
                    for (int j = 0; j < 4; ++j) { const v2u a = t[64 * j]; v[r][j][0] += w1[r] * bflo(a.x); v[r][j][1] += w1[r] * bfhi(a.x); v[r][j][2] += w1[r] * bflo(a.y); v[r][j][3] += w1[r] * bfhi(a.y); } }
                if (s2v[r] >= 65536u) { const v2u* t = (const v2u*)(Y2 + (size_t)(s2v[r] - 65536u) * DM) + lane;
#pragma unroll
                    for (int j = 0; j < 4; ++j) { const v2u a = t[64 * j]; v[r][j][0] += w2[r] * bflo(a.x); v[r][j][1] += w2[r] * bfhi(a.x); v[r][j][2] += w2[r] * bflo(a.y); v[r][j][3] += w2[r] * bfhi(a.y); } }
                const float rinv = 1.0f / sqrtf(row_sumsq(v[r]) * (1.0f / DM) + EPS);
                f32x4* o = (f32x4*)(X + (size_t)mm[r] * DM) + lane;
#pragma unroll
                for (int j = 0; j < 4; ++j) { f32x4 rr = v[r][j] * rinv * fg[j]; if (bad) rr = (f32x4){__builtin_nanf(""), __builtin_nanf(""), __builtin_nanf(""), __builtin_nanf("")}; o[64 * j] = rr; } }
        }
    }
#undef IN
#undef SEAM
}

extern "C" void kernel_launch(void* const* d_in, const int* in_sizes, int n_in, void* d_out, int out_size, void* d_ws, size_t ws_size, hipStream_t stream) {
    static int grid = 0;
    if (grid == 0) {
        if (n_in != 18 || in_sizes[0] != NTOK * DM || out_size != NTOK * DM || ws_size < WS_END) { fprintf(stderr, "kernel_launch: unexpected shapes / workspace (n_in %d, in0 %d, out %d, ws %zu, need %zu)\n", n_in, n_in > 0 ? in_sizes[0] : -1, out_size, ws_size, (size_t)WS_END); grid = -1; return; }
        int dev = 0, cus = 0, per_cu = 0;
        if (hipGetDevice(&dev) != hipSuccess || hipDeviceGetAttribute(&cus, hipDeviceAttributeMultiprocessorCount, dev) != hipSuccess) { grid = -1; return; }
        if (hipFuncSetAttribute((const void*)yoco_fwd, hipFuncAttributeMaxDynamicSharedMemorySize, LDS_BYTES) != hipSuccess) { fprintf(stderr, "kernel_launch: hipFuncSetAttribute failed\n"); grid = -1; return; }
        if (hipOccupancyMaxActiveBlocksPerMultiprocessor(&per_cu, (const void*)yoco_fwd, NWAVES * 64, LDS_BYTES) != hipSuccess || per_cu < 1) fprintf(stderr, "kernel_launch: occupancy query reports %d workgroups per CU\n", per_cu);
        (void)hipGetLastError();
        grid = cus < 256 ? cus : 256;
    }
    if (grid < 0) return;
    if (hipMemsetAsync((char*)d_ws + WS_CTL, 0, CTL_ZERO_BYTES, stream) != hipSuccess) return;
    Args a{};
    for (int i = 0; i < 18; ++i) a.in[i] = (const float*)d_in[i];
    a.out = (float*)d_out; a.ws = (unsigned char*)d_ws;
#if MK_PER_PHASE
    for (int p = 0; p < NPHASE; ++p) { a.ph_lo = p; a.ph_hi = p + 1; hipLaunchKernelGGL(yoco_fwd, dim3(grid), dim3(NWAVES * 64), LDS_BYTES, stream, a); }
#elif MK_DUP >= 0
#ifndef MK_DUP_N
#define MK_DUP_N 1
#endif
    a.ph_lo = 0; a.ph_hi = MK_DUP + 1; a.bar_region = 0; hipLaunchKernelGGL(yoco_fwd, dim3(grid), dim3(NWAVES * 64), LDS_BYTES, stream, a);
    for (int r = 0; r < MK_DUP_N; ++r) { a.ph_lo = MK_DUP; a.ph_hi = MK_DUP + 1; a.bar_region = 1;
#ifdef PROBE_NULL_EPI
        a.pad = 1;
#endif
        hipLaunchKernelGGL(yoco_fwd, dim3(grid), dim3(NWAVES * 64), LDS_BYTES, stream, a); }
    a.pad = 0;
    if (MK_DUP + 1 < NPHASE) { a.ph_lo = MK_DUP + 1; a.ph_hi = NPHASE; a.bar_region = 2; hipLaunchKernelGGL(yoco_fwd, dim3(grid), dim3(NWAVES * 64), LDS_BYTES, stream, a); }
#else
    a.ph_lo = 0; a.ph_hi = NPHASE; hipLaunchKernelGGL(yoco_fwd, dim3(grid), dim3(NWAVES * 64), LDS_BYTES, stream, a);
#endif
}
```

```cpp
#include <hip/hip_runtime.h>
#include <cstdio>
#include <cstdint>
namespace pg8 {
#define PG8_LAS __attribute__((address_space(3)))
typedef unsigned short bf16_t;
typedef short bf16x8 __attribute__((ext_vector_type(8)));
typedef float f32x4 __attribute__((ext_vector_type(4)));
typedef unsigned u32x4 __attribute__((ext_vector_type(4)));
constexpr int BM = 256, BK = 64, HALF = 128, HTB = HALF * BK * 2  , STAGE_BYTES = 8 * HTB, NXCD = 8, WGM = 8;

__host__ __device__ __forceinline__ int lds_byte(int r, int c) { const int st = (r >> 4) * 2 + (c >> 5), rr = r & 15, cc = c & 31, ob = rr * 64 + cc * 2; return st * 1024 + (ob ^ (((ob >> 9) & 1) << 5)); }
__host__ __device__ __forceinline__ void stage_rc(int b, int& R, int& C) { const int st = b / 1024, sb = b % 1024, swz = sb ^ (((sb >> 9) & 1) << 5); R = (st >> 1) * 16 + swz / 64; C = (st & 1) * 32 + (swz % 64) / 2; }
__host__ __device__ __forceinline__ int perm32(int rho) { const int n = rho >> 4, i = rho & 15; return 8 * (i >> 2) + 4 * n + (i & 3); }

struct Unit { int pm, pn, pc; };
struct Gemm { const bf16_t* A; const bf16_t* Bt; int M, N, K, Kext; };

struct StaticOrder {
    int nM, nN, nwg, G, c;
    __host__ __device__ __forceinline__ void init(int M, int N, int G_, int c_) { nM = M / BM; nN = N / BM; nwg = nM * nN; G = G_; c = c_; }
    __host__ __device__ __forceinline__ bool next(int i, Unit& u) const {
        const long L = (long)i * G + c; if (L >= nwg) return false;
        int wgid = (int)L; { const int q = nwg / NXCD, r = nwg % NXCD, xcd = wgid % NXCD, off = wgid / NXCD; wgid = (xcd < r ? xcd * (q + 1) : r * (q + 1) + (xcd - r) * q) + off; }
        const int nig = WGM * nN, gid = wgid / nig, fm = gid * WGM, gsz = (nM - fm) < WGM ? (nM - fm) : WGM;
        u.pm = fm + ((wgid % nig) % gsz); u.pn = (wgid % nig) / gsz; u.pc = u.pn; return true;
    }
    __device__ __forceinline__ void a_ready(const Unit&) const {}
    __device__ __forceinline__ void done(const Unit&) const {}
};

__device__ __forceinline__ unsigned cvt_pk_bf16(float lo, float hi) { unsigned r; asm volatile("v_cvt_pk_bf16_f32 %0, %1, %2" : "=v"(r) : "v"(lo), "v"(hi)); return r; }
typedef float f32x2 __attribute__((ext_vector_type(2)));
typedef unsigned u32x2 __attribute__((ext_vector_type(2)));
struct EpiStore {
    static constexpr bool PERM = true, AFTER_DRAIN = false;
    bf16_t* O; int ldc;
    __device__ __forceinline__ void operator()(const f32x4 (&acc)[2][2][4][2], const Unit& u, int wr, int wc, int fr, int fq) const {
        const int row0 = u.pm * BM + wr * 64 + fr; const int col0 = u.pc * BM + wc * 32 + 8 * fq;
#pragma unroll
        for (int ai = 0; ai < 2; ++ai)
#pragma unroll
            for (int m = 0; m < 4; ++m) { bf16_t* rowp = O + (size_t)(row0 + ai * HALF + m * 16) * ldc + col0;
#pragma unroll
                for (int bj = 0; bj < 2; ++bj) { const f32x4 v0 = acc[ai][bj][m][0], v1 = acc[ai][bj][m][1];
                    u32x4 w; w.x = cvt_pk_bf16(v0[0], v0[1]); w.y = cvt_pk_bf16(v0[2], v0[3]); w.z = cvt_pk_bf16(v1[0], v1[1]); w.w = cvt_pk_bf16(v1[2], v1[3]);
                    *(u32x4*)(rowp + bj * HALF) = w; } }
    }
};
template <bool XB, int SHIFT = 0> struct EpiRes {
    static constexpr bool PERM = false, AFTER_DRAIN = false;
    const float* base; float* out; bf16_t* xb; float* part; static constexpr int ldc = 1024;
    __device__ __forceinline__ void operator()(const f32x4 (&acc)[2][2][4][2], const Unit& u, int wr, int wc, int fr, int fq) const {
        const int col0 = u.pc * BM + wc * 32 + 4 * fq;
#pragma unroll
        for (int ai = 0; ai < 2; ++ai)
#pragma unroll
            for (int m = 0; m < 4; ++m) { const int row = u.pm * BM + ai * HALF + wr * 64 + m * 16 + fr; const size_t off = (size_t)row * ldc + col0; float ss = 0.f;
#pragma unroll
                for (int bj = 0; bj < 2; ++bj)
#pragma unroll
                    for (int n = 0; n < 2; ++n) { const f32x4 bs = *(const f32x4*)(base + off + bj * HALF + n * 16); const f32x4 o = bs + acc[ai][bj][m][n] * (1.0f / (float)(1 << SHIFT)); *(f32x4*)(out + off + bj * HALF + n * 16) = o;
                        if constexpr (XB) { u32x2 w; w.x = cvt_pk_bf16(o[0], o[1]); w.y = cvt_pk_bf16(o[2], o[3]); *(u32x2*)(xb + off + bj * HALF + n * 16) = w; ss += (o[0] * o[0] + o[1] * o[1]) + (o[2] * o[2] + o[3] * o[3]); } }
                if constexpr (XB) { ss += __shfl_xor(ss, 16); ss += __shfl_xor(ss, 32); if (fq == 0) part[(size_t)row * 16 + u.pc * 4 + wc] = ss; }
                if (m & 1) asm volatile("" ::: "memory"); }
    }
};
__device__ __forceinline__ unsigned pk4_fp8(float a, float b, float c, float d) {
    a = __builtin_amdgcn_fmed3f(a, -448.f, 448.f); b = __builtin_amdgcn_fmed3f(b, -448.f, 448.f); c = __builtin_amdgcn_fmed3f(c, -448.f, 448.f); d = __builtin_amdgcn_fmed3f(d, -448.f, 448.f);
    int r = __builtin_amdgcn_cvt_pk_fp8_f32(a, b, 0, false); r = __builtin_amdgcn_cvt_pk_fp8_f32(c, d, r, true); return (unsigned)r;
}
template <bool F8OUT, bool ROWSC = false> struct EpiSwiglu {
    static constexpr bool PERM = false, AFTER_DRAIN = false;
    void* O; int ldc; float isc, osc; const float* rs; const float* ms;
    __device__ __forceinline__ void operator()(const f32x4 (&acc)[2][2][4][2], const Unit& u, int wr, int wc, int fr, int fq) const {
        const int j0 = u.pc * 128 + wc * 32 + 8 * fq; const float c1 = -1.4426950408889634f * isc, c2i = 1.0f / (isc * isc * osc);
#pragma unroll
        for (int ai = 0; ai < 2; ++ai)
#pragma unroll
            for (int m = 0; m < 4; ++m) { const int row = u.pm * BM + ai * HALF + wr * 64 + m * 16 + fr; const size_t off = (size_t)row * ldc + j0;
                float c1r = c1, c2r = c2i; if constexpr (ROWSC) { c1r = c1 * rs[row]; c2r = c2i * ms[row]; }
                f32x4 a[2];
#pragma unroll
                for (int bj = 0; bj < 2; ++bj) { const f32x4 g = acc[ai][bj][m][0], uu = acc[ai][bj][m][1];
#pragma unroll
                    for (int e = 0; e < 4; e += 2) { const f32x2 g2 = (f32x2){g[e], g[e + 1]}, u2 = (f32x2){uu[e], uu[e + 1]};
                        const f32x2 t2 = g2 * c1r; f32x2 ex; ex.x = __builtin_amdgcn_exp2f(t2.x); ex.y = __builtin_amdgcn_exp2f(t2.y);
                        const f32x2 d2 = ex * c2r + c2r; f32x2 r2; r2.x = __builtin_amdgcn_rcpf(d2.x); r2.y = __builtin_amdgcn_rcpf(d2.y);
                        const f32x2 o2 = (g2 * u2) * r2; a[bj][e] = o2.x; a[bj][e + 1] = o2.y; } }
                if constexpr (F8OUT) { u32x2 w; w.x = pk4_fp8(a[0][0], a[0][1], a[0][2], a[0][3]); w.y = pk4_fp8(a[1][0], a[1][1], a[1][2], a[1][3]); *(u32x2*)((unsigned char*)O + off) = w; }
                else { u32x4 w; w.x = cvt_pk_bf16(a[0][0], a[0][1]); w.y = cvt_pk_bf16(a[0][2], a[0][3]); w.z = cvt_pk_bf16(a[1][0], a[1][1]); w.w = cvt_pk_bf16(a[1][2], a[1][3]); *(u32x4*)((bf16_t*)O + off) = w; }
                if (m & 1) __builtin_amdgcn_sched_barrier(0); }
    }
};
struct EpiRope {
    static constexpr bool PERM = false, AFTER_DRAIN = false;
    bf16_t* Q; bf16_t* Kb; float* KM; const float* rope;
    bf16_t* VT; int vt_ld, vt_pn0; const float* rs;
    __device__ __forceinline__ void operator()(const f32x4 (&acc)[2][2][4][2], const Unit& u, int wr, int wc, int fr, int fq) const {
        const bool isk = (u.pc == 4), isv = (u.pc == 5);
        bf16_t* base = Q + (isv ? (long)(VT - Q) : (isk ? (long)(Kb - Q) : 0L)); const int ldc = isv ? vt_ld : (isk ? 256 : 1024); const int colt = isv ? (u.pn - vt_pn0) * BM : (isk ? 0 : u.pc * BM);
        const int rowt = isv ? 0 : u.pm * BM; const bool rot = (wc == 0) && !isv;
        const int col0 = colt + wc * 32 + 4 * fq;
        f32x4 cs[2][2];
#pragma unroll
        for (int bj = 0; bj < 2; ++bj)
#pragma unroll
            for (int n = 0; n < 2; ++n) cs[bj][n] = (f32x4){0.f, 0.f, 0.f, 0.f};
#pragma unroll
        for (int ai = 0; ai < 2; ++ai)
#pragma unroll
            for (int m = 0; m < 4; ++m) { const int r = rowt + ai * HALF + wr * 64 + m * 16 + fr; bf16_t* rowp = base + (size_t)r * ldc + col0;
                f32x4 c4 = (f32x4){1.f, 1.f, 1.f, 1.f}, s4 = (f32x4){0.f, 0.f, 0.f, 0.f};
                if (rot) { const float* rp = rope + (size_t)(r & 2047) * 32 + 4 * fq; c4 = *(const f32x4*)rp; s4 = *(const f32x4*)(rp + 16); }
                const float rsr = isv ? 1.f : rs[r];
#pragma unroll
                for (int bj = 0; bj < 2; ++bj) { f32x4 x1 = acc[ai][bj][m][0] * rsr, x2 = acc[ai][bj][m][1] * rsr;
                    if (isv) { x1 = x1 * *(const f32x4*)(rs + col0 + bj * HALF); x2 = x2 * *(const f32x4*)(rs + col0 + bj * HALF + 16); }
                    if (rot) { const f32x4 y1 = x1 * c4 - x2 * s4, y2 = x2 * c4 + x1 * s4; x1 = y1; x2 = y2; }
                    if (isk) { cs[bj][0] += x1; cs[bj][1] += x2; }
                    u32x2 w; w.x = cvt_pk_bf16(x1[0], x1[1]); w.y = cvt_pk_bf16(x1[2], x1[3]); *(u32x2*)(rowp + bj * HALF) = w;
                    w.x = cvt_pk_bf16(x2[0], x2[1]); w.y = cvt_pk_bf16(x2[2], x2[3]); *(u32x2*)(rowp + bj * HALF + 16) = w; } }
        if (isk) {
#pragma unroll
            for (int bj = 0; bj < 2; ++bj)
#pragma unroll
                for (int n = 0; n < 2; ++n)
#pragma unroll
                    for (int e = 0; e < 4; ++e) { float s = cs[bj][n][e]; s += __shfl_xor(s, 1); s += __shfl_xor(s, 2); s += __shfl_xor(s, 4); s += __shfl_xor(s, 8);
                        if (fr == 0) atomicAdd(KM + (size_t)u.pm * 256 + bj * HALF + wc * 32 + n * 16 + 4 * fq + e, s); }
        }
    }
};
struct QkvOrder {
    StaticOrder so; int G, c, nnorm, nsw, swA, swB;
    __device__ __forceinline__ bool next(int i, Unit& u) const {
        if (so.next(i, u)) return true;
        const int j = i * G + c - nnorm; if (j >= nsw) return false;
        u.pm = swA; u.pn = swB + j; u.pc = 5; return true;
    }
    __device__ __forceinline__ void a_ready(const Unit&) const {}
    __device__ __forceinline__ void done(const Unit&) const {}
};
struct TailOrder {
    int c, ntail, pm0, nct; int pb1, pb2, pb3, pb4, pb5, pb6, pb7;
    __device__ __forceinline__ bool next(int i, Unit& u) const {
        const int j = c >> 1; if (i > 0 || j >= ntail) return false;
        u.pm = pm0 + (j >> 2); u.pc = j & 3;
        const int e = (u.pm >= pb1) + (u.pm >= pb2) + (u.pm >= pb3) + (u.pm >= pb4) + (u.pm >= pb5) + (u.pm >= pb6) + (u.pm >= pb7);
        u.pn = e * nct + u.pc; return true;
    }
    __device__ __forceinline__ void a_ready(const Unit&) const {}
    __device__ __forceinline__ void done(const Unit&) const {}
};
struct EpiNull {
    static constexpr bool PERM = false, AFTER_DRAIN = false;
    float* junk;
    __device__ __forceinline__ void operator()(const f32x4 (&acc)[2][2][4][2], const Unit& u, int wr, int wc, int fr, int fq) const {
        f32x4 s = (f32x4){0.f, 0.f, 0.f, 0.f};
#pragma unroll
        for (int ai = 0; ai < 2; ++ai)
#pragma unroll
            for (int bj = 0; bj < 2; ++bj)
#pragma unroll
                for (int m = 0; m < 4; ++m)
#pragma unroll
                    for (int n = 0; n < 2; ++n) s += acc[ai][bj][m][n];
        if (s[0] + s[1] + s[2] + s[3] == 1.2345e-30f) junk[u.pm + wr + wc + fr + fq] = s[0];
    }
};
struct MoeOrder {
    StaticOrder so; int nct; int pb1, pb2, pb3, pb4, pb5, pb6, pb7;
    __device__ __forceinline__ bool next(int i, Unit& u) const {
        if (!so.next(i, u)) return false;
        const int e = (u.pm >= pb1) + (u.pm >= pb2) + (u.pm >= pb3) + (u.pm >= pb4) + (u.pm >= pb5) + (u.pm >= pb6) + (u.pm >= pb7);
        u.pc = u.pn; u.pn = e * nct + u.pc; return true;
    }
    __device__ __forceinline__ void a_ready(const Unit&) const {}
    __device__ __forceinline__ void done(const Unit&) const {}
};
typedef int i32x4 __attribute__((ext_vector_type(4)));
typedef int i32x8 __attribute__((ext_vector_type(8)));
template <class Epi, class Sched, bool ALIGN_EPI = false, bool SP2 = false, bool FP8 = false>
__device__ __forceinline__ void gemm_phase(PG8_LAS unsigned char* lds, const Gemm g, const Sched& S, const Epi& E) {
    const int tid = threadIdx.x, wid = __builtin_amdgcn_readfirstlane(tid >> 6), lane = tid & 63, wr = wid >> 2, wc = wid & 3, fr = lane & 15, fq = lane >> 4;
    const int K = g.K, nt = (g.Kext ? g.Kext : K) / BK;
    unsigned voffA[2], voffB[2];
#pragma unroll
    for (int i = 0; i < 2; ++i) { int R, C; stage_rc(tid * 16 + i * 8192, R, C); const int Rb = Epi::PERM ? ((R & ~31) + perm32(R & 31)) : R;
        voffA[i] = (unsigned)(R * K + C) * 2u; voffB[i] = (unsigned)(Rb * K + C) * 2u; }
    const size_t kstep = (size_t)(BK * 2);
    const size_t hstep = (size_t)HALF * K * 2;
    const size_t tstep = 2 * hstep;
    const unsigned ldsw = (unsigned)wid * 1024u;
    const int aoff = lds_byte(wr * 64 + fr, fq * 8), boff = lds_byte(wc * 32 + fr, fq * 8);
#define PG8_SA(b, h) (((b) * 2 + (h)) * HTB)
#define PG8_SB(b, h) ((4 + (b) * 2 + (h)) * HTB)
#define PG8_STAGE(bufoff, gbase, voff) do { _Pragma("unroll") for (int _i = 0; _i < 2; ++_i) \
        __builtin_amdgcn_global_load_lds((const unsigned*)((const char*)(gbase) + (voff)[_i]), (PG8_LAS unsigned*)(lds + (bufoff) + ldsw + _i * 8192), 16, 0, 0); } while (0)
#define PG8_LDA(dst, b, h) do { if constexpr (FP8) { _Pragma("unroll") for (int m = 0; m < 4; ++m) { const i32x4 lo_ = *(const PG8_LAS i32x4*)(lds + PG8_SA(b, h) + aoff + m * 2048), hi_ = *(const PG8_LAS i32x4*)(lds + PG8_SA(b, h) + aoff + m * 2048 + 1024); dst##8[m] = __builtin_shufflevector(lo_, hi_, 0, 1, 2, 3, 4, 5, 6, 7); } } \
    else { _Pragma("unroll") for (int m = 0; m < 4; ++m) _Pragma("unroll") for (int k = 0; k < 2; ++k) dst[m][k] = *(const PG8_LAS bf16x8*)(lds + PG8_SA(b, h) + aoff + m * 2048 + k * 1024); } } while (0)
#define PG8_LDB(dst, b, h) do { if constexpr (FP8) { _Pragma("unroll") for (int n = 0; n < 2; ++n) { const i32x4 lo_ = *(const PG8_LAS i32x4*)(lds + PG8_SB(b, h) + boff + n * 2048), hi_ = *(const PG8_LAS i32x4*)(lds + PG8_SB(b, h) + boff + n * 2048 + 1024); dst##8[n] = __builtin_shufflevector(lo_, hi_, 0, 1, 2, 3, 4, 5, 6, 7); } } \
    else { _Pragma("unroll") for (int n = 0; n < 2; ++n) _Pragma("unroll") for (int k = 0; k < 2; ++k) dst[n][k] = *(const PG8_LAS bf16x8*)(lds + PG8_SB(b, h) + boff + n * 2048 + k * 1024); } } while (0)
#define PG8_MMA(ai, bj, At, Bt) do { __builtin_amdgcn_s_setprio(1); \
        if constexpr (FP8) { asm volatile("s_nop 1\n\t" \
            "v_mfma_scale_f32_16x16x128_f8f6f4 %0, %12, %8, %0, %14, %14 op_sel_hi:[0,0,0]\n\t" \
            "v_mfma_scale_f32_16x16x128_f8f6f4 %1, %13, %8, %1, %14, %14 op_sel_hi:[0,0,0]\n\t" \
            "v_mfma_scale_f32_16x16x128_f8f6f4 %2, %12, %9, %2, %14, %14 op_sel_hi:[0,0,0]\n\t" \
            "v_mfma_scale_f32_16x16x128_f8f6f4 %3, %13, %9, %3, %14, %14 op_sel_hi:[0,0,0]\n\t" \
            "v_mfma_scale_f32_16x16x128_f8f6f4 %4, %12, %10, %4, %14, %14 op_sel_hi:[0,0,0]\n\t" \
            "v_mfma_scale_f32_16x16x128_f8f6f4 %5, %13, %10, %5, %14, %14 op_sel_hi:[0,0,0]\n\t" \
            "v_mfma_scale_f32_16x16x128_f8f6f4 %6, %12, %11, %6, %14, %14 op_sel_hi:[0,0,0]\n\t" \
            "v_mfma_scale_f32_16x16x128_f8f6f4 %7, %13, %11, %7, %14, %14 op_sel_hi:[0,0,0]\n\t" \
            : "+v"(acc[ai][bj][0][0]), "+v"(acc[ai][bj][0][1]), "+v"(acc[ai][bj][1][0]), "+v"(acc[ai][bj][1][1]), "+v"(acc[ai][bj][2][0]), "+v"(acc[ai][bj][2][1]), "+v"(acc[ai][bj][3][0]), "+v"(acc[ai][bj][3][1]) \
            : "v"(At##8[0]), "v"(At##8[1]), "v"(At##8[2]), "v"(At##8[3]), "v"(Bt##8[0]), "v"(Bt##8[1]), "v"(scl8)); } \
        else { _Pragma("unroll") for (int m = 0; m < 4; ++m) _Pragma("unroll") for (int n = 0; n < 2; ++n) _Pragma("unroll") for (int k = 0; k < 2; ++k) \
            acc[ai][bj][m][n] = __builtin_amdgcn_mfma_f32_16x16x32_bf16(Bt[n][k], At[m][k], acc[ai][bj][m][n], 0, 0, 0); } \
        __builtin_amdgcn_s_setprio(0); } while (0)
#define PG8_WAIT_V(n) asm volatile("s_waitcnt vmcnt(" #n ")" ::: "memory")
#define PG8_WAIT_L(n) asm volatile("s_waitcnt lgkmcnt(" #n ")" ::: "memory")
#define PG8_BAR __builtin_amdgcn_s_barrier()
#define PG8_SCHED __builtin_amdgcn_sched_barrier(0)
    Unit cur, nxt; int ui = 0;
    if (!S.next(0, cur)) return;
    f32x4 acc[2][2][4][2];
#pragma unroll
    for (int a = 0; a < 2; ++a)
#pragma unroll
        for (int b = 0; b < 2; ++b)
#pragma unroll
            for (int m = 0; m < 4; ++m)
#pragma unroll
                for (int n = 0; n < 2; ++n) { acc[a][b][m][n] = (f32x4){0.f, 0.f, 0.f, 0.f}; }
    const int scl8 = 0x7f7f7f7f;
    bf16x8 At[4][2], B0[2][2], B1[2][2]; i32x8 At8[4], B08[2], B18[2];
    const char* cA = (const char*)g.A + (size_t)cur.pm * tstep; const char* cB = (const char*)g.Bt + (size_t)cur.pn * tstep;
    S.a_ready(cur);
    if constexpr (SP2) {
        PG8_STAGE(PG8_SB(0, 0), cB, voffB); PG8_STAGE(PG8_SB(0, 1), cB + hstep, voffB); PG8_STAGE(PG8_SA(0, 0), cA, voffA); PG8_STAGE(PG8_SA(0, 1), cA + hstep, voffA);
        if (wr == 1) PG8_BAR;
        PG8_WAIT_V(2); PG8_BAR;
        PG8_STAGE(PG8_SB(1, 0), cB + kstep, voffB); PG8_STAGE(PG8_SA(1, 0), cA + kstep, voffA); PG8_STAGE(PG8_SB(1, 1), cB + hstep + kstep, voffB);
        PG8_WAIT_V(6); PG8_BAR;
    } else {
        PG8_STAGE(PG8_SB(0, 0), cB, voffB); PG8_STAGE(PG8_SA(0, 0), cA, voffA); PG8_STAGE(PG8_SB(0, 1), cB + hstep, voffB); PG8_STAGE(PG8_SA(0, 1), cA + hstep, voffA);
        if (wr == 1) PG8_BAR;
        PG8_WAIT_V(4); PG8_BAR;
        PG8_STAGE(PG8_SB(1, 0), cB + kstep, voffB); PG8_STAGE(PG8_SA(1, 0), cA + kstep, voffA); PG8_STAGE(PG8_SB(1, 1), cB + hstep + kstep, voffB);
        PG8_WAIT_V(6); PG8_BAR;
    }
    for (;;) {
        const bool has_next = S.next(ui + 1, nxt);
        const char* nA = has_next ? (const char*)g.A + (size_t)nxt.pm * tstep : cA; const char* nB = has_next ? (const char*)g.Bt + (size_t)nxt.pn * tstep : cB;
        for (int t = 0; t < nt; t += 2) {
            const bool last = (t == nt - 2);
            const char* a1 = cA + (size_t)(t + 1) * kstep;
            const char* a2 = last ? nA : cA + (size_t)(t + 2) * kstep; const char* b2 = last ? nB : cB + (size_t)(t + 2) * kstep;
            const char* a3 = a2 + kstep; const char* b3 = b2 + kstep;
            if (last && has_next) S.a_ready(nxt);
            if constexpr (SP2) {
            PG8_LDB(B0, 0, 0); PG8_LDB(B1, 0, 1); PG8_SCHED; PG8_LDA(At, 0, 0); PG8_STAGE(PG8_SA(1, 1), a1 + hstep, voffA);
            PG8_WAIT_V(8); PG8_WAIT_L(0); PG8_BAR; PG8_MMA(0, 0, At, B0); PG8_MMA(0, 1, At, B1); PG8_BAR; PG8_SCHED;
            PG8_LDA(At, 0, 1); PG8_STAGE(PG8_SB(0, 0), b2, voffB); PG8_STAGE(PG8_SB(0, 1), b2 + hstep, voffB); PG8_STAGE(PG8_SA(0, 0), a2, voffA);
            PG8_WAIT_V(8); PG8_WAIT_L(0); PG8_BAR; PG8_MMA(1, 0, At, B0); PG8_MMA(1, 1, At, B1); PG8_BAR; PG8_SCHED;
            PG8_LDB(B0, 1, 0); PG8_LDB(B1, 1, 1); PG8_SCHED; PG8_LDA(At, 1, 0); PG8_STAGE(PG8_SA(0, 1), a2 + hstep, voffA);
            PG8_WAIT_V(8); PG8_WAIT_L(0); PG8_BAR; PG8_MMA(0, 0, At, B0); PG8_MMA(0, 1, At, B1); PG8_BAR; PG8_SCHED;
            PG8_LDA(At, 1, 1); PG8_STAGE(PG8_SB(1, 0), b3, voffB); PG8_STAGE(PG8_SB(1, 1), b3 + hstep, voffB); PG8_STAGE(PG8_SA(1, 0), a3, voffA);
            PG8_WAIT_V(8); PG8_WAIT_L(0); PG8_BAR; PG8_MMA(1, 0, At, B0); PG8_MMA(1, 1, At, B1); PG8_BAR; PG8_SCHED;
            } else {
            PG8_LDB(B0, 0, 0); PG8_SCHED; PG8_LDA(At, 0, 0); PG8_STAGE(PG8_SA(1, 1), a1 + hstep, voffA);
            PG8_WAIT_L(8); PG8_BAR; PG8_WAIT_L(0); PG8_MMA(0, 0, At, B0); PG8_BAR; PG8_SCHED;
            PG8_LDB(B1, 0, 1); PG8_STAGE(PG8_SB(0, 0), b2, voffB);
            PG8_BAR; PG8_WAIT_L(0); PG8_MMA(0, 1, At, B1); PG8_BAR;
            PG8_LDA(At, 0, 1); PG8_STAGE(PG8_SA(0, 0), a2, voffA);
            PG8_BAR; PG8_WAIT_L(0); PG8_MMA(1, 0, At, B0); PG8_BAR; PG8_SCHED;
            PG8_STAGE(PG8_SB(0, 1), b2 + hstep, voffB);
            PG8_WAIT_V(6); PG8_BAR; PG8_MMA(1, 1, At, B1); PG8_BAR;
            PG8_LDB(B0, 1, 0); PG8_SCHED; PG8_LDA(At, 1, 0); PG8_STAGE(PG8_SA(0, 1), a2 + hstep, voffA);
            PG8_WAIT_L(8); PG8_BAR; PG8_WAIT_L(0); PG8_MMA(0, 0, At, B0); PG8_BAR; PG8_SCHED;
            PG8_LDB(B1, 1, 1); PG8_STAGE(PG8_SB(1, 0), b3, voffB);
            PG8_BAR; PG8_WAIT_L(0); PG8_MMA(0, 1, At, B1); PG8_BAR;
            PG8_LDA(At, 1, 1); PG8_STAGE(PG8_SA(1, 0), a3, voffA);
            PG8_BAR; PG8_WAIT_L(0); PG8_MMA(1, 0, At, B0); PG8_BAR; PG8_SCHED;
            PG8_STAGE(PG8_SB(1, 1), b3 + hstep, voffB);
            PG8_WAIT_V(6); PG8_BAR; PG8_MMA(1, 1, At, B1); PG8_BAR;
            }
        }
        if constexpr (FP8) asm volatile("s_nop 15\n\ts_nop 15" : "+v"(acc[1][0][0][0]), "+v"(acc[1][0][0][1]), "+v"(acc[1][0][1][0]), "+v"(acc[1][0][1][1]), "+v"(acc[1][0][2][0]), "+v"(acc[1][0][2][1]), "+v"(acc[1][0][3][0]), "+v"(acc[1][0][3][1]),
            "+v"(acc[1][1][0][0]), "+v"(acc[1][1][0][1]), "+v"(acc[1][1][1][0]), "+v"(acc[1][1][1][1]), "+v"(acc[1][1][2][0]), "+v"(acc[1][1][2][1]), "+v"(acc[1][1][3][0]), "+v"(acc[1][1][3][1]));
        if constexpr (ALIGN_EPI) { if (wr == 0) PG8_BAR; }
        if constexpr (!Epi::AFTER_DRAIN) { E(acc, cur, wr, wc, fr, fq); S.done(cur); }
        if (!has_next) break;
#pragma unroll
        for (int a = 0; a < 2; ++a)
#pragma unroll
            for (int b = 0; b < 2; ++b)
#pragma unroll
                for (int m = 0; m < 4; ++m)
#pragma unroll
                    for (int n = 0; n < 2; ++n) { acc[a][b][m][n] = (f32x4){0.f, 0.f, 0.f, 0.f}; }
        cur = nxt; cA = nA; cB = nB; ++ui;
        if constexpr (ALIGN_EPI) { if (wr == 1) PG8_BAR; }
    }
    PG8_WAIT_V(0);
    if constexpr (!ALIGN_EPI) { if (wr == 0) PG8_BAR; }
    PG8_BAR;
    if constexpr (Epi::AFTER_DRAIN) { E.fused(acc, cur, wr, wc, fr, fq, lds, wid, lane); S.done(cur); }
#undef PG8_SA
#undef PG8_SB
#undef PG8_STAGE
#undef PG8_LDA
#undef PG8_LDB
#undef PG8_MMA
#undef PG8_WAIT_V
#undef PG8_WAIT_L
#undef PG8_BAR
#undef PG8_SCHED
}
}
#ifndef MK_PER_PHASE
#define MK_PER_PHASE 0
#endif
#ifndef MK_DUP
#define MK_DUP (-1)
#endif
#ifndef MOBA_DMA
#define MOBA_DMA 1
#endif
#ifndef SPLIT_P2
#define SPLIT_P2 1
#endif
#ifndef P2_ITEMS
#define P2_ITEMS 43008
#endif
#ifndef DOWN_F8
#define DOWN_F8 1
#endif
#ifndef DENSE_F8
#define DENSE_F8 0
#endif
#ifndef MOE_F8
#define MOE_F8 1
#endif
constexpr float XA_SC = 8.f, WGU_SC = 64.f, ACT_SC = 8.f, WDN_SC = 128.f;
constexpr int NWAVES = 8;
constexpr int NPHASE = 17;

constexpr int DM = 1024, BATCH = 16, SEQ = 2048, NTOK = BATCH * SEQ;
constexpr int MH = 4, DQK = 128, DV = 256, CH = 64, NCH = SEQ / CH;
constexpr int WIN_LD = 3080;
constexpr int AH = 8, AKV = 2, HD = 128, NBLK = 8;
constexpr int DFF = 2816, NE = 8, DEXP = 3584;
constexpr int MAXPANEL = 264;
constexpr float EPS = 1e-6f;

constexpr size_t MiB = 1u << 20;
constexpr size_t WS_CTL = 0, CTL_ZERO_BYTES = 1 * MiB;
constexpr int CW_BAR = 4096;
constexpr size_t WS_KM = 256 * 1024;
constexpr size_t WS_ROPE = 1 * MiB;
constexpr size_t WS_GATES = 2 * MiB;
constexpr size_t WS_ME = 4 * MiB;
constexpr size_t WS_MW = 5 * MiB;
constexpr size_t WS_MR = 6 * MiB;
constexpr size_t WS_MP = 7 * MiB;
constexpr size_t WS_HIST = 8 * MiB;
constexpr size_t WS_PB = 8 * MiB + 64 * 1024;
constexpr size_t WS_PART = 9 * MiB;
constexpr size_t WS_RS = 12 * MiB, WS_MS = 13 * MiB;
constexpr size_t WS_WIN = 16 * MiB;
constexpr size_t WS_WOUT = 22 * MiB;
constexpr size_t WS_WGU = 24 * MiB;
constexpr size_t WS_WDN = 35 * MiB;
constexpr size_t WS_WQKV = 41 * MiB;
constexpr size_t WS_WO = 44 * MiB;
constexpr size_t WS_WMGU = 46 * MiB;
constexpr size_t WS_WMDN = 158 * MiB;
constexpr size_t WS_A = 224 * MiB;
constexpr size_t WS_B = 360 * MiB;
constexpr size_t WS_QKO = WS_B;
constexpr size_t WS_KVT = WS_B + 128 * MiB;
constexpr size_t WS_H = WS_B + 224 * MiB;
constexpr size_t WS_ACT = WS_B;
constexpr size_t WS_Q = WS_B;
constexpr size_t WS_K = WS_B + 64 * MiB;
constexpr size_t WS_VT = WS_B + 80 * MiB;
constexpr size_t WS_ATT = WS_B + 96 * MiB;
constexpr size_t WS_ACT2 = WS_B;
constexpr size_t WS_Y2 = WS_B + (size_t)MAXPANEL * 256 * DEXP * 2;
constexpr size_t WS_END = WS_Y2 + 4 * MiB;
static_assert(WS_WMDN + (size_t)NE * 1024 * DEXP * 2 <= WS_A && WS_A + (size_t)MAXPANEL * 256 * 1024 * 2 <= WS_B, "d_ws map");

constexpr int RING_OFF = 0, RING_BYTES = 131072;
constexpr int LDSCTL_OFF = 155648, MISC_OFF = LDSCTL_OFF + 320;
constexpr int LDS_BYTES = 156672;

#define GAS __attribute__((address_space(1)))
#define LAS __attribute__((address_space(3)))
typedef unsigned short bf16;
typedef unsigned v4u __attribute__((ext_vector_type(4)));
typedef unsigned v2u __attribute__((ext_vector_type(2)));
typedef float f32x4 __attribute__((ext_vector_type(4)));
typedef short bf16x8 __attribute__((ext_vector_type(8)));
typedef GAS unsigned gu32;
#define RLX_AGENT __ATOMIC_RELAXED, __HIP_MEMORY_SCOPE_AGENT
#define LDS_WAIT() asm volatile("s_waitcnt lgkmcnt(0)" ::: "memory")
#define VM_WAIT() asm volatile("s_waitcnt vmcnt(0)" ::: "memory")
#define MFMA16(a, b, c) __builtin_amdgcn_mfma_f32_16x16x32_bf16((a), (b), (c), 0, 0, 0)
__device__ __forceinline__ unsigned pk2(float lo, float hi) { return pg8::cvt_pk_bf16(lo, hi); }
__device__ __forceinline__ float bflo(unsigned w) { return __uint_as_float(w << 16); }
__device__ __forceinline__ float bfhi(unsigned w) { return __uint_as_float(w & 0xffff0000u); }
__device__ __forceinline__ float wave_sum(float v) {
#pragma unroll
    for (int o = 1; o < 64; o <<= 1) v += __shfl_xor(v, o);
    return v;
}

#define XB_TMO      128
#define XB_XCNT(j)  (256  + 64 * (j))
#define XB_XSUB(j)  (1280 + 64 * (j))
#define XB_XGEN(j)  (2304 + 64 * (j))
#define XB_TOP      3328
#define XB_TOPGEN   3392
#define XCD_BAR_WORDS 3456
#define XB_SPIN_CAP (1u << 18)

__device__ __forceinline__ unsigned xb_ld(unsigned* p)              { return __hip_atomic_load(p, __ATOMIC_RELAXED, __HIP_MEMORY_SCOPE_AGENT); }
__device__ __forceinline__ unsigned xb_add(unsigned* p, unsigned v) { return __hip_atomic_fetch_add(p, v, __ATOMIC_RELAXED, __HIP_MEMORY_SCOPE_AGENT); }
__device__ __forceinline__ unsigned xb_xcc_id() { return (unsigned)__builtin_amdgcn_s_getreg((3 << 11) | 20) & 0xFu; }
#define XB_SPIN(cond, bar) do { unsigned _sp = 0; while (cond) { __builtin_amdgcn_s_sleep(1); \
    if ((++_sp & 255u) == 0u) { if (xb_ld(&(bar)[XB_TMO])) break; if (_sp > XB_SPIN_CAP) { atomicAdd(&(bar)[XB_TMO], 1u); break; } } } } while (0)

struct XcdBarrier {
    unsigned* bar; unsigned x;
    volatile LAS unsigned* st;
};

__device__ __forceinline__ XcdBarrier xcd_barrier_post(unsigned* bar, volatile LAS unsigned* st) {
    XcdBarrier b; b.bar = bar; b.x = xb_xcc_id(); b.st = st;
    if (threadIdx.x == 0) (void)xb_add(&bar[XB_XCNT(b.x)], 1u);
    return b;
}
__device__ __forceinline__ void xcd_barrier_complete(unsigned* bar, unsigned x, unsigned& nloc, unsigned& nx) {
    const unsigned G = gridDim.x * gridDim.y * gridDim.z;
    unsigned sum, cnt, mine, sp = 0u;
    for (;;) {
        sum = 0u; cnt = 0u; mine = 0u;
#pragma unroll
        for (unsigned j = 0; j < 16; ++j) { const unsigned c = xb_ld(&bar[XB_XCNT(j)]); sum += c; cnt += (c > 0u) ? 1u : 0u; mine = (j == x) ? c : mine; }
        if (sum == G) break;
        __builtin_amdgcn_s_sleep(1);
        if ((++sp & 255u) == 0u) { if (xb_ld(&bar[XB_TMO])) break; if (sp > XB_SPIN_CAP) { atomicAdd(&bar[XB_TMO], 1u); break; } }
    }
    nloc = mine > 0u ? mine : 1u; nx = cnt > 0u ? cnt : 1u;
}

__device__ __forceinline__ void xcd_barrier(const XcdBarrier& b) {
    asm volatile("s_waitcnt vmcnt(0)" ::: "memory");
    __syncthreads();
    if (threadIdx.x == 0) {
        unsigned* bar = b.bar;
        __builtin_amdgcn_s_waitcnt(0);
        unsigned nloc = b.st[0], nx = b.st[1];
        if (nloc == 0u) { xcd_barrier_complete(bar, b.x, nloc, nx); b.st[0] = nloc; b.st[1] = nx; }
        const unsigned old = xb_add(&bar[XB_XSUB(b.x)], 1u);
        const unsigned gen = old / nloc;
        if (old + 1u == (gen + 1u) * nloc) {
            __builtin_amdgcn_fence(__ATOMIC_RELEASE, "agent");
            asm volatile("s_waitcnt vmcnt(0)" ::: "memory");
            const unsigned og = xb_add(&bar[XB_TOP], 1u);
            const unsigned tg = og / nx;
            if (og + 1u == (tg + 1u) * nx) xb_add(&bar[XB_TOPGEN], 1u);
            else XB_SPIN(xb_ld(&bar[XB_TOPGEN]) == tg, bar);
            __builtin_amdgcn_fence(__ATOMIC_ACQUIRE, "agent");
            xb_add(&bar[XB_XGEN(b.x)], 1u);
            asm volatile("s_waitcnt vmcnt(0)" ::: "memory");
        } else {
            XB_SPIN(xb_ld(&bar[XB_XGEN(b.x)]) == gen, bar);
            __builtin_amdgcn_fence(__ATOMIC_ACQUIRE, "agent");
            asm volatile("s_waitcnt vmcnt(0)" ::: "memory");
        }
    }
    __syncthreads();
}


struct TDesc { const float* src; bf16* dst; const float* gain; int ldw, col0, ncol32, kgrp, ngrp, dst_ld, dst_rpg, mode, F, row_off; float scale; int item0, nitem, f8, pad; };
constexpr int NDESC = 12;

__device__ __forceinline__ void tdesc_set(LAS TDesc* t, int& run, const float* src, bf16* dst, const float* gain, int ldw, int col0, int ncols, int kgrp, int ngrp, int dst_ld, int dst_rpg, int mode, int F, int row_off, float scale, int f8 = 0) {
    t->f8 = f8; t->pad = 0;
    t->src = src; t->dst = dst; t->gain = gain; t->ldw = ldw; t->col0 = col0; t->ncol32 = ncols / 32; t->kgrp = kgrp; t->ngrp = ngrp; t->dst_ld = dst_ld; t->dst_rpg = dst_rpg; t->mode = mode; t->F = F; t->row_off = row_off; t->scale = scale;
    t->item0 = run; t->nitem = (kgrp * ngrp / 64) * (ncols / 32); run += t->nitem;
}
__device__ __forceinline__ void titem_load(const LAS TDesc* t, int it, int lane, f32x4 (&v)[8]) {
    const int ncol32 = t->ncol32, kb = it / ncol32, nb = it - kb * ncol32;
    const float* src = t->src + (size_t)(kb * 64) * t->ldw + t->col0 + nb * 32;
    const int kr = lane >> 3, c4 = lane & 7;
#pragma unroll
    for (int i = 0; i < 8; ++i) v[i] = *(const f32x4*)(src + (size_t)(8 * i + kr) * t->ldw + 4 * c4);
}
__device__ __forceinline__ void titem_store(const LAS TDesc* t, int it, LAS float* scr, int lane, const f32x4 (&v)[8]) {
    const int ncol32 = t->ncol32, kb = it / ncol32, nb = it - kb * ncol32;
    const int k0g = kb * 64, grp = k0g / t->kgrp, k0 = k0g - grp * t->kgrp, nrel0 = nb * 32;
    const int kr = lane >> 3, c4 = lane & 7;
    const float* gp = t->gain; const float sc = t->scale;
#pragma unroll
    for (int i = 0; i < 8; ++i) { const int kk = 8 * i + kr; const float gsc = gp ? gp[k0 + kk] * sc : sc;
        LAS float* d = scr + kk * 33 + 4 * c4; d[0] = v[i][0] * gsc; d[1] = v[i][1] * gsc; d[2] = v[i][2] * gsc; d[3] = v[i][3] * gsc; }
    LDS_WAIT(); asm volatile("" ::: "memory");
    const int c = lane & 7;
#pragma unroll
    for (int j = 0; j < 4; ++j) { const int n = (lane >> 3) + 8 * j; const LAS float* s = scr + (8 * c) * 33 + n;
        const int nrel = nrel0 + n; int drow;
        if (t->mode == 0) drow = nrel;
        else { const int F = t->F, uu = nrel >= F ? 1 : 0, j2 = nrel - uu * F, jl = j2 & 127;
            drow = 256 * (j2 >> 7) + 128 * ((jl >> 2) & 1) + 32 * (jl >> 5) + 16 * uu + 4 * ((jl >> 3) & 3) + (jl & 3); }
        drow += grp * t->dst_rpg + t->row_off;
        if (t->f8) { v2u o; o.x = pg8::pk4_fp8(s[0 * 33], s[1 * 33], s[2 * 33], s[3 * 33]); o.y = pg8::pk4_fp8(s[4 * 33], s[5 * 33], s[6 * 33], s[7 * 33]); *(v2u*)((unsigned char*)t->dst + (size_t)drow * t->dst_ld + k0 + 8 * c) = o; }
        else { v4u o; o.x = pk2(s[0 * 33], s[1 * 33]); o.y = pk2(s[2 * 33], s[3 * 33]); o.z = pk2(s[4 * 33], s[5 * 33]); o.w = pk2(s[6 * 33], s[7 * 33]); *(v4u*)(t->dst + (size_t)drow * t->dst_ld + k0 + 8 * c) = o; } }
    LDS_WAIT(); asm volatile("" ::: "memory");
}
__device__ __forceinline__ void convert_items(const LAS TDesc* td, LAS float* scr, int lane, int first, int stride, int count, int thresh, int shift) {
    f32x4 va[8], vb[8]; int it = first, da = 0, db = 0, ia = 0, ib = 0;
#define TD_FIND(it_, d_) do { d_ = 0; _Pragma("unroll") for (int q = 1; q < NDESC; ++q) d_ += ((it_) >= td[q].item0) ? 1 : 0; } while (0)
#define TD_MAP(l_) ((l_) + ((l_) >= thresh ? shift : 0))
    if (it < count) { ia = TD_MAP(it); TD_FIND(ia, da); titem_load(td + da, ia - td[da].item0, lane, va); }
    while (it < count) {
        int nx = it + stride;
        if (nx < count) { ib = TD_MAP(nx); TD_FIND(ib, db); titem_load(td + db, ib - td[db].item0, lane, vb); }
        titem_store(td + da, ia - td[da].item0, scr, lane, va);
        it = nx; if (it >= count) break;
        nx = it + stride;
        if (nx < count) { ia = TD_MAP(nx); TD_FIND(ia, da); titem_load(td + da, ia - td[da].item0, lane, va); }
        titem_store(td + db, ib - td[db].item0, scr, lane, vb);
        it = nx;
    }
#undef TD_FIND
#undef TD_MAP
}
__device__ __forceinline__ void sincos_d(double x, double& s, double& c) {
    const double n = __builtin_rint(x * 0.63661977236758134308);
    double r = __builtin_fma(-n, 1.57079632679489655800e+00, x); r = __builtin_fma(-n, 6.12323399573676603587e-17, r);
    const double r2 = r * r;
    double sp = -1.0 / 1307674368000.0; sp = sp * r2 + 1.0 / 6227020800.0; sp = sp * r2 - 1.0 / 39916800.0; sp = sp * r2 + 1.0 / 362880.0; sp = sp * r2 - 1.0 / 5040.0; sp = sp * r2 + 1.0 / 120.0; sp = sp * r2 - 1.0 / 6.0; sp = sp * r2 + 1.0;
    const double sr = sp * r;
    double cp = 1.0 / 20922789888000.0; cp = cp * r2 - 1.0 / 87178291200.0; cp = cp * r2 + 1.0 / 479001600.0; cp = cp * r2 - 1.0 / 3628800.0; cp = cp * r2 + 1.0 / 40320.0; cp = cp * r2 - 1.0 / 720.0; cp = cp * r2 + 1.0 / 24.0; cp = cp * r2 - 0.5; cp = cp * r2 + 1.0;
    const int q = ((int)n) & 3;
    s = (q == 0) ? sr : (q == 1) ? cp : (q == 2) ? -sr : -cp;
    c = (q == 0) ? cp : (q == 1) ? -sr : (q == 2) ? -cp : sr;
}
__device__ __forceinline__ double inv_freq_d(int i) {
    switch (i) { case 0: return 1.0; case 1: return 0.44036660267178046; case 2: return 0.19392274474868576; case 3: return 0.085397100285765609; case 4: return 0.037606030930863933;
        case 5: return 0.016560440080994446; case 6: return 0.0072926647372171093; case 7: return 0.0032114459947525909; case 8: return 0.001414213562373095; case 9: return 0.00062277242191459599;
        case 10: return 0.0002742481756762073; case 11: return 0.00012076973741146504; case 12: return 5.3182958969449883e-05; case 13: return 2.3419998961409342e-05; case 14: return 1.031338537721246e-05; default: return 4.5416704806078695e-06; }
}
__device__ __forceinline__ void load_row(const float* row, int lane, f32x4 (&v)[4]) {
    const f32x4* xr = (const f32x4*)row + lane;
#pragma unroll
    for (int j = 0; j < 4; ++j) v[j] = xr[64 * j];
}
__device__ __forceinline__ float row_sumsq(const f32x4 (&v)[4]) {
    float s = 0.f;
#pragma unroll
    for (int j = 0; j < 4; ++j) s += (v[j][0] * v[j][0] + v[j][1] * v[j][1]) + (v[j][2] * v[j][2] + v[j][3] * v[j][3]);
    return wave_sum(s);
}
__device__ __forceinline__ void store_row_bf16(bf16* orow, int lane, const f32x4 (&v)[4], float sc) {
    v2u* o8 = (v2u*)orow + lane;
#pragma unroll
    for (int j = 0; j < 4; ++j) { v2u w; w.x = pk2(v[j][0] * sc, v[j][1] * sc); w.y = pk2(v[j][2] * sc, v[j][3] * sc); o8[64 * j] = w; }
}

__device__ __forceinline__ void store_row_fp8(unsigned char* orow, int lane, const f32x4 (&v)[4], float sc) {
    unsigned* o4 = (unsigned*)orow + lane;
#pragma unroll
    for (int j = 0; j < 4; ++j) o4[64 * j] = pg8::pk4_fp8(v[j][0] * sc, v[j][1] * sc, v[j][2] * sc, v[j][3] * sc);
}

constexpr int ML_QS = 0, ML_KS = 17408, ML_KWT = 34816, ML_VT = 53248;
constexpr int ML_TD = 150016;
template <int VS> __device__ __forceinline__ void mlstm_phase(LAS unsigned char* lds, const bf16* QKO, const bf16* KVT, const float* GATES, const float* b_if, bf16* Hout, int unit0, int ustride, int tid) {
    constexpr int NVS = 256 / VS, NJ = VS / 32, NJV = VS / 16, NVP = VS / 64;
    constexpr int ML_SBF = ML_VT + VS * 144, ML_NV = ML_SBF + VS * 272, ML_GD = ML_NV + 1024, ML_GP = ML_GD + NCH * 256, ML_GB = ML_GP + NCH * 256;
    static_assert(ML_GB + NCH * 256 <= ML_TD, "mLSTM LDS map");
    const int lane = tid & 63, w = __builtin_amdgcn_readfirstlane(tid >> 6), l15 = lane & 15, g = lane >> 4;
    const int tt = w & 3, vh = w >> 2;
    for (int unit = unit0; unit < 64 * NVS; unit += ustride) {
        const int bh = unit / NVS, vs = unit % NVS, b = bh >> 2, h = bh & 3;
        const size_t tok0 = (size_t)b * SEQ;
        const float bi = b_if[h], bfg = b_if[4 + h];
        f32x4 accS[NJV];
#pragma unroll
        for (int j = 0; j < NJV; ++j) accS[j] = (f32x4){0.f, 0.f, 0.f, 0.f};
        float m_s = 0.f;
        for (int i = tid; i < VS * 272 / 16; i += 512) *(LAS v4u*)(lds + ML_SBF + i * 16) = (v4u){0u, 0u, 0u, 0u};
        if (tid < 256) *(LAS float*)(lds + ML_NV + tid * 4) = 0.f;
#pragma unroll 1
        for (int cc = 0; cc < 4; ++cc) { const int c = 4 * w + cc; const size_t tq = (tok0 + (size_t)c * CH + lane) * 8;
            const float igv = GATES[tq + h] + bi, xf = GATES[tq + 4 + h] + bfg;
            float bc = fminf(xf, 0.f) - log1pf(__expf(-fabsf(xf)));
#pragma unroll
            for (int o = 1; o < 64; o <<= 1) { const float t = __shfl_up(bc, o); if (lane >= o) bc += t; }
            const float dd = igv - bc; float pm = dd;
#pragma unroll
            for (int o = 1; o < 64; o <<= 1) { const float t = __shfl_up(pm, o); if (lane >= o) pm = fmaxf(pm, t); }
            *(LAS float*)(lds + ML_GD + c * 256 + lane * 4) = dd; *(LAS float*)(lds + ML_GP + c * 256 + lane * 4) = pm; *(LAS float*)(lds + ML_GB + c * 256 + lane * 4) = bc; }
        __syncthreads();
        v4u rq[2], rk[2], rt[2], rv[NVP];
#define ML_LOADS(c_) do { const size_t t0_ = tok0 + (size_t)(c_) * CH; \
        _Pragma("unroll") for (int i_ = 0; i_ < 2; ++i_) { const int p_ = tid + 512 * i_; const int r_ = p_ >> 4, cp_ = p_ & 15; const bf16* s_ = QKO + (t0_ + r_) * 2048 + h * 128 + cp_ * 8; rq[i_] = *(const v4u*)s_; rk[i_] = *(const v4u*)(s_ + 1536); \
            const int kk_ = p_ >> 3, sg_ = p_ & 7; rt[i_] = *(const v4u*)(KVT + (size_t)(h * 128 + kk_) * NTOK + t0_ + 8 * sg_); } \
        _Pragma("unroll") for (int i_ = 0; i_ < NVP; ++i_) { const int p_ = tid + 512 * i_; rv[i_] = *(const v4u*)(KVT + (size_t)(512 + h * 256 + vs * VS + (p_ >> 3)) * NTOK + t0_ + 8 * (p_ & 7)); } \
        } while (0)
        ML_LOADS(0);
        for (int c = 0; c < NCH; ++c) {
            const size_t t0 = tok0 + (size_t)c * CH;
            const float dd = *(const LAS float*)(lds + ML_GD + c * 256 + lane * 4);
            const float g_tot = *(const LAS float*)(lds + ML_GB + c * 256 + 63 * 4), mm63 = fmaxf(m_s, *(const LAS float*)(lds + ML_GP + c * 256 + 63 * 4));
            const float wgt = __expf(dd - mm63), decay = __expf(m_s - mm63);
            {
                float wv[8];
#pragma unroll
                for (int e = 0; e < 8; ++e) wv[e] = __shfl(wgt, 8 * (tid & 7) + e);
#pragma unroll
                for (int i = 0; i < 2; ++i) { const int p = tid + 512 * i; const int r = p >> 4, cp = p & 15;
                    *(LAS v4u*)(lds + ML_QS + r * 272 + cp * 16) = rq[i]; *(LAS v4u*)(lds + ML_KS + r * 272 + cp * 16) = rk[i];
                    const int kk = p >> 3, sg = p & 7; v4u o;
                    o.x = pk2(bflo(rt[i].x) * wv[0], bfhi(rt[i].x) * wv[1]); o.y = pk2(bflo(rt[i].y) * wv[2], bfhi(rt[i].y) * wv[3]);
                    o.z = pk2(bflo(rt[i].z) * wv[4], bfhi(rt[i].z) * wv[5]); o.w = pk2(bflo(rt[i].w) * wv[6], bfhi(rt[i].w) * wv[7]);
                    *(LAS v4u*)(lds + ML_KWT + kk * 144 + sg * 16) = o; }
#pragma unroll
                for (int i = 0; i < NVP; ++i) { const int p = tid + 512 * i; *(LAS v4u*)(lds + ML_VT + (p >> 3) * 144 + (p & 7) * 16) = rv[i]; }
            }
            __syncthreads();
            if (c + 1 < NCH) ML_LOADS(c + 1);
            const int cur = c & 1;
            const int t_loc = 16 * tt + l15;
            bf16x8 qf[4];
#pragma unroll
            for (int kp = 0; kp < 4; ++kp) qf[kp] = *(const LAS bf16x8*)(lds + ML_QS + t_loc * 272 + (32 * kp + 8 * g) * 2);
            const float mmt = fmaxf(m_s, *(const LAS float*)(lds + ML_GP + c * 256 + t_loc * 4)), bct = *(const LAS float*)(lds + ML_GB + c * 256 + t_loc * 4);
            f32x4 P[4]; float psum = 0.f;
#pragma unroll
            for (int i = 0; i < 4; ++i) {
                P[i] = (f32x4){0.f, 0.f, 0.f, 0.f};
                if (i <= tt) {
                    f32x4 a = (f32x4){0.f, 0.f, 0.f, 0.f};
#pragma unroll
                    for (int kp = 0; kp < 4; ++kp) { const bf16x8 kf = *(const LAS bf16x8*)(lds + ML_KS + (16 * i + l15) * 272 + (32 * kp + 8 * g) * 2); a = MFMA16(kf, qf[kp], a); }
                    const f32x4 ddv = *(const LAS f32x4*)(lds + ML_GD + c * 256 + (16 * i + 4 * g) * 4);
#pragma unroll
                    for (int r = 0; r < 4; ++r) { const int s = 16 * i + 4 * g + r; const float pv = (s <= t_loc) ? a[r] * __expf(ddv[r] - mmt) : 0.f; P[i][r] = pv; psum += pv; }
                }
            }
            psum += __shfl_xor(psum, 16); psum += __shfl_xor(psum, 32);
            bf16x8 pf[2];
#pragma unroll
            for (int kp = 0; kp < 2; ++kp) { v4u o; o.x = pk2(P[2 * kp][0], P[2 * kp][1]); o.y = pk2(P[2 * kp][2], P[2 * kp][3]); o.z = pk2(P[2 * kp + 1][0], P[2 * kp + 1][1]); o.w = pk2(P[2 * kp + 1][2], P[2 * kp + 1][3]);
                pf[kp] = __builtin_bit_cast(bf16x8, o); }
            float nqp = 0.f;
#pragma unroll
            for (int kp = 0; kp < 4; ++kp) { const v4u qw = __builtin_bit_cast(v4u, qf[kp]); const LAS float* nv = (const LAS float*)(lds + ML_NV + cur * 512) + 32 * kp + 8 * g;
                const f32x4 n0 = *(const LAS f32x4*)nv, n1 = *(const LAS f32x4*)(nv + 4);
                nqp += bflo(qw.x) * n0[0] + bfhi(qw.x) * n0[1] + bflo(qw.y) * n0[2] + bfhi(qw.y) * n0[3] + bflo(qw.z) * n1[0] + bfhi(qw.z) * n1[1] + bflo(qw.w) * n1[2] + bfhi(qw.w) * n1[3]; }
            nqp += __shfl_xor(nqp, 16); nqp += __shfl_xor(nqp, 32);
            const float iw = __expf(m_s - mmt);
            const float nq = psum + iw * nqp;
            const float den = fmaxf(fabsf(nq), __expf(-(bct + mmt)));
            const float rden = 1.0f / den;
#pragma unroll
            for (int j = 0; j < NJ; ++j) {
                const int v_loc = (VS / 2) * vh + 16 * j + l15;
                f32x4 ao = (f32x4){0.f, 0.f, 0.f, 0.f}, ai = (f32x4){0.f, 0.f, 0.f, 0.f};
#pragma unroll
                for (int kp = 0; kp < 2; ++kp) if (2 * kp <= tt) {
                    const v2u lo = *(const LAS v2u*)(lds + ML_VT + v_loc * 144 + (32 * kp + 4 * g) * 2), hi = *(const LAS v2u*)(lds + ML_VT + v_loc * 144 + (32 * kp + 16 + 4 * g) * 2);
                    const v4u vv = (v4u){lo.x, lo.y, hi.x, hi.y};
                    ao = MFMA16(__builtin_bit_cast(bf16x8, vv), pf[kp], ao); }
#pragma unroll
                for (int kp = 0; kp < 4; ++kp) { const bf16x8 sf = *(const LAS bf16x8*)(lds + ML_SBF + v_loc * 272 + (32 * kp + 8 * g) * 2); ai = MFMA16(sf, qf[kp], ai); }
                v2u o; o.x = pk2((ao[0] + iw * ai[0]) * rden, (ao[1] + iw * ai[1]) * rden); o.y = pk2((ao[2] + iw * ai[2]) * rden, (ao[3] + iw * ai[3]) * rden);
                *(v2u*)(Hout + (t0 + t_loc) * 1024 + h * 256 + vs * VS + (VS / 2) * vh + 16 * j + 4 * g) = o;
            }
            {
                bf16x8 kf[2];
#pragma unroll
                for (int kp = 0; kp < 2; ++kp) kf[kp] = *(const LAS bf16x8*)(lds + ML_KWT + (16 * w + l15) * 144 + (32 * kp + 8 * g) * 2);
#pragma unroll
                for (int jv = 0; jv < NJV; ++jv) { accS[jv] = accS[jv] * decay;
#pragma unroll
                    for (int kp = 0; kp < 2; ++kp) { const bf16x8 vf = *(const LAS bf16x8*)(lds + ML_VT + (16 * jv + l15) * 144 + (32 * kp + 8 * g) * 2); accS[jv] = MFMA16(kf[kp], vf, accS[jv]); } }
            }
            if (tid < 128) { float s = 0.f;
#pragma unroll
                for (int i = 0; i < 8; ++i) { const v4u x = *(const LAS v4u*)(lds + ML_KWT + tid * 144 + i * 16); s += (bflo(x.x) + bfhi(x.x)) + (bflo(x.y) + bfhi(x.y)) + (bflo(x.z) + bfhi(x.z)) + (bflo(x.w) + bfhi(x.w)); }
                const float nold = *(const LAS float*)(lds + ML_NV + cur * 512 + tid * 4);
                *(LAS float*)(lds + ML_NV + (cur ^ 1) * 512 + tid * 4) = decay * nold + s; }
            __syncthreads();
#pragma unroll
            for (int jv = 0; jv < NJV; ++jv) { v2u o; o.x = pk2(accS[jv][0], accS[jv][1]); o.y = pk2(accS[jv][2], accS[jv][3]);
                *(LAS v2u*)(lds + ML_SBF + (16 * jv + l15) * 272 + (16 * w + 4 * g) * 2) = o; }
            m_s = g_tot + mm63;
        }
        __syncthreads();
#undef ML_LOADS
    }
}

constexpr int AT_K0 = 0, AT_V0 = 34816, AT_KM = 71680, AT_END = 75776;
__device__ __forceinline__ void moba_phase(LAS unsigned char* lds, const bf16* Qb, const bf16* Kb, const bf16* VT, const float* KM, bf16* ATT, int vcu, int G, int tid) {
    const int lane = tid & 63, w = __builtin_amdgcn_readfirstlane(tid >> 6), l15 = lane & 15, g = lane >> 4;
    constexpr float SC2 = 0.08838834764831845f * 1.4426950408889634f;
    const float NEG = -__builtin_inff();
    for (int item = vcu; item < 512; item += G) {
        const int bh = item >> 2, pr = item & 3, b = bh >> 3, h = bh & 7, kvh = h >> 2;
        for (int half = 0; half < 2; ++half) {
            const int qb = half ? pr : 7 - pr;
            const size_t row0 = (size_t)b * SEQ + 256 * qb + 32 * w;
            bf16x8 qf[2][4];
#pragma unroll
            for (int u = 0; u < 2; ++u)
#pragma unroll
                for (int kp = 0; kp < 4; ++kp) qf[u][kp] = *(const bf16x8*)(Qb + (row0 + 16 * u + l15) * 1024 + h * 128 + 32 * kp + 8 * g);
            for (int i = tid; i < 1024; i += 512) { const int n = i >> 7, d = i & 127; *(LAS float*)(lds + AT_KM + i * 4) = KM[(size_t)(b * 8 + n) * 256 + kvh * 128 + d] * (1.0f / 256.0f); }
            const int ntile = 4 * (qb + 1);
            v4u rk[2], rv[2];
#define AT_LOADS(j_) do { const int n_ = (j_) >> 2, kt_ = (j_) & 3; const size_t key0_ = (size_t)b * SEQ + 256 * n_ + 64 * kt_; \
            _Pragma("unroll") for (int i_ = 0; i_ < 2; ++i_) { const int p_ = tid + 512 * i_; rk[i_] = *(const v4u*)(Kb + (key0_ + (p_ >> 4)) * 256 + kvh * 128 + 8 * (p_ & 15)); \
                rv[i_] = *(const v4u*)(VT + (size_t)(kvh * 128 + (p_ >> 3)) * NTOK + key0_ + 8 * (p_ & 7)); } } while (0)
#define AT_STAGE(buf_) do { _Pragma("unroll") for (int i_ = 0; i_ < 2; ++i_) { const int p_ = tid + 512 * i_; \
                *(LAS v4u*)(lds + AT_K0 + (buf_) * 17408 + (p_ >> 4) * 272 + (p_ & 15) * 16) = rk[i_]; \
                const int sg_ = p_ & 7, vo_ = (p_ >> 3) * 144 + (sg_ >> 2) * 64 + (sg_ & 1) * 32 + ((sg_ >> 1) & 1) * 8;     \
                *(LAS v2u*)(lds + AT_V0 + (buf_) * 18432 + vo_) = (v2u){rv[i_].x, rv[i_].y}; *(LAS v2u*)(lds + AT_V0 + (buf_) * 18432 + vo_ + 16) = (v2u){rv[i_].z, rv[i_].w}; } } while (0)
            AT_LOADS(0);
            __syncthreads();
            AT_STAGE(0);
            __syncthreads();
            unsigned sel[2];
#pragma unroll
            for (int u = 0; u < 2; ++u) {
                float gate[7];
#pragma unroll
                for (int n = 0; n < 7; ++n) { gate[n] = NEG;
                    if (n < qb) { float s = 0.f;
#pragma unroll
                        for (int kp = 0; kp < 4; ++kp) { const v4u qw = __builtin_bit_cast(v4u, qf[u][kp]); const LAS float* kmp = (const LAS float*)(lds + AT_KM) + n * 128 + 32 * kp + 8 * g;
                            const f32x4 k0 = *(const LAS f32x4*)kmp, k1 = *(const LAS f32x4*)(kmp + 4);
                            s += bflo(qw.x) * k0[0] + bfhi(qw.x) * k0[1] + bflo(qw.y) * k0[2] + bfhi(qw.y) * k0[3] + bflo(qw.z) * k1[0] + bfhi(qw.z) * k1[1] + bflo(qw.w) * k1[2] + bfhi(qw.w) * k1[3]; }
                        s += __shfl_xor(s, 16); s += __shfl_xor(s, 32); gate[n] = s; } }
                unsigned sm = 0u;
                if (qb <= 3) sm = (1u << qb) - 1u;
                else {
#pragma unroll
                    for (int rnd = 0; rnd < 3; ++rnd) { float bv = NEG; int bi = 0;
#pragma unroll
                        for (int n = 0; n < 7; ++n) { const bool ok = (n < qb) && !((sm >> n) & 1u) && (gate[n] > bv); bv = ok ? gate[n] : bv; bi = ok ? n : bi; }
                        sm |= 1u << bi; }
                }
                sel[u] = sm;
            }
            f32x4 accO[2][8]; float m_run[2], l_run[2];
#pragma unroll
            for (int u = 0; u < 2; ++u) { m_run[u] = -1e30f; l_run[u] = 0.f;
#pragma unroll
                for (int jd = 0; jd < 8; ++jd) accO[u][jd] = (f32x4){0.f, 0.f, 0.f, 0.f}; }
            for (int j = 0; j < ntile; ++j) {
                if (j + 1 < ntile) AT_LOADS(j + 1);
                const int buf = j & 1, n = j >> 2, kt = j & 3; const bool own = (n == qb);
                const bool active = !own || (64 * kt <= 32 * w + 31);
                if (active) {
                    const LAS unsigned char* kb = lds + AT_K0 + buf * 17408; const LAS unsigned char* vb = lds + AT_V0 + buf * 18432;
                    f32x4 S[2][4];
#pragma unroll
                    for (int i = 0; i < 4; ++i) { bf16x8 kf[4];
#pragma unroll
                        for (int kp = 0; kp < 4; ++kp) kf[kp] = *(const LAS bf16x8*)(kb + (16 * i + l15) * 272 + (32 * kp + 8 * g) * 2);
#pragma unroll
                        for (int u = 0; u < 2; ++u) { f32x4 a = (f32x4){0.f, 0.f, 0.f, 0.f};
#pragma unroll
                            for (int kp = 0; kp < 4; ++kp) a = MFMA16(kf[kp], qf[u][kp], a);
                            S[u][i] = a; } }
                    bf16x8 pf[2][2];
#pragma unroll
                    for (int u = 0; u < 2; ++u) {
                        const bool allowed = own || ((sel[u] >> n) & 1u);
                        if (own && (64 * kt + 63 > 32 * w + 16 * u)) {
                            const int qpos = 32 * w + 16 * u + l15;
#pragma unroll
                            for (int i = 0; i < 4; ++i)
#pragma unroll
                                for (int r = 0; r < 4; ++r) { const int kpos = 64 * kt + 16 * i + 4 * g + r; S[u][i][r] = (kpos <= qpos) ? S[u][i][r] : NEG; }
                        }
                        float mx = fmaxf(fmaxf(S[u][0][0], S[u][0][1]), fmaxf(S[u][0][2], S[u][0][3]));
#pragma unroll
                        for (int i = 1; i < 4; ++i) mx = fmaxf(mx, fmaxf(fmaxf(S[u][i][0], S[u][i][1]), fmaxf(S[u][i][2], S[u][i][3])));
                        mx = fmaxf(mx, __shfl_xor(mx, 16)); mx = fmaxf(mx, __shfl_xor(mx, 32));
                        mx = allowed ? mx : NEG;
                        if (__any((mx - m_run[u]) * SC2 > 8.f)) {
                            const float mn = fmaxf(m_run[u], mx);
                            const float alpha = __builtin_amdgcn_exp2f((m_run[u] - mn) * SC2);
                            m_run[u] = mn; l_run[u] *= alpha;
#pragma unroll
                            for (int jd = 0; jd < 8; ++jd) accO[u][jd] = accO[u][jd] * alpha;
                        }
                        const float mb = allowed ? m_run[u] * SC2 : __builtin_inff(); float ps = 0.f;
#pragma unroll
                        for (int i = 0; i < 4; ++i)
#pragma unroll
                            for (int r = 0; r < 4; ++r) { const float p = __builtin_amdgcn_exp2f(S[u][i][r] * SC2 - mb); S[u][i][r] = p; ps += p; }
                        ps += __shfl_xor(ps, 16); ps += __shfl_xor(ps, 32);
                        l_run[u] += ps;
#pragma unroll
                        for (int kp = 0; kp < 2; ++kp) { v4u o; o.x = pk2(S[u][2 * kp][0], S[u][2 * kp][1]); o.y = pk2(S[u][2 * kp][2], S[u][2 * kp][3]); o.z = pk2(S[u][2 * kp + 1][0], S[u][2 * kp + 1][1]); o.w = pk2(S[u][2 * kp + 1][2], S[u][2 * kp + 1][3]);
                            pf[u][kp] = __builtin_bit_cast(bf16x8, o); }
                    }
#pragma unroll
                    for (int jd = 0; jd < 8; ++jd)
#pragma unroll
                        for (int kp = 0; kp < 2; ++kp) {
                            const bf16x8 vf = *(const LAS bf16x8*)(vb + (16 * jd + l15) * 144 + kp * 64 + g * 16);
                            accO[0][jd] = MFMA16(vf, pf[0][kp], accO[0][jd]); accO[1][jd] = MFMA16(vf, pf[1][kp], accO[1][jd]); }
                }
                if (j + 1 < ntile) AT_STAGE(buf ^ 1);
                __syncthreads();
            }
#pragma unroll
            for (int u = 0; u < 2; ++u) { const float rl = 1.0f / l_run[u]; bf16* orow = ATT + (row0 + 16 * u + l15) * 1024 + h * 128 + 4 * g;
#pragma unroll
                for (int jd = 0; jd < 8; ++jd) { v2u o; o.x = pk2(accO[u][jd][0] * rl, accO[u][jd][1] * rl); o.y = pk2(accO[u][jd][2] * rl, accO[u][jd][3] * rl); *(v2u*)(orow + 16 * jd) = o; } }
#undef AT_LOADS
#undef AT_STAGE
        }
    }
}

constexpr int AT3_K = 0, AT3_V = 49152, AT3_KM = 98304;
__device__ __forceinline__ void moba_phase_dma(LAS unsigned char* lds, const bf16* Qb, const bf16* Kb, const bf16* VT, const float* KM, bf16* ATT, int vcu, int G, int tid) {
    const int lane = tid & 63, w = __builtin_amdgcn_readfirstlane(tid >> 6), l15 = lane & 15, g = lane >> 4;
    constexpr float SC2 = 0.08838834764831845f * 1.4426950408889634f;
    const float NEG = -__builtin_inff();
    int kofs[2], vofs[2];
#pragma unroll
    for (int i = 0; i < 2; ++i) { const int p = (w * 2 + i) * 64 + lane; { const int r = p >> 4, c = (p & 15) ^ (r & 15); kofs[i] = r * 256 + c * 8; }
        { const int d = p >> 3, c = (p & 7) ^ ((d >> 1) & 7); vofs[i] = d * NTOK + c * 8; } }
    const int kl = 8 * (l15 >> 2) + (l15 & 3);
    const int vsw = (l15 >> 1) & 7;
    for (int item = vcu; item < 512; item += G) {
        const int bh = item >> 2, pr = item & 3, b = bh >> 3, h = bh & 7, kvh = h >> 2;
        for (int half = 0; half < 2; ++half) {
            const int qb = half ? pr : 7 - pr;
            const size_t row0 = (size_t)b * SEQ + 256 * qb + 32 * w;
            bf16x8 qf[2][4];
#pragma unroll
            for (int u = 0; u < 2; ++u)
#pragma unroll
                for (int kp = 0; kp < 4; ++kp) qf[u][kp] = *(const bf16x8*)(Qb + (row0 + 16 * u + l15) * 1024 + h * 128 + 32 * kp + 8 * g);
            for (int i = tid; i < 1024; i += 512) { const int n = i >> 7, d = i & 127; *(LAS float*)(lds + AT3_KM + i * 4) = KM[(size_t)(b * 8 + n) * 256 + kvh * 128 + d] * (1.0f / 256.0f); }
            const int ntile = 4 * (qb + 1);
#define AT_DMA(j_, slot_) do { const int n_ = (j_) >> 2, kt_ = (j_) & 3; const size_t key0_ = (size_t)b * SEQ + 256 * n_ + 64 * kt_; \
            _Pragma("unroll") for (int i_ = 0; i_ < 2; ++i_) { \
                __builtin_amdgcn_global_load_lds((const unsigned*)(Kb + key0_ * 256 + kvh * 128 + kofs[i_]), (LAS unsigned*)(lds + AT3_K + (slot_) * 16384 + (w * 2 + i_) * 1024), 16, 0, 0); \
                __builtin_amdgcn_global_load_lds((const unsigned*)(VT + (size_t)kvh * 128 * NTOK + key0_ + vofs[i_]), (LAS unsigned*)(lds + AT3_V + (slot_) * 16384 + (w * 2 + i_) * 1024), 16, 0, 0); } } while (0)
            asm volatile("s_waitcnt vmcnt(0) lgkmcnt(0)" ::: "memory"); __builtin_amdgcn_s_barrier(); asm volatile("" ::: "memory");
            AT_DMA(0, 0); AT_DMA(1, 1);
            asm volatile("s_waitcnt lgkmcnt(0)" ::: "memory"); __builtin_amdgcn_s_barrier(); asm volatile("" ::: "memory");
            unsigned sel[2];
#pragma unroll
            for (int u = 0; u < 2; ++u) {
                float gate[7];
#pragma unroll
                for (int n = 0; n < 7; ++n) { gate[n] = NEG;
                    if (n < qb) { float s = 0.f;
#pragma unroll
                        for (int kp = 0; kp < 4; ++kp) { const v4u qw = __builtin_bit_cast(v4u, qf[u][kp]); const LAS float* kmp = (const LAS float*)(lds + AT3_KM) + n * 128 + 32 * kp + 8 * g;
                            const f32x4 k0 = *(const LAS f32x4*)kmp, k1 = *(const LAS f32x4*)(kmp + 4);
                            s += bflo(qw.x) * k0[0] + bfhi(qw.x) * k0[1] + bflo(qw.y) * k0[2] + bfhi(qw.y) * k0[3] + bflo(qw.z) * k1[0] + bfhi(qw.z) * k1[1] + bflo(qw.w) * k1[2] + bfhi(qw.w) * k1[3]; }
                        s += __shfl_xor(s, 16); s += __shfl_xor(s, 32); gate[n] = s; } }
                unsigned sm = 0u;
                if (qb <= 3) sm = (1u << qb) - 1u;
                else {
#pragma unroll
                    for (int rnd = 0; rnd < 3; ++rnd) { float bv = NEG; int bi = 0;
#pragma unroll
                        for (int n = 0; n < 7; ++n) { const bool ok = (n < qb) && !((sm >> n) & 1u) && (gate[n] > bv); bv = ok ? gate[n] : bv; bi = ok ? n : bi; }
                        sm |= 1u << bi; }
                }
                sel[u] = sm;
            }
            f32x4 accO[2][8]; float m_run[2], l_run[2];
#pragma unroll
            for (int u = 0; u < 2; ++u) { m_run[u] = -1e30f; l_run[u] = 0.f;
#pragma unroll
                for (int jd = 0; jd < 8; ++jd) accO[u][jd] = (f32x4){0.f, 0.f, 0.f, 0.f}; }
            int slot = 0;
            for (int j = 0; j < ntile; ++j) {
                if (j + 1 < ntile) asm volatile("s_waitcnt vmcnt(4)" ::: "memory"); else asm volatile("s_waitcnt vmcnt(0)" ::: "memory");
                __builtin_amdgcn_s_barrier(); asm volatile("" ::: "memory");
                if (j + 2 < ntile) { const int s2 = slot == 0 ? 2 : slot - 1; AT_DMA(j + 2, s2); }
                const int n = j >> 2, kt = j & 3; const bool own = (n == qb);
                const bool active = !own || (64 * kt <= 32 * w + 31);
                if (active) {
                    const LAS unsigned char* kb = lds + AT3_K + slot * 16384; const LAS unsigned char* vb = lds + AT3_V + slot * 16384;
                    f32x4 S[2][4];
#pragma unroll
                    for (int i = 0; i < 4; ++i) { bf16x8 kf[4];
#pragma unroll
                        for (int kp = 0; kp < 4; ++kp) kf[kp] = *(const LAS bf16x8*)(kb + (kl + 32 * (i >> 1) + 4 * (i & 1)) * 256 + (((4 * kp + g) ^ ((kl & 15) | (4 * (i & 1)))) << 4));
#pragma unroll
                        for (int u = 0; u < 2; ++u) { f32x4 a = (f32x4){0.f, 0.f, 0.f, 0.f};
#pragma unroll
                            for (int kp = 0; kp < 4; ++kp) a = MFMA16(kf[kp], qf[u][kp], a);
                            S[u][i] = a; } }
                    bf16x8 pf[2][2];
#pragma unroll
                    for (int u = 0; u < 2; ++u) {
                        const bool allowed = own || ((sel[u] >> n) & 1u);
                        if (own && (64 * kt + 63 > 32 * w + 16 * u)) {
                            const int qpos = 32 * w + 16 * u + l15;
#pragma unroll
                            for (int i = 0; i < 4; ++i)
#pragma unroll
                                for (int r = 0; r < 4; ++r) { const int kpos = 64 * kt + 32 * (i >> 1) + 8 * g + 4 * (i & 1) + r; S[u][i][r] = (kpos <= qpos) ? S[u][i][r] : NEG; }
                        }
                        float mx = fmaxf(fmaxf(S[u][0][0], S[u][0][1]), fmaxf(S[u][0][2], S[u][0][3]));
#pragma unroll
                        for (int i = 1; i < 4; ++i) mx = fmaxf(mx, fmaxf(fmaxf(S[u][i][0], S[u][i][1]), fmaxf(S[u][i][2], S[u][i][3])));
                        mx = fmaxf(mx, __shfl_xor(mx, 16)); mx = fmaxf(mx, __shfl_xor(mx, 32));
                        mx = allowed ? mx : NEG;
                        if (__any((mx - m_run[u]) * SC2 > 8.f)) {
                            const float mn = fmaxf(m_run[u], mx);
                            const float alpha = __builtin_amdgcn_exp2f((m_run[u] - mn) * SC2);
                            m_run[u] = mn; l_run[u] *= alpha;
#pragma unroll
                            for (int jd = 0; jd < 8; ++jd) accO[u][jd] = accO[u][jd] * alpha;
                        }
                        const float mb = allowed ? m_run[u] * SC2 : __builtin_inff(); float ps = 0.f;
#pragma unroll
                        for (int i = 0; i < 4; ++i)
#pragma unroll
                            for (int r = 0; r < 4; ++r) { const float p = __builtin_amdgcn_exp2f(S[u][i][r] * SC2 - mb); S[u][i][r] = p; ps += p; }
                        ps += __shfl_xor(ps, 16); ps += __shfl_xor(ps, 32);
                        l_run[u] += ps;
#pragma unroll
                        for (int kp = 0; kp < 2; ++kp) { v4u o; o.x = pk2(S[u][2 * kp][0], S[u][2 * kp][1]); o.y = pk2(S[u][2 * kp][2], S[u][2 * kp][3]); o.z = pk2(S[u][2 * kp + 1][0], S[u][2 * kp + 1][1]); o.w = pk2(S[u][2 * kp + 1][2], S[u][2 * kp + 1][3]);
                            pf[u][kp] = __builtin_bit_cast(bf16x8, o); }
                    }
#pragma unroll
                    for (int jd = 0; jd < 8; ++jd)
#pragma unroll
                        for (int kp = 0; kp < 2; ++kp) {
                            const bf16x8 vf = *(const LAS bf16x8*)(vb + (16 * jd + l15) * 128 + (((4 * kp + g) ^ vsw) << 4));
                            accO[0][jd] = MFMA16(vf, pf[0][kp], accO[0][jd]); accO[1][jd] = MFMA16(vf, pf[1][kp], accO[1][jd]); }
                }
                slot = slot == 2 ? 0 : slot + 1;
            }
#pragma unroll
            for (int u = 0; u < 2; ++u) { const float rl = 1.0f / l_run[u]; bf16* orow = ATT + (row0 + 16 * u + l15) * 1024 + h * 128 + 4 * g;
#pragma unroll
                for (int jd = 0; jd < 8; ++jd) { v2u o; o.x = pk2(accO[u][jd][0] * rl, accO[u][jd][1] * rl); o.y = pk2(accO[u][jd][2] * rl, accO[u][jd][3] * rl); *(v2u*)(orow + 16 * jd) = o; } }
#undef AT_DMA
        }
    }
}

#define TD_SETUP(td) do { if (tid == 0) { int run = 0; \
            tdesc_set(td + 0, run, mlstm_w_in, Win_t, mlstm_norm, WIN_LD, 0, 512, 1024, 1, 1024, 0, 0, 0, 0, 0.08838834764831845f); \
            tdesc_set(td + 1, run, mlstm_w_in, Win_t, mlstm_norm, WIN_LD, 512, 512, 1024, 1, 1024, 0, 0, 0, 1536, 1.f); \
            tdesc_set(td + 2, run, mlstm_w_in, Win_t, mlstm_norm, WIN_LD, 1024, 1024, 1024, 1, 1024, 0, 0, 0, 2048, 1.f); \
            tdesc_set(td + 3, run, mlstm_w_in, Win_t, mlstm_norm, WIN_LD, 2048, 1024, 1024, 1, 1024, 0, 0, 0, 512, 1.f); \
            tdesc_set(td + 4, run, mlstm_w_out, Wout_t, nullptr, 1024, 0, 1024, 1024, 1, 1024, 0, 0, 0, 0, 1.f); \
            tdesc_set(td + 5, run, dense_w_gu, Wgu_t, ffn_norm, 5632, 0, 5632, 1024, 1, 1024, 0, 1, DFF, 0, DENSE_F8 ? WGU_SC : 1.f, DENSE_F8); \
            tdesc_set(td + 6, run, dense_w_down, Wdn_t, nullptr, 1024, 0, 1024, DFF, 1, DFF, 0, 0, 0, 0, DOWN_F8 ? WDN_SC : 1.f, DOWN_F8); \
            tdesc_set(td + 7, run, moba_w_q, Wqkv_t, moba_norm, 1024, 0, 1024, 1024, 1, 1024, 0, 0, 0, 0, 1.f); \
            tdesc_set(td + 8, run, kv_w, Wqkv_t, kv_norm, 512, 0, 512, 1024, 1, 1024, 0, 0, 0, 1024, 1.f); \
            tdesc_set(td + 9, run, moba_w_o, Wo_t, nullptr, 1024, 0, 1024, 1024, 1, 1024, 0, 0, 0, 0, 1.f); \
            tdesc_set(td + 10, run, moe_w_gu, Wmgu_t, ffn_norm + 1024, 7168, 0, 7168, 1024, 8, 1024, 7168, 1, DEXP, 0, MOE_F8 ? WGU_SC : 1.f, MOE_F8); \
            tdesc_set(td + 11, run, moe_w_down, Wmdn_t, nullptr, 1024, 0, 1024, DEXP, 8, DEXP, 1024, 0, 0, 0, MOE_F8 ? WDN_SC : 1.f, MOE_F8); \
        } } while (0)
struct Args { const float* in[18]; float* out; unsigned char* ws; int ph_lo, ph_hi, bar_region, pad; };
__global__ void __launch_bounds__(NWAVES * 64, 2) yoco_fwd(Args args) {
    extern __shared__ __attribute__((aligned(16))) unsigned char lds_raw[];
    LAS unsigned char* lds = (LAS unsigned char*)lds_raw;
    volatile LAS unsigned* MISC = (volatile LAS unsigned*)(lds + MISC_OFF);
    const int tid = threadIdx.x, lane = tid & 63, wave = __builtin_amdgcn_readfirstlane(tid >> 6);
    const int G = gridDim.x; const int bx = blockIdx.x; const int vcu = (G % 8 == 0) ? (bx % 8) * (G / 8) + bx / 8 : bx;
    const int gw = vcu * NWAVES + wave, NGW = G * NWAVES;
    unsigned char* ws = args.ws;
    gu32* ctl = (gu32*)(ws + WS_CTL);
    const float* x_in = args.in[0]; const float* mlstm_norm = args.in[1]; const float* mlstm_w_in = args.in[2]; const float* mlstm_b_if = args.in[3]; const float* mlstm_out_norm = args.in[4];
    const float* mlstm_w_out = args.in[5]; const float* ffn_norm = args.in[6]; const float* dense_w_gu = args.in[7]; const float* dense_w_down = args.in[8]; const float* moe_router = args.in[9];
    const float* moe_w_gu = args.in[10]; const float* moe_w_down = args.in[11]; const float* kv_norm = args.in[12]; const float* kv_w = args.in[13]; const float* moba_norm = args.in[14];
    const float* moba_w_q = args.in[15]; const float* moba_w_o = args.in[16]; const float* final_norm = args.in[17];
    float* X = args.out;
    bf16* Win_t = (bf16*)(ws + WS_WIN); bf16* Wout_t = (bf16*)(ws + WS_WOUT); bf16* Wgu_t = (bf16*)(ws + WS_WGU); bf16* Wdn_t = (bf16*)(ws + WS_WDN);
    bf16* Wqkv_t = (bf16*)(ws + WS_WQKV); bf16* Wo_t = (bf16*)(ws + WS_WO); bf16* Wmgu_t = (bf16*)(ws + WS_WMGU); bf16* Wmdn_t = (bf16*)(ws + WS_WMDN);
    bf16* XN = (bf16*)(ws + WS_A); bf16* XB = (bf16*)(ws + WS_A + 64 * MiB); float* PART = (float*)(ws + WS_PART); float* RS = (float*)(ws + WS_RS); float* MS = (float*)(ws + WS_MS); bf16* APERM = (bf16*)(ws + WS_A); bf16* Y = (bf16*)(ws + WS_A);
    bf16* QKO = (bf16*)(ws + WS_QKO); bf16* KVT = (bf16*)(ws + WS_KVT); bf16* Hb = (bf16*)(ws + WS_H); bf16* ACT = (bf16*)(ws + WS_ACT);
    bf16* Qb = (bf16*)(ws + WS_Q); bf16* Kb = (bf16*)(ws + WS_K); bf16* VTb = (bf16*)(ws + WS_VT); bf16* ATT = (bf16*)(ws + WS_ATT); bf16* ACT2 = (bf16*)(ws + WS_ACT2); bf16* Y2 = (bf16*)(ws + WS_Y2);
    float* KM = (float*)(ws + WS_KM); float* ROPE = (float*)(ws + WS_ROPE); float* GATES = (float*)(ws + WS_GATES);
    unsigned* ME = (unsigned*)(ws + WS_ME); float* MW = (float*)(ws + WS_MW); unsigned* MR = (unsigned*)(ws + WS_MR); unsigned* MP = (unsigned*)(ws + WS_MP);
    unsigned* HIST = (unsigned*)(ws + WS_HIST); unsigned* PB = (unsigned*)(ws + WS_PB);

    for (int u = tid; u < (LDS_BYTES - LDSCTL_OFF) / 4; u += NWAVES * 64) ((LAS unsigned*)(lds + LDSCTL_OFF))[u] = 0u;
    __syncthreads();
    unsigned* barw = (unsigned*)(ctl + CW_BAR) + args.bar_region * XCD_BAR_WORDS;
    XcdBarrier bar; bar.bar = barw; bar.x = 0; bar.st = nullptr;
    if (!MK_PER_PHASE) bar = xcd_barrier_post(barw, MISC + 8);
    const int lo = args.ph_lo, hi = args.ph_hi;
#define IN(k) (lo <= (k) && (k) < hi)
#define SEAM(k) do { if (IN(k) && IN((k) + 1)) { if (MK_PER_PHASE) { if (tid == 0) __hip_atomic_store(ctl, 0xBADBA0u, RLX_AGENT); } else xcd_barrier(bar); } } while (0)

    if (IN(0)) {
        LAS TDesc* td = (LAS TDesc*)(lds + 8 * 8448);
        TD_SETUP(td);
        __syncthreads();
        const bool split2 = SPLIT_P2 && G == 256 && IN(2);
        const int nitems = split2 ? td[4].item0 : td[NDESC - 1].item0 + td[NDESC - 1].nitem;
        LAS float* scr = (LAS float*)(lds + wave * 8448);
        convert_items(td, scr, lane, gw, NGW, nitems, 0, 0);
        for (int i = vcu * 512 + tid; i < 2048 * 16; i += G * 512) { const int pos = i >> 4, fi = i & 15; double s, c; sincos_d((double)pos * inv_freq_d(fi), s, c); ROPE[pos * 32 + fi] = (float)c; ROPE[pos * 32 + 16 + fi] = (float)s; }
        {
            float wg[4][4][8];
#pragma unroll
            for (int j = 0; j < 4; ++j)
#pragma unroll
                for (int e = 0; e < 4; ++e) { const int k = 4 * lane + 256 * j + e; const float gk = mlstm_norm[k]; const f32x4 a = *(const f32x4*)(mlstm_w_in + (size_t)k * WIN_LD + 3072), bq = *(const f32x4*)(mlstm_w_in + (size_t)k * WIN_LD + 3076);
#pragma unroll
                    for (int c = 0; c < 4; ++c) { wg[j][e][c] = a[c] * gk; wg[j][e][4 + c] = bq[c] * gk; } }
            for (int m = gw; m < NTOK; m += NGW) {
                f32x4 v[4]; load_row(x_in + (size_t)m * DM, lane, v);
                const float rinv = 1.0f / sqrtf(row_sumsq(v) * (1.0f / DM) + EPS);
                store_row_bf16(XN + (size_t)m * DM, lane, v, rinv);
                float gs[8];
#pragma unroll
                for (int c = 0; c < 8; ++c) { float s = 0.f;
#pragma unroll
                    for (int j = 0; j < 4; ++j)
#pragma unroll
                        for (int e = 0; e < 4; ++e) s += v[j][e] * wg[j][e][c];
                    gs[c] = wave_sum(s) * rinv; }
                float mine = gs[0];
#pragma unroll
                for (int c = 1; c < 8; ++c) mine = (lane == c) ? gs[c] : mine;
                if (lane < 8) GATES[(size_t)m * 8 + lane] = mine;
            }
        }
    }
    SEAM(0);
#ifdef PROBE_BARRIERS
    if (!MK_PER_PHASE && IN(0) && IN(1)) { for (int r = 0; r < PROBE_BARRIERS; ++r) xcd_barrier(bar); }
#endif

    if (IN(1)) {
        { pg8::Gemm gm{XN, Win_t, NTOK, 2048, DM}; pg8::StaticOrder S; S.init(NTOK, 2048, G, bx); pg8::EpiStore E{QKO, 2048};
          pg8::gemm_phase<pg8::EpiStore, pg8::StaticOrder, true, true>(lds + RING_OFF, gm, S, E); }
        __syncthreads();
        { pg8::Gemm gm{Win_t + (size_t)1536 * DM, XN, 1536, NTOK, DM}; pg8::StaticOrder S; S.init(1536, NTOK, G, bx); pg8::EpiStore E{KVT, NTOK};
          pg8::gemm_phase<pg8::EpiStore, pg8::StaticOrder, true, true>(lds + RING_OFF, gm, S, E); }
    }
    SEAM(1);

    if (IN(2)) { __syncthreads();
        if (SPLIT_P2 && G == 256 && IN(0)) {
            LAS TDesc* td = (LAS TDesc*)(lds + ML_TD); TD_SETUP(td);
            __syncthreads();
            if (vcu & 1) convert_items(td, (LAS float*)(lds + wave * 8448), lane, (vcu >> 1) * NWAVES + wave, (G >> 1) * NWAVES, td[NDESC - 1].item0 + td[NDESC - 1].nitem - td[4].item0, 0, td[4].item0);
            else { if (wave >= 4) __builtin_amdgcn_s_setprio(1);
                mlstm_phase<128>(lds, QKO, KVT, GATES, mlstm_b_if, Hb, vcu >> 1, G >> 1, tid); __builtin_amdgcn_s_setprio(0); }
        } else {
            if (wave >= 4) __builtin_amdgcn_s_setprio(1);
            mlstm_phase<64>(lds, QKO, KVT, GATES, mlstm_b_if, Hb, vcu, G, tid); __builtin_amdgcn_s_setprio(0); }
    }
    SEAM(2);

    if (IN(3)) {
        float og[16];
#pragma unroll
        for (int i = 0; i < 16; ++i) og[i] = mlstm_out_norm[16 * lane + i];
        for (int m0 = gw; m0 < NTOK; m0 += 2 * NGW) {
            const int mm[2] = {m0, (m0 + NGW < NTOK) ? m0 + NGW : m0};
            v4u hh[2][2], oo[2][2];
#pragma unroll
            for (int r = 0; r < 2; ++r) { const size_t m = (size_t)mm[r];
                hh[r][0] = *(const v4u*)(Hb + m * 1024 + 16 * lane); hh[r][1] = *(const v4u*)(Hb + m * 1024 + 16 * lane + 8);
                oo[r][0] = *(const v4u*)(QKO + m * 2048 + 512 + 16 * lane); oo[r][1] = *(const v4u*)(QKO + m * 2048 + 512 + 16 * lane + 8); }
#pragma unroll
            for (int r = 0; r < 2; ++r) { const size_t m = (size_t)mm[r];
                float hv[16], ov[16];
#pragma unroll
                for (int q = 0; q < 2; ++q) { const v4u hw = hh[r][q], ow = oo[r][q];
                    hv[8 * q + 0] = bflo(hw.x); hv[8 * q + 1] = bfhi(hw.x); hv[8 * q + 2] = bflo(hw.y); hv[8 * q + 3] = bfhi(hw.y); hv[8 * q + 4] = bflo(hw.z); hv[8 * q + 5] = bfhi(hw.z); hv[8 * q + 6] = bflo(hw.w); hv[8 * q + 7] = bfhi(hw.w);
                    ov[8 * q + 0] = bflo(ow.x); ov[8 * q + 1] = bfhi(ow.x); ov[8 * q + 2] = bflo(ow.y); ov[8 * q + 3] = bfhi(ow.y); ov[8 * q + 4] = bflo(ow.z); ov[8 * q + 5] = bfhi(ow.z); ov[8 * q + 6] = bflo(ow.w); ov[8 * q + 7] = bfhi(ow.w); }
                float s = 0.f;
#pragma unroll
                for (int i = 0; i < 16; ++i) s += hv[i] * hv[i];
                s += __shfl_xor(s, 1); s += __shfl_xor(s, 2); s += __shfl_xor(s, 4); s += __shfl_xor(s, 8);
                const float rinv = 1.0f / sqrtf(s * (1.0f / DV) + EPS);
                float rr[16];
#pragma unroll
                for (int i = 0; i < 16; ++i) rr[i] = hv[i] * rinv * og[i] * __builtin_amdgcn_rcpf(1.0f + __expf(-ov[i]));
                v4u w0, w1; w0.x = pk2(rr[0], rr[1]); w0.y = pk2(rr[2], rr[3]); w0.z = pk2(rr[4], rr[5]); w0.w = pk2(rr[6], rr[7]); w1.x = pk2(rr[8], rr[9]); w1.y = pk2(rr[10], rr[11]); w1.z = pk2(rr[12], rr[13]); w1.w = pk2(rr[14], rr[15]);
                *(v4u*)(XN + m * 1024 + 16 * lane) = w0; *(v4u*)(XN + m * 1024 + 16 * lane + 8) = w1; }
        }
    }
    SEAM(3);

    if (IN(4)) { pg8::Gemm gm{XN, Wout_t, NTOK, DM, DM}; pg8::StaticOrder S; S.init(NTOK, DM, G, bx); pg8::EpiRes<true> E{x_in, X, XB, PART};
        pg8::gemm_phase<pg8::EpiRes<true>, pg8::StaticOrder, true, true>(lds + RING_OFF, gm, S, E); }
    SEAM(4);

#define ROW_SCALES() do { for (int row = vcu * 512 + tid; row < NTOK; row += G * 512) { const f32x4* pp = (const f32x4*)(PART + (size_t)row * 16); const f32x4 p0 = pp[0], p1 = pp[1], p2 = pp[2], p3 = pp[3]; \
        const float s_ = (((p0[0] + p0[1]) + (p0[2] + p0[3])) + ((p1[0] + p1[1]) + (p1[2] + p1[3]))) + (((p2[0] + p2[1]) + (p2[2] + p2[3])) + ((p3[0] + p3[1]) + (p3[2] + p3[3]))); \
        const float ms_ = s_ * (1.0f / DM) + EPS; MS[row] = ms_; RS[row] = 1.0f / sqrtf(ms_); } } while (0)
    if (IN(5)) { ROW_SCALES(); }
    SEAM(5);

    if (IN(6)) { pg8::Gemm gm{XB, Wgu_t, NTOK, 2 * DFF, DM}; pg8::StaticOrder S; S.init(NTOK, 2 * DFF, G, bx); pg8::EpiSwiglu<DOWN_F8 != 0, true> E{ACT, DFF, 1.f, DOWN_F8 ? ACT_SC : 1.f, RS, MS};
        pg8::gemm_phase<pg8::EpiSwiglu<DOWN_F8 != 0, true>, pg8::StaticOrder, true, true>(lds + RING_OFF, gm, S, E); }
    SEAM(6);

    if (IN(7)) { pg8::Gemm gm{ACT, Wdn_t, NTOK, DM, DOWN_F8 ? DFF / 2 : DFF}; pg8::StaticOrder S; S.init(NTOK, DM, G, bx); pg8::EpiRes<true, DOWN_F8 ? 10 : 0> E{X, X, XB, PART};
        static_assert(ACT_SC * WDN_SC == 1024.f, "P7 epilogue shift");
        pg8::gemm_phase<pg8::EpiRes<true, DOWN_F8 ? 10 : 0>, pg8::StaticOrder, true, true, DOWN_F8 != 0>(lds + RING_OFF, gm, S, E); }
    SEAM(7);

    if (IN(8)) { ROW_SCALES(); }
    SEAM(8);

    if (IN(9)) {
        constexpr long TSTEP = 256L * DM * 2;
        constexpr long WS_XB = (long)WS_A + 64L * 1048576L;
        static_assert(((long)WS_WQKV + 1280L * DM * 2 - WS_XB) % TSTEP == 0 && (WS_XB - (long)WS_WQKV) % TSTEP == 0, "swapped-unit tile offsets");
        pg8::QkvOrder S; S.so.init(NTOK, 1280, G, bx); S.G = G; S.c = bx; S.nnorm = (NTOK / 256) * 5; S.nsw = NTOK / 256;
        S.swA = (int)(((long)WS_WQKV + 1280L * DM * 2 - WS_XB) / TSTEP); S.swB = (int)((WS_XB - (long)WS_WQKV) / TSTEP);
        pg8::Gemm gm{XB, Wqkv_t, NTOK, 1280, DM}; pg8::EpiRope E{Qb, Kb, KM, ROPE, VTb, NTOK, S.swB, RS};
        pg8::gemm_phase<pg8::EpiRope, pg8::QkvOrder, true, true>(lds + RING_OFF, gm, S, E);
    }
    SEAM(9);

    if (IN(10)) { __syncthreads(); if (wave >= 4) __builtin_amdgcn_s_setprio(1);
        if (MOBA_DMA) moba_phase_dma(lds, Qb, Kb, VTb, KM, ATT, vcu, G, tid); else moba_phase(lds, Qb, Kb, VTb, KM, ATT, vcu, G, tid);
        __builtin_amdgcn_s_setprio(0); }
    SEAM(10);

    if (IN(11)) { pg8::Gemm gm{ATT, Wo_t, NTOK, DM, DM}; pg8::StaticOrder S; S.init(NTOK, DM, G, bx); pg8::EpiRes<false> E{X, X, nullptr, nullptr};
        pg8::gemm_phase<pg8::EpiRes<false>, pg8::StaticOrder, true, true>(lds + RING_OFF, gm, S, E); }
    SEAM(11);

    constexpr int ROWC_OFF = 16384;
    const bool rowcache = MOE_F8 && G == 256 && IN(12) && IN(13);
    if (IN(12)) {
        __syncthreads();
        float wr8[4][4][8];
#pragma unroll
        for (int j = 0; j < 4; ++j)
#pragma unroll
            for (int e = 0; e < 4; ++e) { const int k = 4 * lane + 256 * j + e; const float gk = ffn_norm[1024 + k]; const f32x4 a = *(const f32x4*)(moe_router + (size_t)k * 8), bq = *(const f32x4*)(moe_router + (size_t)k * 8 + 4);
#pragma unroll
                for (int c = 0; c < 4; ++c) { wr8[j][e][c] = a[c] * gk; wr8[j][e][4 + c] = bq[c] * gk; } }
        LAS unsigned* le = (LAS unsigned*)lds;
        for (int chunk = vcu; chunk < 256; chunk += G) {
            for (int i = 0; i < 16; ++i) { const int tl = 16 * wave + i; const size_t m = (size_t)chunk * 128 + tl;
                f32x4 v[4]; load_row(X + m * DM, lane, v);
                const float rinv = 1.0f / sqrtf(row_sumsq(v) * (1.0f / DM) + EPS);
                float lg[8];
#pragma unroll
                for (int c = 0; c < 8; ++c) { float s = 0.f;
#pragma unroll
                    for (int j = 0; j < 4; ++j)
#pragma unroll
                        for (int e = 0; e < 4; ++e) s += v[j][e] * wr8[j][e][c];
                    lg[c] = wave_sum(s) * rinv; }
                int e1 = 0; float l1 = lg[0];
#pragma unroll
                for (int c = 1; c < 8; ++c) { const bool gt = lg[c] > l1; l1 = gt ? lg[c] : l1; e1 = gt ? c : e1; }
                int e2 = -1; float l2 = -__builtin_inff();
#pragma unroll
                for (int c = 0; c < 8; ++c) { const bool gt = (c != e1) && (lg[c] > l2); l2 = gt ? lg[c] : l2; e2 = gt ? c : e2; }
                const float w2 = 1.0f / (1.0f + __expf(l1 - l2)), w1 = 1.0f - w2;
                if (rowcache) { LAS unsigned* rc = (LAS unsigned*)(lds + ROWC_OFF + tl * 1024) + lane; const float qs = rinv * XA_SC;
#pragma unroll
                    for (int j = 0; j < 4; ++j) rc[64 * j] = pg8::pk4_fp8(v[j][0] * qs, v[j][1] * qs, v[j][2] * qs, v[j][3] * qs); }
                if (lane == 0) { le[tl] = (unsigned)e1 | ((unsigned)e2 << 8); ME[m] = (unsigned)e1 | ((unsigned)e2 << 8); MW[2 * m] = w1; MW[2 * m + 1] = w2; }
            }
            __syncthreads();
            if (tid < 128) { const unsigned mine = le[tid]; const unsigned a1 = mine & 255u, a2 = mine >> 8; unsigned r1 = 0, r2 = 0;
                for (int j = 0; j < tid; ++j) { const unsigned o = le[j]; const unsigned b1 = o & 255u, b2 = o >> 8; r1 += (b1 == a1) + (b2 == a1); r2 += (b1 == a2) + (b2 == a2); }
                MR[(size_t)chunk * 128 + tid] = r1 | (r2 << 16); }
            else if (tid < 136) { const unsigned ex = tid - 128; unsigned cnt = 0;
                for (int j = 0; j < 128; ++j) { const unsigned o = le[j]; cnt += ((o & 255u) == ex) + ((o >> 8) == ex); }
                HIST[chunk * 8 + ex] = cnt; }
            __syncthreads();
        }
    }
    SEAM(12);

    if (IN(13)) {
        __syncthreads();
        LAS unsigned* lh = (LAS unsigned*)lds;
        LAS unsigned* pre4 = (LAS unsigned*)(lds + 8192);
        LAS unsigned* cnt = (LAS unsigned*)(lds + 8192 + 2048);
        LAS unsigned* cpre = (LAS unsigned*)(lds + 8192 + 2048 + 64);
        for (int i = tid; i < 2048; i += 512) lh[i] = HIST[i];
        __syncthreads();
        { const int ex = wave; unsigned s4 = lh[(4 * lane) * 8 + ex] + lh[(4 * lane + 1) * 8 + ex] + lh[(4 * lane + 2) * 8 + ex] + lh[(4 * lane + 3) * 8 + ex]; unsigned inc = s4;
#pragma unroll
          for (int o = 1; o < 64; o <<= 1) { const unsigned t = __shfl_up(inc, o); if (lane >= o) inc += t; }
          pre4[ex * 64 + lane] = inc - s4; if (lane == 63) cnt[ex] = inc; }
        __syncthreads();
        unsigned mybase = 0u; { unsigned run = 0;
#pragma unroll
            for (int e = 0; e < 8; ++e) { if (e == tid) mybase = run; run += (cnt[e] + 255u) & ~255u; }
            if (vcu == 0 && tid < 8) PB[tid] = mybase >> 8;
            if (vcu == 0 && tid == 0) PB[8] = run >> 8; }
        for (int chunk = vcu; chunk < 256; chunk += G) {
            if (tid < 8) { unsigned p = pre4[tid * 64 + (chunk >> 2)]; for (int c2 = chunk & ~3; c2 < chunk; ++c2) p += lh[c2 * 8 + tid]; cpre[tid] = p + mybase; }
            __syncthreads();
            for (int i = 0; i < 16; ++i) { const size_t m = (size_t)chunk * 128 + 16 * wave + i;
                const unsigned me = ME[m], mr = MR[m]; const unsigned e1 = me & 255u, e2 = me >> 8;
                const unsigned s1 = cpre[e1] + (mr & 0xffffu), s2 = cpre[e2] + (mr >> 16);
                if (rowcache) { const LAS unsigned* rc = (const LAS unsigned*)(lds + ROWC_OFF + (16 * wave + i) * 1024) + lane;
                    unsigned* o1 = (unsigned*)((unsigned char*)APERM + (size_t)s1 * DM) + lane; unsigned* o2 = (unsigned*)((unsigned char*)APERM + (size_t)s2 * DM) + lane;
#pragma unroll
                    for (int j = 0; j < 4; ++j) { const unsigned w = rc[64 * j]; o1[64 * j] = w; o2[64 * j] = w; } }
                else {
                f32x4 v[4]; load_row(X + m * DM, lane, v);
                const float rinv = 1.0f / sqrtf(row_sumsq(v) * (1.0f / DM) + EPS);
                if (MOE_F8) { store_row_fp8((unsigned char*)APERM + (size_t)s1 * DM, lane, v, rinv * XA_SC); store_row_fp8((unsigned char*)APERM + (size_t)s2 * DM, lane, v, rinv * XA_SC); }
                else { store_row_bf16(APERM + (size_t)s1 * DM, lane, v, rinv); store_row_bf16(APERM + (size_t)s2 * DM, lane, v, rinv); } }
                if (lane == 0) { MP[2 * m] = s1; MP[2 * m + 1] = s2; } }
            __syncthreads();
        }
    }
    SEAM(13);

    if (IN(14)) { const int npan = (int)PB[8];
        pg8::MoeOrder S; S.so.init(npan * 256, 2 * DEXP, G, bx); S.nct = 2 * DEXP / 256; S.pb1 = PB[1]; S.pb2 = PB[2]; S.pb3 = PB[3]; S.pb4 = PB[4]; S.pb5 = PB[5]; S.pb6 = PB[6]; S.pb7 = PB[7];
        pg8::Gemm gm{APERM, Wmgu_t, npan * 256, 2 * DEXP, MOE_F8 ? DM / 2 : DM};
#ifdef PROBE_NULL_EPI
        if (args.pad) { pg8::EpiNull E{(float*)(ws + WS_PART)}; pg8::gemm_phase<pg8::EpiNull, pg8::MoeOrder, true, true, MOE_F8 != 0>(lds + RING_OFF, gm, S, E); } else
#endif
        { pg8::EpiSwiglu<MOE_F8 != 0> E{ACT2, DEXP, MOE_F8 ? 1.f / (XA_SC * WGU_SC) : 1.f, MOE_F8 ? ACT_SC : 1.f, nullptr, nullptr};
        pg8::gemm_phase<pg8::EpiSwiglu<MOE_F8 != 0>, pg8::MoeOrder, true, true, MOE_F8 != 0>(lds + RING_OFF, gm, S, E); } }
    SEAM(14);

    if (IN(15)) { const int npan = (int)PB[8]; const int nmain = npan < 256 ? npan : 256; constexpr int KU = MOE_F8 ? DEXP / 2 : DEXP;
        { pg8::MoeOrder S; S.so.init(nmain * 256, DM, G, bx); S.nct = DM / 256; S.pb1 = PB[1]; S.pb2 = PB[2]; S.pb3 = PB[3]; S.pb4 = PB[4]; S.pb5 = PB[5]; S.pb6 = PB[6]; S.pb7 = PB[7];
          pg8::Gemm gm{ACT2, Wmdn_t, nmain * 256, DM, KU}; pg8::EpiStore E{Y, DM};
          pg8::gemm_phase<pg8::EpiStore, pg8::MoeOrder, true, true, MOE_F8 != 0>(lds + RING_OFF, gm, S, E); }
        if (npan > nmain) {
            __syncthreads();
            pg8::TailOrder T; T.c = bx; T.ntail = (npan - nmain) * 4; T.pm0 = nmain; T.nct = DM / 256; T.pb1 = PB[1]; T.pb2 = PB[2]; T.pb3 = PB[3]; T.pb4 = PB[4]; T.pb5 = PB[5]; T.pb6 = PB[6]; T.pb7 = PB[7];
            const int half = bx & 1; const size_t koff = half ? (size_t)(KU / 2) : 0;
            pg8::Gemm gt{ACT2 + koff, Wmdn_t + koff, npan * 256, DM, KU, KU / 2};
            pg8::EpiStore E2{half ? Y2 - (size_t)nmain * 256 * DM : Y, DM};
            pg8::gemm_phase<pg8::EpiStore, pg8::TailOrder, true, true, MOE_F8 != 0>(lds + RING_OFF, gt, T, E2);
        }
    }
    SEAM(15);

    if (IN(16)) {
        f32x4 fg[4]; load_row(final_norm, lane, fg);
        const bool bad = (__hip_atomic_load(ctl, RLX_AGENT) != 0u) || (__hip_atomic_load((gu32*)(barw + XB_TMO), RLX_AGENT) != 0u);
        const float ysc = MOE_F8 ? 1.f / (ACT_SC * WDN_SC) : 1.f;
        for (int m0 = gw; m0 < NTOK; m0 += 2 * NGW) {
            const int mm[2] = {m0, (m0 + NGW < NTOK) ? m0 + NGW : m0};
            f32x4 v[2][4]; v2u ya[2][4], yb[2][4]; float w1[2], w2[2]; unsigned s1v[2], s2v[2];
#pragma unroll
            for (int r = 0; r < 2; ++r) { const size_t m = (size_t)mm[r]; load_row(X + m * DM, lane, v[r]);
                const unsigned s1 = MP[2 * m], s2 = MP[2 * m + 1]; s1v[r] = s1; s2v[r] = s2; w1[r] = MW[2 * m] * ysc; w2[r] = MW[2 * m + 1] * ysc;
                const v2u* y1 = (const v2u*)(Y + (size_t)s1 * DM) + lane; const v2u* y2 = (const v2u*)(Y + (size_t)s2 * DM) + lane;
#pragma unroll
                for (int j = 0; j < 4; ++j) { ya[r][j] = y1[64 * j]; yb[r][j] = y2[64 * j]; } }
#pragma unroll
            for (int r = 0; r < 2; ++r) {
#pragma unroll
                for (int j = 0; j < 4; ++j) { const v2u a = ya[r][j], bq = yb[r][j];
                    v[r][j][0] += w1[r] * bflo(a.x) + w2[r] * bflo(bq.x); v[r][j][1] += w1[r] * bfhi(a.x) + w2[r] * bfhi(bq.x); v[r][j][2] += w1[r] * bflo(a.y) + w2[r] * bflo(bq.y); v[r][j][3] += w1[r] * bfhi(a.y) + w2[r] * bfhi(bq.y); }
                if (s1v[r] >= 65536u) { const v2u* t = (const v2u*)(Y2 + (size_t)(s1v[r] - 65536u) * DM) + lane;
#pragma unroll
                    for (int j = 0; j < 4; ++j) { const v2u a = t[64 * j]; v[r][j][0] += w1[r] * bflo(a.x); v[r][j][1] += w1[r] * bfhi(a.x); v[r][j][2] += w1[r] * bflo(a.y); v[r][j][3] += w1[r] * bfhi(a.y); } }
                if (s2v[r] >= 65536u) { const v2u* t = (const v2u*)(Y2 + (size_t)(s2v[r] - 65536u) * DM) + lane;
#pragma unroll
                    for (int j = 0; j < 4; ++j) { const v2u a = t[64 * j]; v[r][j][0] += w2[r] * bflo(a.x); v[r][j][1] += w2[r] * bfhi(a.x); v[r][j][2] += w2[r] * bflo(a.y); v[r][j][3] += w2[r] * bfhi(a.y); } }
                const float rinv = 1.0f / sqrtf(row_sumsq(v[r]) * (1.0f / DM) + EPS);
                f32x4* o = (f32x4*)(X + (size_t)mm[r] * DM) + lane;
#pragma unroll
                for (int j = 0; j < 4; ++j) { f32x4 rr = v[r][j] * rinv * fg[j]; if (bad) rr = (f32x4){__builtin_nanf(""), __builtin_nanf(""), __builtin_nanf(""), __builtin_nanf("")}; o[64 * j] = rr; } }
        }
    }
#undef IN
#undef SEAM
}

extern "C" void kernel_launch(void* const* d_in, const int* in_sizes, int n_in, void* d_out, int out_size, void* d_ws, size_t ws_size, hipStream_t stream) {
    static int grid = 0;
    if (grid == 0) {
        if (n_in != 18 || in_sizes[0] != NTOK * DM || out_size != NTOK * DM || ws_size < WS_END) { fprintf(stderr, "kernel_launch: unexpected shapes / workspace (n_in %d, in0 %d, out %d, ws %zu, need %zu)\n", n_in, n_in > 0 ? in_sizes[0] : -1, out_size, ws_size, (size_t)WS_END); grid = -1; return; }
        int dev = 0, cus = 0, per_cu = 0;
        if (hipGetDevice(&dev) != hipSuccess || hipDeviceGetAttribute(&cus, hipDeviceAttributeMultiprocessorCount, dev) != hipSuccess) { grid = -1; return; }
        if (hipFuncSetAttribute((const void*)yoco_fwd, hipFuncAttributeMaxDynamicSharedMemorySize, LDS_BYTES) != hipSuccess) { fprintf(stderr, "kernel_launch: hipFuncSetAttribute failed\n"); grid = -1; return; }
        if (hipOccupancyMaxActiveBlocksPerMultiprocessor(&per_cu, (const void*)yoco_fwd, NWAVES * 64, LDS_BYTES) != hipSuccess || per_cu < 1) fprintf(stderr, "kernel_launch: occupancy query reports %d workgroups per CU\n", per_cu);
        (void)hipGetLastError();
        grid = cus < 256 ? cus : 256;
    }
    if (grid < 0) return;
    if (hipMemsetAsync((char*)d_ws + WS_CTL, 0, CTL_ZERO_BYTES, stream) != hipSuccess) return;
    Args a{};
    for (int i = 0; i < 18; ++i) a.in[i] = (const float*)d_in[i];
    a.out = (float*)d_out; a.ws = (unsigned char*)d_ws;
#if MK_PER_PHASE
    for (int p = 0; p < NPHASE; ++p) { a.ph_lo = p; a.ph_hi = p + 1; hipLaunchKernelGGL(yoco_fwd, dim3(grid), dim3(NWAVES * 64), LDS_BYTES, stream, a); }
#elif MK_DUP >= 0
#ifndef MK_DUP_N
#define MK_DUP_N 1
#endif
    a.ph_lo = 0; a.ph_hi = MK_DUP + 1; a.bar_region = 0; hipLaunchKernelGGL(yoco_fwd, dim3(grid), dim3(NWAVES * 64), LDS_BYTES, stream, a);
    for (int r = 0; r < MK_DUP_N; ++r) { a.ph_lo = MK_DUP; a.ph_hi = MK_DUP + 1; a.bar_region = 1;
#ifdef PROBE_NULL_EPI
        a.pad = 1;
#endif
        hipLaunchKernelGGL(yoco_fwd, dim3(grid), dim3(NWAVES * 64), LDS_BYTES, stream, a); }
    a.pad = 0;
    if (MK_DUP + 1 < NPHASE) { a.ph_lo = MK_DUP + 1; a.ph_hi = NPHASE; a.bar_region = 2; hipLaunchKernelGGL(yoco_fwd, dim3(grid), dim3(NWAVES * 64), LDS_BYTES, stream, a); }
#else
    a.ph_lo = 0; a.ph_hi = NPHASE; hipLaunchKernelGGL(yoco_fwd, dim3(grid), dim3(NWAVES * 64), LDS_BYTES, stream, a);
#endif
}
```
